# Optimizing an MI355X kernel written in HIP

```python
import math
import jax, jax.numpy as jnp
from jax import lax
import numpy as np

D_MODEL = 1024
BATCH = 4
SEQ = 4096
DEPTH = 2

GRID_W = 64
CTX_LEN = 256
N_HEADS = 8
HEAD_DIM = 64
V_DIM = 2 * HEAD_DIM
QK_W = N_HEADS * 2 * HEAD_DIM
ATTN_W = N_HEADS * V_DIM
CONV_W = 1024
CONV_K = 31
ROT_AXIS = HEAD_DIM // 2
ROPE_THETA = 10000.0
Q_BLOCK = 128
D_FF = 2816
N_EXPERTS = 8
TOP_K = 2
D_FF_EXPERT = 3584
N_DENSE = (DEPTH + 1) // 2
N_MOE = DEPTH // 2
EPS = 1e-6
Q_OFF = 0
K_OFF = Q_OFF + QK_W
V_OFF = K_OFF + QK_W
GLU_OFF = V_OFF + ATTN_W
GATE_OFF = GLU_OFF + 2 * CONV_W
IN_W = GATE_OFF + 2 * D_MODEL

kernel_name = "hybrid_diffattn_conformer_moe_dit"


def _rms(x, g):
    xf = x.astype(jnp.float32)
    y = xf * lax.rsqrt(jnp.mean(xf * xf, axis=-1, keepdims=True) + EPS)
    return (y * g.astype(jnp.float32)).astype(x.dtype)


def _layer_norm(x, g, b):
    xf = x.astype(jnp.float32)
    mu = jnp.mean(xf, axis=-1, keepdims=True)
    xc = xf - mu
    var = jnp.mean(xc * xc, axis=-1, keepdims=True)
    y = xc * lax.rsqrt(var + EPS) * g.astype(jnp.float32) + b.astype(jnp.float32)
    return y.astype(x.dtype)


def _modulate(h, shift, scale):
    return h * (1 + scale) + shift


def _axial_rope(rows):
    row = jnp.broadcast_to(jnp.arange(rows, dtype=jnp.float32)[:, None], (rows, GRID_W)).reshape(-1)
    col = jnp.broadcast_to(jnp.arange(GRID_W, dtype=jnp.float32)[None, :], (rows, GRID_W)).reshape(-1)
    inv = ROPE_THETA ** (-jnp.arange(0, ROT_AXIS, 2, dtype=jnp.float32) / ROT_AXIS)
    ar = row[:, None] * inv
    ac = col[:, None] * inv
    ang = jnp.concatenate([ar, ar, ac, ac], axis=-1)
    return jnp.cos(ang), jnp.sin(ang)


def _apply_rope(x, cos, sin):
    xs = x.reshape(x.shape[:-1] + (2, 2, ROT_AXIS // 2))
    rot = jnp.concatenate([-xs[..., 1:2, :], xs[..., 0:1, :]], axis=-2).reshape(x.shape)
    c = cos[None, :, None, None, :]
    s = sin[None, :, None, None, :]
    return (x * c + rot * s).astype(x.dtype)


def _qk_heads(raw, g):
    b, n = raw.shape[:2]
    return _rms(raw.reshape(b, n, N_HEADS, 2, HEAD_DIM), g)


def _v_heads(raw):
    b, n = raw.shape[:2]
    return raw.reshape(b, n, N_HEADS, V_DIM)


def _diff_attend(q, k, v, lam):
    s = jnp.einsum('bqhcd,bkhcd->bhcqk', q, k, preferred_element_type=jnp.float32) * (HEAD_DIM ** -0.5)
    p = jax.nn.softmax(s, axis=-1)
    w = p[:, :, 0] - lam * p[:, :, 1]
    return jnp.einsum('bhqk,bkhd->bqhd', w.astype(v.dtype), v)


def _latent_diff_attention(q, k_all, v_all, lam):
    b, s = q.shape[:2]
    nb = s // Q_BLOCK
    qb = jnp.moveaxis(q.reshape((b, nb, Q_BLOCK) + q.shape[2:]), 1, 0)
    ob = lax.map(lambda qq: _diff_attend(qq, k_all, v_all, lam), qb)
    return jnp.moveaxis(ob, 0, 1).reshape(b, s, N_HEADS, V_DIM)


def _attn_out(o, g, lam_init, w_o):
    b, n = o.shape[:2]
    o = _rms(o, g) * (1 - lam_init)
    return o.reshape(b, n, ATTN_W) @ w_o


def _conformer_conv(u_glu, dw_w, dw_b, ln_g, ln_b, w_o):
    a, gt = u_glu[..., :CONV_W], u_glu[..., CONV_W:]
    u = a * jax.nn.sigmoid(gt)
    u = lax.conv_general_dilated(u, dw_w[:, None, :].astype(u.dtype), window_strides=(1,),
                                 padding=[(CONV_K // 2, CONV_K // 2)],
                                 dimension_numbers=('NWC', 'WIO', 'NWC'),
                                 feature_group_count=CONV_W) + dw_b
    u = jax.nn.silu(_layer_norm(u, ln_g, ln_b))
    return u @ w_o


def _merge(p, y_attn, dw_w, dw_b, ln_g, ln_b, w_conv_o, w_out):
    y_conv = _conformer_conv(p[..., GLU_OFF:GATE_OFF], dw_w, dw_b, ln_g, ln_b, w_conv_o)
    gates = jax.nn.sigmoid(p[..., GATE_OFF:])
    return (gates[..., :D_MODEL] * y_attn + gates[..., D_MODEL:] * y_conv) @ w_out


def _swiglu(h, wg, wu, wd):
    return (jax.nn.silu(h @ wg) * (h @ wu)) @ wd


def _moe_swiglu(h, w_r, wg, wu, wd):
    lead = h.shape[:-1]
    t = h.reshape(-1, D_MODEL)
    logits = (t @ w_r).astype(jnp.float32)
    top_v, top_i = lax.top_k(logits, TOP_K)
    top_w = jax.nn.softmax(top_v, axis=-1)
    gates = jnp.sum(jax.nn.one_hot(top_i, N_EXPERTS, dtype=jnp.float32) * top_w[..., None], axis=1)
    out = jnp.zeros_like(t)
    for e in range(N_EXPERTS):
        out = out + gates[:, e:e + 1].astype(t.dtype) * _swiglu(t, wg[e], wu[e], wd[e])
    return out.reshape(lead + (D_MODEL,))


def _ffn(h, l, w_ff_gate, w_ff_up, w_ff_down, w_router, w_exp_gate, w_exp_up, w_exp_down):
    i = l // 2
    if l % 2 == 0:
        return _swiglu(h, w_ff_gate[i], w_ff_up[i], w_ff_down[i])
    return _moe_swiglu(h, w_router[i], w_exp_gate[i], w_exp_up[i], w_exp_down[i])


def setup_inputs(seed: int = 0) -> dict:
    key = jax.random.key(seed)
    ks = jax.random.split(key, 32)
    f = jnp.float32
    nrm = lambda k, shp, s: jax.random.normal(k, shp, f) * s
    gain = lambda k, shp: 1.0 + 0.02 * jax.random.normal(k, shp, f)
    d = D_MODEL
    return {
        "x": nrm(ks[0], (BATCH, SEQ, d), 1.0),
        "c": nrm(ks[1], (BATCH, d), 1.0),
        "ctx": nrm(ks[2], (BATCH, CTX_LEN, d), 1.0),
        "c_ctx": nrm(ks[3], (d,), 1.0),
        "w_mod": nrm(ks[4], (DEPTH, d, 6 * d), 0.5 * d ** -0.5),
        "b_mod": nrm(ks[5], (DEPTH, 6 * d), 0.01),
        "g_mix": gain(ks[6], (DEPTH, d)),
        "w_in": nrm(ks[7], (DEPTH, d, IN_W), d ** -0.5),
        "q_norm_g": gain(ks[8], (DEPTH, HEAD_DIM)),
        "k_norm_g": gain(ks[9], (DEPTH, HEAD_DIM)),
        "lambda_q1": nrm(ks[10], (DEPTH, HEAD_DIM), 0.1),
        "lambda_k1": nrm(ks[11], (DEPTH, HEAD_DIM), 0.1),
        "lambda_q2": nrm(ks[12], (DEPTH, HEAD_DIM), 0.1),
        "lambda_k2": nrm(ks[13], (DEPTH, HEAD_DIM), 0.1),
        "subln_g": gain(ks[14], (DEPTH, V_DIM)),
        "w_attn_o": nrm(ks[15], (DEPTH, ATTN_W, d), ATTN_W ** -0.5),
        "dw_weight": nrm(ks[16], (DEPTH, CONV_K, CONV_W), CONV_K ** -0.5),
        "dw_bias": nrm(ks[17], (DEPTH, CONV_W), 0.01),
        "conv_ln_g": gain(ks[18], (DEPTH, CONV_W)),
        "conv_ln_b": nrm(ks[19], (DEPTH, CONV_W), 0.01),
        "w_conv_o": nrm(ks[20], (DEPTH, CONV_W, d), CONV_W ** -0.5),
        "w_out": nrm(ks[21], (DEPTH, d, d), d ** -0.5),
        "g_ffn": gain(ks[22], (DEPTH, d)),
        "w_ff_gate": nrm(ks[23], (N_DENSE, d, D_FF), d ** -0.5),
        "w_ff_up": nrm(ks[24], (N_DENSE, d, D_FF), d ** -0.5),
        "w_ff_down": nrm(ks[25], (N_DENSE, D_FF, d), D_FF ** -0.5),
        "w_router": nrm(ks[26], (N_MOE, d, N_EXPERTS), d ** -0.5),
        "w_exp_gate": nrm(ks[27], (N_MOE, N_EXPERTS, d, D_FF_EXPERT), d ** -0.5),
        "w_exp_up": nrm(ks[28], (N_MOE, N_EXPERTS, d, D_FF_EXPERT), d ** -0.5),
        "w_exp_down": nrm(ks[29], (N_MOE, N_EXPERTS, D_FF_EXPERT, d), D_FF_EXPERT ** -0.5),
    }


def reference(x, c, ctx, c_ctx, w_mod, b_mod, g_mix, w_in, q_norm_g, k_norm_g,
              lambda_q1, lambda_k1, lambda_q2, lambda_k2, subln_g, w_attn_o,
              dw_weight, dw_bias, conv_ln_g, conv_ln_b, w_conv_o, w_out, g_ffn,
              w_ff_gate, w_ff_up, w_ff_down, w_router, w_exp_gate, w_exp_up, w_exp_down):
    s = x.shape[1]
    rows = s // GRID_W
    cos, sin = _axial_rope(rows)
    xc = ctx
    f32 = jnp.float32
    for l in range(DEPTH):
        last = l == DEPTH - 1
        ml = jnp.split((jax.nn.silu(c) @ w_mod[l] + b_mod[l])[:, None, :], 6, axis=-1)
        mc = jnp.split(jax.nn.silu(c_ctx) @ w_mod[l] + b_mod[l], 6, axis=-1)
        lam_init = 0.8 - 0.6 * math.exp(-0.3 * l)
        lam = (jnp.exp(jnp.sum(lambda_q1[l].astype(f32) * lambda_k1[l].astype(f32)))
               - jnp.exp(jnp.sum(lambda_q2[l].astype(f32) * lambda_k2[l].astype(f32))) + lam_init)

        h_lat = _modulate(_rms(x, g_mix[l]), ml[0], ml[1])
        h_ctx = _modulate(_rms(xc, g_mix[l]), mc[0], mc[1])
        p_lat = h_lat @ w_in[l]
        if last:
            p_kv = h_ctx @ w_in[l][:, K_OFF:GLU_OFF]
            k_ctx_raw, v_ctx_raw = p_kv[..., :QK_W], p_kv[..., QK_W:]
        else:
            p_ctx = h_ctx @ w_in[l]
            k_ctx_raw, v_ctx_raw = p_ctx[..., K_OFF:V_OFF], p_ctx[..., V_OFF:GLU_OFF]
        k_ctx = _qk_heads(k_ctx_raw, k_norm_g[l])
        v_ctx = _v_heads(v_ctx_raw)
        q_lat = _apply_rope(_qk_heads(p_lat[..., Q_OFF:K_OFF], q_norm_g[l]), cos, sin)
        k_lat = _apply_rope(_qk_heads(p_lat[..., K_OFF:V_OFF], k_norm_g[l]), cos, sin)
        v_lat = _v_heads(p_lat[..., V_OFF:GLU_OFF])
        k_all = jnp.concatenate([k_ctx, k_lat], axis=1)
        v_all = jnp.concatenate([v_ctx, v_lat], axis=1)
        o_lat = _latent_diff_attention(q_lat, k_all, v_all, lam)
        y_attn_lat = _attn_out(o_lat, subln_g[l], lam_init, w_attn_o[l])
        mix_lat = _merge(p_lat, y_attn_lat, dw_weight[l], dw_bias[l], conv_ln_g[l], conv_ln_b[l], w_conv_o[l], w_out[l])
        x = x + ml[2] * mix_lat
        if not last:
            q_ctx = _qk_heads(p_ctx[..., Q_OFF:K_OFF], q_norm_g[l])
            o_ctx = _diff_attend(q_ctx, k_ctx, v_ctx, lam)
            y_attn_ctx = _attn_out(o_ctx, subln_g[l], lam_init, w_attn_o[l])
            mix_ctx = _merge(p_ctx, y_attn_ctx, dw_weight[l], dw_bias[l], conv_ln_g[l], conv_ln_b[l], w_conv_o[l], w_out[l])
            xc = xc + mc[2] * mix_ctx

        h2 = _modulate(_rms(x, g_ffn[l]), ml[3], ml[4])
        x = x + ml[5] * _ffn(h2, l, w_ff_gate, w_ff_up, w_ff_down, w_router, w_exp_gate, w_exp_up, w_exp_down)
        if not last:
            h2c = _modulate(_rms(xc, g_ffn[l]), mc[3], mc[4])
            xc = xc + mc[5] * _ffn(h2c, l, w_ff_gate, w_ff_up, w_ff_down, w_router, w_exp_gate, w_exp_up, w_exp_down)
    return x
```

```cpp
#include <hip/hip_runtime.h>
#include <cstdio>
#include <cstdint>

#ifndef FAST_GEMM
#define FAST_GEMM 1
#endif
#ifndef FAST_ATTN
#define FAST_ATTN 1
#define ATT_STAGGER 0
#endif

#define GAS __attribute__((address_space(1)))
#define LAS __attribute__((address_space(3)))
typedef unsigned short bf16;
typedef unsigned v4u __attribute__((ext_vector_type(4)));
typedef unsigned v2u __attribute__((ext_vector_type(2)));
typedef float f32x4 __attribute__((ext_vector_type(4)));
typedef float f32x2 __attribute__((ext_vector_type(2)));
typedef float f32x16 __attribute__((ext_vector_type(16)));
typedef short bf16x8 __attribute__((ext_vector_type(8)));
typedef short s16x4 __attribute__((ext_vector_type(4)));

constexpr int D = 1024, NB = 4, SEQ = 4096, CTXL = 256, TK = SEQ + CTXL, RL = NB * SEQ, RC = NB * CTXL, R = RL + RC;
constexpr int NH = 8, HD = 64, VD = 128, INW = 7168, DFF = 2816, NE = 8, DFE = 3584, CK = 31;
constexpr float EPS = 1e-6f;
constexpr float QSCALE = 0.125f * 1.4426950408889634f;
enum { I_X = 0, I_C, I_CTX, I_CCTX, I_WMOD, I_BMOD, I_GMIX, I_WIN, I_QG, I_KG, I_LQ1, I_LK1, I_LQ2, I_LK2, I_SUBLN, I_WATTNO, I_DWW, I_DWB, I_CLNG, I_CLNB, I_WCONVO, I_WOUT, I_GFFN,
       I_WFFG, I_WFFU, I_WFFD, I_WR, I_WEG, I_WEU, I_WED, N_IN };

constexpr size_t MiB = 1u << 20;
constexpr size_t WS_CTL = 0, CTL_ZERO_BYTES = 1 * MiB;
constexpr size_t WS_MOD = 1 * MiB;
constexpr size_t WS_ROPE = 1 * MiB + 256 * 1024;
constexpr size_t WS_LAM = 1 * MiB + 300 * 1024;
constexpr size_t WS_BC = 1 * MiB + 320 * 1024;
constexpr size_t WS_TOK = 2 * MiB;
constexpr size_t WS_SLIST = 2 * MiB + 512 * 1024;
constexpr size_t WS_WIN = 3 * MiB;
constexpr size_t WS_WA = 31 * MiB, WS_WC = 33 * MiB, WS_WO = 35 * MiB;
constexpr size_t WS_WGU0 = 43 * MiB, WS_WD0 = 54 * MiB;
constexpr size_t WS_WEGU = 60 * MiB, WS_WED = 172 * MiB;
constexpr size_t WS_XB = 228 * MiB;
constexpr size_t WS_A0 = 296 * MiB;
constexpr size_t WS_A1 = 330 * MiB;
constexpr size_t WS_A2 = 364 * MiB;
constexpr size_t WS_A3 = 398 * MiB;
constexpr size_t WS_A4 = 432 * MiB;
constexpr size_t WS_A5 = 466 * MiB;
constexpr size_t WS_END = 554 * MiB;
constexpr int CW_BAR = 4096;
constexpr int CW_CNT = 16384;

constexpr int RING_BYTES = 131072, LDSCTL_OFF = RING_BYTES, MISC_OFF = LDSCTL_OFF + 320, MOETAB_OFF = LDSCTL_OFF + 1024, LDS_BYTES = 147456;

#define LDS_WAIT() asm volatile("s_waitcnt lgkmcnt(0)" ::: "memory")
#define VM_WAIT() asm volatile("s_waitcnt vmcnt(0)" ::: "memory")
__device__ __forceinline__ unsigned cvt_pk_bf16(float lo, float hi) { unsigned r; asm volatile("v_cvt_pk_bf16_f32 %0, %1, %2" : "=v"(r) : "v"(lo), "v"(hi)); return r; }
__device__ __forceinline__ float bflo(unsigned w) { return __uint_as_float(w << 16); }
__device__ __forceinline__ float bfhi(unsigned w) { return __uint_as_float(w & 0xffff0000u); }
__device__ __forceinline__ float sigm(float x) { return 1.f / (1.f + __expf(-x)); }
__device__ __forceinline__ float sigf(float x) { return __builtin_amdgcn_rcpf(1.f + __builtin_amdgcn_exp2f(x * -1.4426950408889634f)); }
__device__ __forceinline__ float wave_sum(float v) {
#pragma unroll
    for (int o = 1; o < 64; o <<= 1) v += __shfl_xor(v, o);
    return v;
}
__device__ __forceinline__ int row_mi(int row) { return row < RL ? (row >> 12) : 4; }
__device__ __forceinline__ int row_b(int row) { return row < RL ? (row >> 12) : ((row - RL) >> 8); }
__device__ __forceinline__ int row_t(int row) { return row < RL ? (CTXL + (row & 4095)) : ((row - RL) & 255); }

#define XB_TMO      128
#define XB_XCNT(j)  (256  + 64 * (j))
#define XB_XSUB(j)  (1280 + 64 * (j))
#define XB_XGEN(j)  (2304 + 64 * (j))
#define XB_TOP      3328
#define XB_TOPGEN   3392
#define XCD_BAR_WORDS 3456
#define XB_SPIN_CAP (1u << 22)
__device__ __forceinline__ unsigned xb_ld(unsigned* p)              { return __hip_atomic_load(p, __ATOMIC_RELAXED, __HIP_MEMORY_SCOPE_AGENT); }
__device__ __forceinline__ unsigned xb_add(unsigned* p, unsigned v) { return __hip_atomic_fetch_add(p, v, __ATOMIC_RELAXED, __HIP_MEMORY_SCOPE_AGENT); }
__device__ __forceinline__ unsigned xb_xcc_id() { return (unsigned)__builtin_amdgcn_s_getreg((3 << 11) | 20) & 0xFu; }
#define XB_SPIN(cond, bar) do { unsigned _sp = 0; while (cond) { __builtin_amdgcn_s_sleep(1); \
    if ((++_sp & 255u) == 0u) { if (xb_ld(&(bar)[XB_TMO])) break; if (_sp > XB_SPIN_CAP) { atomicAdd(&(bar)[XB_TMO], 1u); break; } } } } while (0)
struct XcdBarrier { unsigned* bar; unsigned x; volatile LAS unsigned* st; };
__device__ __forceinline__ XcdBarrier xcd_barrier_post(unsigned* bar, volatile LAS unsigned* st) {
    XcdBarrier b; b.bar = bar; b.x = xb_xcc_id(); b.st = st;
    if (threadIdx.x == 0) (void)xb_add(&bar[XB_XCNT(b.x)], 1u);
    return b;
}
__device__ __forceinline__ void xcd_barrier_complete(unsigned* bar, unsigned x, unsigned& nloc, unsigned& nx) {
    const unsigned G = gridDim.x * gridDim.y * gridDim.z;
    unsigned sum, cnt, mine, sp = 0u;
    for (;;) {
        sum = 0u; cnt = 0u; mine = 0u;
#pragma unroll
        for (unsigned j = 0; j < 16; ++j) { const unsigned c = xb_ld(&bar[XB_XCNT(j)]); sum += c; cnt += (c > 0u) ? 1u : 0u; mine = (j == x) ? c : mine; }
        if (sum == G) break;
        __builtin_amdgcn_s_sleep(1);
        if ((++sp & 255u) == 0u) { if (xb_ld(&bar[XB_TMO])) break; if (sp > XB_SPIN_CAP) { atomicAdd(&bar[XB_TMO], 1u); break; } }
    }
    nloc = mine > 0u ? mine : 1u; nx = cnt > 0u ? cnt : 1u;
}
__device__ __forceinline__ void xcd_barrier(const XcdBarrier& b) {
    asm volatile("s_waitcnt vmcnt(0)" ::: "memory");
    __syncthreads();
    if (threadIdx.x == 0) {
        unsigned* bar = b.bar;
        __builtin_amdgcn_s_waitcnt(0);
        unsigned nloc = b.st[0], nx = b.st[1];
        if (nloc == 0u) { xcd_barrier_complete(bar, b.x, nloc, nx); b.st[0] = nloc; b.st[1] = nx; }
        const unsigned old = xb_add(&bar[XB_XSUB(b.x)], 1u);
        const unsigned gen = old / nloc;
        if (old + 1u == (gen + 1u) * nloc) {
            __builtin_amdgcn_fence(__ATOMIC_RELEASE, "agent");
            asm volatile("s_waitcnt vmcnt(0)" ::: "memory");
            const unsigned og = xb_add(&bar[XB_TOP], 1u);
            const unsigned tg = og / nx;
            if (og + 1u == (tg + 1u) * nx) xb_add(&bar[XB_TOPGEN], 1u);
            else XB_SPIN(xb_ld(&bar[XB_TOPGEN]) == tg, bar);
            __builtin_amdgcn_fence(__ATOMIC_ACQUIRE, "agent");
            xb_add(&bar[XB_XGEN(b.x)], 1u);
            asm volatile("s_waitcnt vmcnt(0)" ::: "memory");
        } else {
            XB_SPIN(xb_ld(&bar[XB_XGEN(b.x)]) == gen, bar);
            __builtin_amdgcn_fence(__ATOMIC_ACQUIRE, "agent");
            asm volatile("s_waitcnt vmcnt(0)" ::: "memory");
        }
    }
    __syncthreads();
}

struct Unit { const char* A; const char* B; const int* rows; int row0, col0, lo, hi, aux; };

__device__ __forceinline__ void tile_of(int wgid, int nM, int nN, int& pm, int& pn) {
    const int nwg = nM * nN;
    { const int q = nwg / 8, r = nwg % 8, xcd = wgid % 8, off = wgid / 8; wgid = (xcd < r ? xcd * (q + 1) : r * (q + 1) + (xcd - r) * q) + off; }
    const int nig = 8 * nN, gid = wgid / nig, fm = gid * 8, gsz = (nM - fm) < 8 ? (nM - fm) : 8;
    pm = fm + ((wgid % nig) % gsz); pn = (wgid % nig) / gsz;
}
struct SchedPlain {
    const char* A; const char* Bt; int nM, nN, K, G, c;
    __device__ __forceinline__ bool next(int i, Unit& u) const {
        const int L = i * G + c; if (L >= nM * nN) return false;
        int pm, pn; tile_of(L, nM, nN, pm, pn);
        u.A = A + (size_t)pm * 256 * K * 2; u.B = Bt + (size_t)pn * 256 * K * 2; u.rows = nullptr; u.row0 = pm * 256; u.col0 = pn * 256; u.lo = 0; u.hi = 0x7fffffff; u.aux = 0; return true;
    }
};
struct SchedMerge {
    const char* A0; const char* B0; const char* A1; const char* B1; int nM, nN, K, G, c;
    __device__ __forceinline__ bool next(int i, Unit& u) const {
        const int L = (i >> 1) * G + c; if (L >= nM * nN) return false;
        int pm, pn; tile_of(L, nM, nN, pm, pn); const int pass = i & 1;
        u.A = (pass ? A1 : A0) + (size_t)pm * 256 * K * 2; u.B = (pass ? B1 : B0) + (size_t)pn * 256 * K * 2; u.rows = nullptr; u.row0 = pm * 256; u.col0 = pn * 256; u.lo = 0; u.hi = 0x7fffffff; u.aux = pass; return true;
    }
};
struct SchedMoe {
    const char* A; const char* Bt; const int* slist; const LAS int* tab; int NU, nN, K, G, c; size_t bstride; int gather; int Lmax;
    __device__ __forceinline__ bool next(int i, Unit& u) const {
        const int L = i * G + c; if (L >= Lmax) return false;
        int pm, pn; tile_of(L, NU, nN, pm, pn);
        const int tile = __builtin_amdgcn_readfirstlane(tab[pm * 4 + 0]), e = __builtin_amdgcn_readfirstlane(tab[pm * 4 + 1]);
        u.lo = __builtin_amdgcn_readfirstlane(tab[pm * 4 + 2]); u.hi = __builtin_amdgcn_readfirstlane(tab[pm * 4 + 3]);
        u.A = gather ? A : A + (size_t)tile * 256 * K * 2; u.rows = gather ? slist + tile * 256 : nullptr;
        u.B = Bt + (size_t)e * bstride + (size_t)pn * 256 * K * 2; u.row0 = tile * 256; u.col0 = pn * 256; u.aux = e; return true;
    }
};

__device__ __forceinline__ int qk_vec_of(int v) { return ((v >> 8) << 2) | ((v >> 5) & 3); }
__device__ __forceinline__ int qk_dim_of(int v) { const int j = v & 31; return (((v >> 7) & 1) << 5) | (((j >> 2) & 1) << 4) | ((j >> 3) << 2) | (j & 3); }
__device__ __forceinline__ int qk_src_col(int v) { return qk_vec_of(v) * 64 + qk_dim_of(v); }
__device__ __forceinline__ v4u pack8(f32x4 a, f32x4 b) { v4u w; w.x = cvt_pk_bf16(a[0], a[1]); w.y = cvt_pk_bf16(a[2], a[3]); w.z = cvt_pk_bf16(b[0], b[1]); w.w = cvt_pk_bf16(b[2], b[3]); return w; }
__device__ __forceinline__ void unpack8(v4u w, f32x4& a, f32x4& b) { a = (f32x4){bflo(w.x), bfhi(w.x), bflo(w.y), bfhi(w.y)}; b = (f32x4){bflo(w.z), bfhi(w.z), bflo(w.w), bfhi(w.w)}; }
struct EpiInProj {
    static constexpr bool ROW16 = true;
    bf16 *Q, *K, *V, *U0, *GT; const float *qg, *kg, *rope;
    __device__ __forceinline__ void store8(const Unit&, int row, int col, f32x4 v0, f32x4 v1) const {
        if (col < 3072) {
            const int b = row_b(row), t = row_t(row);
            if (col < 2048) {
                const int vec = qk_vec_of(col), d0 = qk_dim_of(col); bf16* base = (vec < 16 ? Q : K) + ((size_t)(((b * NH) * 2 + (vec & 15)) * TK + t) * 64 + d0);
                v2u w0, w1; w0.x = cvt_pk_bf16(v0[0], v0[1]); w0.y = cvt_pk_bf16(v0[2], v0[3]); w1.x = cvt_pk_bf16(v1[0], v1[1]); w1.y = cvt_pk_bf16(v1[2], v1[3]);
                *(v2u*)base = w0; *(v2u*)(base + 16) = w1; }
            else { const v4u w = pack8(v0, v1); const int cc = col - 2048, h = cc >> 7, dv = cc & 127; *(v4u*)(V + ((size_t)((b * NH + h) * TK + t) * 128 + dv)) = w; }
        } else if (col < 5120) {
            const int ch = (col - 3072) >> 1; v2u w; w.x = cvt_pk_bf16(v0[0] * sigm(v1[0]), v0[1] * sigm(v1[1])); w.y = cvt_pk_bf16(v0[2] * sigm(v1[2]), v0[3] * sigm(v1[3]));
            *(v2u*)(U0 + (size_t)row * 1024 + ch) = w;
        } else {
            f32x4 a, b;
#pragma unroll
            for (int j = 0; j < 4; ++j) { a[j] = sigm(v0[j]); b[j] = sigm(v1[j]); }
            *(v4u*)(GT + (size_t)row * 2048 + (col - 5120)) = pack8(a, b);
        }
    }
    __device__ __forceinline__ void store16(const Unit& u, int row, int col, f32x4 a0, f32x4 a1, f32x4 b0, f32x4 b1) const {
        if (col >= 2048) { store8(u, row, col, a0, a1); store8(u, row, col + 128, b0, b1); return; }
        const int b = row_b(row), t = row_t(row), vec = qk_vec_of(col), q4 = ((col & 31) >> 3) << 2;
        float ss = 0.f;
#pragma unroll
        for (int r = 0; r < 4; ++r) ss += (a0[r] * a0[r] + a1[r] * a1[r]) + (b0[r] * b0[r] + b1[r] * b1[r]);
        ss += __shfl_xor(ss, 16); ss += __shfl_xor(ss, 32);
        const float rinv = 1.f / sqrtf(ss * (1.f / 64.f) + EPS) * (vec < 16 ? QSCALE : 1.f);
        const float* g = (vec < 16 ? qg : kg) + q4;
        a0 = a0 * rinv * *(const f32x4*)g; a1 = a1 * rinv * *(const f32x4*)(g + 16); b0 = b0 * rinv * *(const f32x4*)(g + 32); b1 = b1 * rinv * *(const f32x4*)(g + 48);
        if (t >= CTXL) { const int sq = t - CTXL; const float* c0p = rope + (sq >> 6) * 16 + q4; const float* c1p = rope + (sq & 63) * 16 + q4;
            const f32x4 c0 = *(const f32x4*)c0p, s0 = *(const f32x4*)(c0p + 1024), c1 = *(const f32x4*)c1p, s1 = *(const f32x4*)(c1p + 1024);
            const f32x4 x0 = a0 * c0 - a1 * s0, x1 = a1 * c0 + a0 * s0, y0 = b0 * c1 - b1 * s1, y1 = b1 * c1 + b0 * s1; a0 = x0; a1 = x1; b0 = y0; b1 = y1; }
        bf16* base = (vec < 16 ? Q : K) + ((size_t)(((b * NH) * 2 + (vec & 15)) * TK + t) * 64 + q4);
        v2u w; w.x = cvt_pk_bf16(a0[0], a0[1]); w.y = cvt_pk_bf16(a0[2], a0[3]); *(v2u*)base = w;
        w.x = cvt_pk_bf16(a1[0], a1[1]); w.y = cvt_pk_bf16(a1[2], a1[3]); *(v2u*)(base + 16) = w;
        w.x = cvt_pk_bf16(b0[0], b0[1]); w.y = cvt_pk_bf16(b0[2], b0[3]); *(v2u*)(base + 32) = w;
        w.x = cvt_pk_bf16(b1[0], b1[1]); w.y = cvt_pk_bf16(b1[2], b1[3]); *(v2u*)(base + 48) = w;
    }
};
struct EpiMerge {
    static constexpr bool ROW16 = false;
    const bf16* GT; bf16* TF; bf16* M1;
    __device__ __forceinline__ void store8(const Unit& u, int row, int col, f32x4 v0, f32x4 v1) const {
        f32x4 g0, g1; unpack8(*(const v4u*)(GT + (size_t)row * 2048 + u.aux * 1024 + col), g0, g1);
        if (u.aux == 0) { *(v4u*)(TF + (size_t)row * 1024 + col) = pack8(g0 * v0, g1 * v1); }
        else { f32x4 t0, t1; unpack8(*(const v4u*)(TF + (size_t)row * 1024 + col), t0, t1); *(v4u*)(M1 + (size_t)row * 1024 + col) = pack8(t0 + g0 * v0, t1 + g1 * v1); }
    }
};
struct EpiResid {
    static constexpr bool ROW16 = false;
    const float* src_lat; const float* src_ctx; float* dst; const float* gate;
    __device__ __forceinline__ void store8(const Unit&, int row, int col, f32x4 v0, f32x4 v1) const {
        const float* s = (row < RL ? src_lat + (size_t)row * 1024 : src_ctx + (size_t)(row - RL) * 1024) + col; const float* g = gate + row_mi(row) * 6144 + col;
        const f32x4 s0 = *(const f32x4*)s, s1 = *(const f32x4*)(s + 4), g0 = *(const f32x4*)g, g1 = *(const f32x4*)(g + 4);
        float* d = dst + (size_t)row * 1024 + col; *(f32x4*)d = s0 + g0 * v0; *(f32x4*)(d + 4) = s1 + g1 * v1;
    }
};
struct EpiSwiglu {
    static constexpr bool ROW16 = false;
    bf16* ACT; int ld;
    __device__ __forceinline__ void store8(const Unit&, int row, int col, f32x4 v0, f32x4 v1) const {
        v2u w; w.x = cvt_pk_bf16(v0[0] * sigm(v0[0]) * v1[0], v0[1] * sigm(v0[1]) * v1[1]); w.y = cvt_pk_bf16(v0[2] * sigm(v0[2]) * v1[2], v0[3] * sigm(v0[3]) * v1[3]);
        *(v2u*)(ACT + (size_t)row * ld + (col >> 1)) = w;
    }
};
struct EpiBf16Plain { bf16* O; int ld;
    static constexpr bool ROW16 = false;
    __device__ __forceinline__ void store8(const Unit&, int row, int col, f32x4 v0, f32x4 v1) const { *(v4u*)(O + (size_t)row * ld + col) = pack8(v0, v1); }
};

template <class Epi, class Sched>
__device__ __forceinline__ void gemm_naive(LAS unsigned char* lds, const int K, const Sched& S, const Epi& E) {
    LAS float* As = (LAS float*)lds; LAS float* Bs = As + 32 * 132;
    const int tid = threadIdx.x, ty = tid >> 4, tx = tid & 15, lr = tid >> 2, kc = (tid & 3) * 8;
    Unit u;
    for (int i = 0; S.next(i, u); ++i) {
        for (int sub = 0; sub < 4; ++sub) {
            const int rm = (sub >> 1) * 128, cn = (sub & 1) * 128;
            const size_t arow = u.rows ? (size_t)u.rows[rm + lr] : (size_t)(rm + lr);
            const bf16* ap = (const bf16*)u.A + arow * K + kc; const bf16* bp = (const bf16*)u.B + (size_t)(cn + lr) * K + kc;
            float acc[4][8];
#pragma unroll
            for (int r = 0; r < 4; ++r)
#pragma unroll
                for (int c = 0; c < 8; ++c) acc[r][c] = 0.f;
            for (int k0 = 0; k0 < K; k0 += 32) {
                const v4u av = *(const v4u*)(ap + k0), bv = *(const v4u*)(bp + k0);
                f32x4 a0, a1, b0, b1; unpack8(av, a0, a1); unpack8(bv, b0, b1);
#pragma unroll
                for (int j = 0; j < 4; ++j) { As[(kc + j) * 132 + lr] = a0[j]; As[(kc + 4 + j) * 132 + lr] = a1[j]; Bs[(kc + j) * 132 + lr] = b0[j]; Bs[(kc + 4 + j) * 132 + lr] = b1[j]; }
                __syncthreads();
#pragma unroll 4
                for (int kk = 0; kk < 32; ++kk) {
                    const f32x4 a = *(const LAS f32x4*)(As + kk * 132 + ty * 4), p = *(const LAS f32x4*)(Bs + kk * 132 + tx * 8), q = *(const LAS f32x4*)(Bs + kk * 132 + tx * 8 + 4);
#pragma unroll
                    for (int r = 0; r < 4; ++r) {
#pragma unroll
                        for (int c = 0; c < 4; ++c) { acc[r][c] += a[r] * p[c]; acc[r][4 + c] += a[r] * q[c]; } }
                }
                __syncthreads();
            }
#pragma unroll
            for (int r = 0; r < 4; ++r) { const int row = u.row0 + rm + ty * 4 + r;
                if (row >= u.lo && row < u.hi) E.store8(u, row, u.col0 + cn + tx * 8, (f32x4){acc[r][0], acc[r][1], acc[r][2], acc[r][3]}, (f32x4){acc[r][4], acc[r][5], acc[r][6], acc[r][7]}); }
        }
    }
}

namespace pg8 {
constexpr int BM = 256, BK = 64, HALF = 128, HTB = HALF * BK * 2, STAGE_BYTES = 8 * HTB;
__device__ __forceinline__ int lds_byte(int r, int c) { const int st = (r >> 4) * 2 + (c >> 5), rr = r & 15, cc = c & 31, ob = rr * 64 + cc * 2; return st * 1024 + (ob ^ (((ob >> 9) & 1) << 5)); }
__device__ __forceinline__ void stage_rc(int b, int& R_, int& C_) { const int st = b / 1024, sb = b % 1024, swz = sb ^ (((sb >> 9) & 1) << 5); R_ = (st >> 1) * 16 + swz / 64; C_ = (st & 1) * 32 + (swz % 64) / 2; }
__device__ __forceinline__ int perm32(int rho) { const int n = rho >> 4, i = rho & 15; return 8 * (i >> 2) + 4 * n + (i & 3); }

template <class Epi, class Sched, bool GATHER>
__device__ __forceinline__ void gemm_phase(LAS unsigned char* lds, const int K, const Sched& S, const Epi& E) {
    const int tid = threadIdx.x, wid = __builtin_amdgcn_readfirstlane(tid >> 6), lane = tid & 63, wr = wid >> 2, wc = wid & 3, fr = lane & 15, fq = lane >> 4;
    const int nt = K / BK;
    int Rr[2], Cc[2]; unsigned voffB[2];
#pragma unroll
    for (int i = 0; i < 2; ++i) { stage_rc(tid * 16 + i * 8192, Rr[i], Cc[i]); const int Rb = (Rr[i] & ~31) + perm32(Rr[i] & 31); voffB[i] = (unsigned)(Rb * K + Cc[i]) * 2u; }
    const size_t kstep = (size_t)(BK * 2), hstep = (size_t)HALF * K * 2;
    const unsigned ldsw = (unsigned)wid * 1024u;
    const int aoff = lds_byte(wr * 64 + fr, fq * 8), boff = lds_byte(wc * 32 + fr, fq * 8);
#define PG8_SA(b, h) (((b) * 2 + (h)) * HTB)
#define PG8_SB(b, h) ((4 + (b) * 2 + (h)) * HTB)
#define PG8_STAGE2(bufoff, gbase, o0, o1) do { \
        __builtin_amdgcn_global_load_lds((const unsigned*)((const char*)(gbase) + (o0)), (LAS unsigned*)(lds + (bufoff) + ldsw), 16, 0, 0); \
        __builtin_amdgcn_global_load_lds((const unsigned*)((const char*)(gbase) + (o1)), (LAS unsigned*)(lds + (bufoff) + ldsw + 8192), 16, 0, 0); } while (0)
#define PG8_STAGEB(bufoff, gbase) PG8_STAGE2(bufoff, gbase, voffB[0], voffB[1])
#define PG8_LDA(dst, b, h) do { _Pragma("unroll") for (int m = 0; m < 4; ++m) _Pragma("unroll") for (int k = 0; k < 2; ++k) dst[m][k] = *(const LAS bf16x8*)(lds + PG8_SA(b, h) + aoff + m * 2048 + k * 1024); } while (0)
#define PG8_LDB(dst, b, h) do { _Pragma("unroll") for (int n = 0; n < 2; ++n) _Pragma("unroll") for (int k = 0; k < 2; ++k) dst[n][k] = *(const LAS bf16x8*)(lds + PG8_SB(b, h) + boff + n * 2048 + k * 1024); } while (0)
#define PG8_MMA(ai, bj, At, Bt) do { __builtin_amdgcn_s_setprio(1); _Pragma("unroll") for (int m = 0; m < 4; ++m) _Pragma("unroll") for (int n = 0; n < 2; ++n) _Pragma("unroll") for (int k = 0; k < 2; ++k) \
        acc[ai][bj][m][n] = __builtin_amdgcn_mfma_f32_16x16x32_bf16(Bt[n][k], At[m][k], acc[ai][bj][m][n], 0, 0, 0); __builtin_amdgcn_s_setprio(0); } while (0)
#define PG8_WAIT_V(n) asm volatile("s_waitcnt vmcnt(" #n ")" ::: "memory")
#define PG8_WAIT_L(n) asm volatile("s_waitcnt lgkmcnt(" #n ")" ::: "memory")
#define PG8_BAR __builtin_amdgcn_s_barrier()
#define PG8_SCHED __builtin_amdgcn_sched_barrier(0)
#define PG8_OFFS(u, o0, o1) do { _Pragma("unroll") for (int _i = 0; _i < 2; ++_i) { \
        if (GATHER && (u).rows) { const unsigned r0_ = (unsigned)(u).rows[Rr[_i]], r1_ = (unsigned)(u).rows[Rr[_i] + HALF]; o0[_i] = (r0_ * (unsigned)K + (unsigned)Cc[_i]) * 2u; o1[_i] = (r1_ * (unsigned)K + (unsigned)Cc[_i]) * 2u; } \
        else { o0[_i] = (unsigned)(Rr[_i] * K + Cc[_i]) * 2u; o1[_i] = o0[_i] + (unsigned)hstep; } } } while (0)
    Unit cur, nxt; int ui = 0;
    if (!S.next(0, cur)) return;
    f32x4 acc[2][2][4][2];
#pragma unroll
    for (int a = 0; a < 2; ++a)
#pragma unroll
        for (int b = 0; b < 2; ++b)
#pragma unroll
            for (int m = 0; m < 4; ++m)
#pragma unroll
                for (int n = 0; n < 2; ++n) acc[a][b][m][n] = (f32x4){0.f, 0.f, 0.f, 0.f};
    bf16x8 At[4][2], B0[2][2], B1[2][2];
    unsigned vA0[2], vA1[2], nA0[2], nA1[2];
    PG8_OFFS(cur, vA0, vA1);
    const char* cA = cur.A; const char* cB = cur.B;
    PG8_STAGEB(PG8_SB(0, 0), cB); PG8_STAGEB(PG8_SB(0, 1), cB + hstep); PG8_STAGE2(PG8_SA(0, 0), cA, vA0[0], vA0[1]); PG8_STAGE2(PG8_SA(0, 1), cA, vA1[0], vA1[1]);
    if (wr == 1) PG8_BAR;
    PG8_WAIT_V(2); PG8_BAR;
    PG8_STAGEB(PG8_SB(1, 0), cB + kstep); PG8_STAGE2(PG8_SA(1, 0), cA + kstep, vA0[0], vA0[1]); PG8_STAGEB(PG8_SB(1, 1), cB + hstep + kstep);
    PG8_WAIT_V(6); PG8_BAR;
    for (;;) {
        const bool has_next = S.next(ui + 1, nxt);
        const char* nA = has_next ? nxt.A : cA; const char* nB = has_next ? nxt.B : cB;
        if (GATHER) { if (has_next) { PG8_OFFS(nxt, nA0, nA1); } else {
#pragma unroll
            for (int i = 0; i < 2; ++i) { nA0[i] = vA0[i]; nA1[i] = vA1[i]; } } }
        for (int t = 0; t < nt; t += 2) {
            const bool last = (t == nt - 2);
            const char* a1 = cA + (size_t)(t + 1) * kstep;
            const char* a2 = last ? nA : cA + (size_t)(t + 2) * kstep; const char* b2 = last ? nB : cB + (size_t)(t + 2) * kstep;
            const char* a3 = a2 + kstep; const char* b3 = b2 + kstep;
            unsigned x00 = vA0[0], x01 = vA0[1], x10 = vA1[0], x11 = vA1[1];
            if (GATHER) { if (last) { x00 = nA0[0]; x01 = nA0[1]; x10 = nA1[0]; x11 = nA1[1]; } }
            PG8_LDB(B0, 0, 0); PG8_LDB(B1, 0, 1); PG8_SCHED; PG8_LDA(At, 0, 0); PG8_STAGE2(PG8_SA(1, 1), a1, vA1[0], vA1[1]);
            PG8_WAIT_V(8); PG8_WAIT_L(0); PG8_BAR; PG8_MMA(0, 0, At, B0); PG8_MMA(0, 1, At, B1); PG8_BAR; PG8_SCHED;
            PG8_LDA(At, 0, 1); PG8_STAGEB(PG8_SB(0, 0), b2); PG8_STAGEB(PG8_SB(0, 1), b2 + hstep); PG8_STAGE2(PG8_SA(0, 0), a2, x00, x01);
            PG8_WAIT_V(8); PG8_WAIT_L(0); PG8_BAR; PG8_MMA(1, 0, At, B0); PG8_MMA(1, 1, At, B1); PG8_BAR; PG8_SCHED;
            PG8_LDB(B0, 1, 0); PG8_LDB(B1, 1, 1); PG8_SCHED; PG8_LDA(At, 1, 0); PG8_STAGE2(PG8_SA(0, 1), a2, x10, x11);
            PG8_WAIT_V(8); PG8_WAIT_L(0); PG8_BAR; PG8_MMA(0, 0, At, B0); PG8_MMA(0, 1, At, B1); PG8_BAR; PG8_SCHED;
            PG8_LDA(At, 1, 1); PG8_STAGEB(PG8_SB(1, 0), b3); PG8_STAGEB(PG8_SB(1, 1), b3 + hstep); PG8_STAGE2(PG8_SA(1, 0), a3, x00, x01);
            PG8_WAIT_V(8); PG8_WAIT_L(0); PG8_BAR; PG8_MMA(1, 0, At, B0); PG8_MMA(1, 1, At, B1); PG8_BAR; PG8_SCHED;
        }
        if (wr == 0) PG8_BAR;
        {
            const int row0 = cur.row0 + wr * 64 + fr, colb = cur.col0 + wc * 32 + 8 * fq;
#pragma unroll
            for (int ai = 0; ai < 2; ++ai)
#pragma unroll
                for (int m = 0; m < 4; ++m) { const int row = row0 + ai * HALF + m * 16;
                    if (row >= cur.lo && row < cur.hi) {
                        if constexpr (Epi::ROW16) E.store16(cur, row, colb, acc[ai][0][m][0], acc[ai][0][m][1], acc[ai][1][m][0], acc[ai][1][m][1]);
                        else {
#pragma unroll
                            for (int bj = 0; bj < 2; ++bj) E.store8(cur, row, colb + bj * HALF, acc[ai][bj][m][0], acc[ai][bj][m][1]); } } }
        }
        if (!has_next) break;
#pragma unroll
        for (int a = 0; a < 2; ++a)
#pragma unroll
            for (int b = 0; b < 2; ++b)
#pragma unroll
                for (int m = 0; m < 4; ++m)
#pragma unroll
                    for (int n = 0; n < 2; ++n) acc[a][b][m][n] = (f32x4){0.f, 0.f, 0.f, 0.f};
        cur = nxt; cA = nA; cB = nB; ++ui;
        if (GATHER) {
#pragma unroll
            for (int i = 0; i < 2; ++i) { vA0[i] = nA0[i]; vA1[i] = nA1[i]; } }
        if (wr == 1) PG8_BAR;
    }
    PG8_WAIT_V(0);
    PG8_BAR;
#undef PG8_SA
#undef PG8_SB
#undef PG8_STAGE2
#undef PG8_STAGEB
#undef PG8_LDA
#undef PG8_LDB
#undef PG8_MMA
#undef PG8_WAIT_V
#undef PG8_WAIT_L
#undef PG8_BAR
#undef PG8_SCHED
#undef PG8_OFFS
}
}


template <bool MASK = false, class Epi>
__device__ __forceinline__ void gemm_small_tile(LAS unsigned char* lds, const bf16* A, const bf16* Bt, int K, int row_abs0, int col_abs0, const Unit& u, const Epi& E) {
    const int tid = threadIdx.x, wid = __builtin_amdgcn_readfirstlane(tid >> 6), lane = tid & 63, fr = lane & 15, fq = lane >> 4;
    const int kw = K >> 3, kbeg = wid * kw;
    f32x4 acc[4][2][2];
#pragma unroll
    for (int m = 0; m < 4; ++m)
#pragma unroll
        for (int g = 0; g < 2; ++g)
#pragma unroll
            for (int n = 0; n < 2; ++n) acc[m][g][n] = (f32x4){0.f, 0.f, 0.f, 0.f};
    const bf16* ap = A + (size_t)fr * K + kbeg + 8 * fq;
    const bf16* bp = Bt + (size_t)(8 * (fr >> 2) + (fr & 3)) * K + kbeg + 8 * fq;
#pragma unroll 4
    for (int k0 = 0; k0 < kw; k0 += 32) {
        bf16x8 af[4], bfr[2][2];
#pragma unroll
        for (int m = 0; m < 4; ++m) af[m] = *(const bf16x8*)(ap + (size_t)(16 * m) * K + k0);
#pragma unroll
        for (int g = 0; g < 2; ++g)
#pragma unroll
            for (int n = 0; n < 2; ++n) bfr[g][n] = *(const bf16x8*)(bp + (size_t)(32 * g + 4 * n) * K + k0);
#pragma unroll
        for (int m = 0; m < 4; ++m)
#pragma unroll
            for (int g = 0; g < 2; ++g)
#pragma unroll
                for (int n = 0; n < 2; ++n) acc[m][g][n] = __builtin_amdgcn_mfma_f32_16x16x32_bf16(bfr[g][n], af[m], acc[m][g][n], 0, 0, 0);
    }
    LAS float* P = (LAS float*)lds + wid * 4096;
#pragma unroll
    for (int m = 0; m < 4; ++m)
#pragma unroll
        for (int g = 0; g < 2; ++g)
#pragma unroll
            for (int n = 0; n < 2; ++n) *(LAS f32x4*)(P + (16 * m + fr) * 64 + 32 * g + 8 * fq + 4 * n) = acc[m][g][n];
    __syncthreads();
    { const int r = tid >> 3, c8 = (tid & 7) * 8; f32x4 v0 = (f32x4){0.f, 0.f, 0.f, 0.f}, v1 = v0;
#pragma unroll
      for (int w = 0; w < 8; ++w) { const LAS float* q = (const LAS float*)lds + w * 4096 + r * 64 + c8; v0 += *(const LAS f32x4*)q; v1 += *(const LAS f32x4*)(q + 4); }
      if (!MASK || (row_abs0 + r >= u.lo && row_abs0 + r < u.hi)) E.store8(u, row_abs0 + r, col_abs0 + c8, v0, v1); }
    __syncthreads();
}

template <bool GATHER, class Epi, class Sched>
__device__ __forceinline__ void run_gemm(LAS unsigned char* lds, int K, const Sched& S, const Epi& E) {
#if FAST_GEMM
    pg8::gemm_phase<Epi, Sched, GATHER>(lds, K, S, E);
#else
    gemm_naive<Epi, Sched>(lds, K, S, E);
    __syncthreads();
#endif
}

struct Args { const float* in[N_IN]; float* out; unsigned char* ws; int ph_lo, ph_hi; };
struct Frame { LAS unsigned char* lds; int tid, lane, wave, vcu, G; };

__device__ __forceinline__ void attn_naive(const Frame& F, const bf16* Q, const bf16* Kb, const bf16* Vb, bf16* ON, const float* subln, const float* lamv, bool with_ctx) {
    LAS float* Qs = (LAS float*)F.lds;
    LAS float* Ks = Qs + 16 * 128;
    LAS float* Vs = Ks + 2 * 64 * 65;
    LAS float* Ps = Vs + 64 * 128;
    const int tid = F.tid, qi = tid >> 5, sl = tid & 31;
    const float lam = lamv[0], oscale = lamv[1];
    const int n_lat = NB * NH * (SEQ / 16), n_ctx = with_ctx ? NB * NH * (CTXL / 16) : 0;
    for (int unit = F.vcu; unit < n_lat + n_ctx; unit += F.G) {
        int b, h, t0, nkeys;
        if (unit < n_lat) { b = unit / (NH * (SEQ / 16)); const int r = unit % (NH * (SEQ / 16)); h = r / (SEQ / 16); t0 = CTXL + (r % (SEQ / 16)) * 16; nkeys = TK; }
        else { const int uu = unit - n_lat; b = uu / (NH * (CTXL / 16)); const int r = uu % (NH * (CTXL / 16)); h = r / (CTXL / 16); t0 = (r % (CTXL / 16)) * 16; nkeys = CTXL; }
        __syncthreads();
        for (int idx = tid; idx < 16 * 128; idx += 512) { const int q = idx >> 7, cd = idx & 127, c = cd >> 6, d = cd & 63;
            Qs[idx] = __uint_as_float((unsigned)Q[(size_t)(((b * NH + h) * 2 + c) * TK + t0 + q) * 64 + d] << 16); }
        float o0[4] = {0, 0, 0, 0}, o1[4] = {0, 0, 0, 0}, l0 = 0.f, l1 = 0.f;
        for (int k0 = 0; k0 < nkeys; k0 += 64) {
            __syncthreads();
            for (int idx = tid; idx < 2 * 64 * 64; idx += 512) { const int c = idx >> 12, key = (idx >> 6) & 63, d = idx & 63;
                Ks[(c * 64 + key) * 65 + d] = __uint_as_float((unsigned)Kb[(size_t)(((b * NH + h) * 2 + c) * TK + k0 + key) * 64 + d] << 16); }
            for (int idx = tid; idx < 64 * 128; idx += 512) { const int key = idx >> 7, dv = idx & 127;
                Vs[idx] = __uint_as_float((unsigned)Vb[(size_t)((b * NH + h) * TK + k0 + key) * 128 + dv] << 16); }
            __syncthreads();
#pragma unroll
            for (int c = 0; c < 2; ++c)
#pragma unroll
                for (int kk = 0; kk < 2; ++kk) { const int key = sl + 32 * kk; float s = 0.f;
                    for (int d = 0; d < 64; ++d) s += Qs[qi * 128 + c * 64 + d] * Ks[(c * 64 + key) * 65 + d];
                    Ps[(c * 16 + qi) * 64 + key] = __builtin_amdgcn_exp2f(s); }
            __syncthreads();
            for (int key = 0; key < 64; ++key) { const float p0 = Ps[qi * 64 + key], p1 = Ps[(16 + qi) * 64 + key]; const f32x4 v = *(const LAS f32x4*)(Vs + key * 128 + sl * 4);
                l0 += p0; l1 += p1;
#pragma unroll
                for (int j = 0; j < 4; ++j) { o0[j] += p0 * v[j]; o1[j] += p1 * v[j]; } }
        }
        const float i0 = 1.f / l0, i1 = lam / l1; float o[4], ss = 0.f;
#pragma unroll
        for (int j = 0; j < 4; ++j) { o[j] = o0[j] * i0 - o1[j] * i1; ss += o[j] * o[j]; }
#pragma unroll
        for (int m = 1; m < 32; m <<= 1) ss += __shfl_xor(ss, m);
        const float rinv = 1.f / sqrtf(ss * (1.f / 128.f) + EPS) * oscale;
        const int t = t0 + qi, row = t >= CTXL ? b * SEQ + (t - CTXL) : RL + b * CTXL + t;
        const f32x4 g = *(const f32x4*)(subln + sl * 4);
        v2u w; w.x = cvt_pk_bf16(o[0] * rinv * g[0], o[1] * rinv * g[1]); w.y = cvt_pk_bf16(o[2] * rinv * g[2], o[3] * rinv * g[3]);
        *(v2u*)(ON + (size_t)row * 1024 + h * 128 + sl * 4) = w;
    }
    __syncthreads();
}


namespace att {
#define SBAR() __builtin_amdgcn_sched_barrier(0)
constexpr int STAGE = 32768, ST_K1 = 8192, ST_V = 16384, OFF_WS = 3 * STAGE;
__device__ __forceinline__ int crow(int r, int hi) { return (r & 3) + 8 * (r >> 2) + 4 * hi; }
__device__ __forceinline__ int v_st(int k, int c) { const int kk = (k & ~0xC) | ((k & 4) << 1) | ((k & 8) >> 1); return ((kk >> 3) * 4 + (c >> 5)) * 512 + ((kk & 7) * 32 + (c & 31)) * 2; }
__device__ __forceinline__ int v_rd_base(int lane) { return ((lane & 3) << 3) | (((lane >> 2) & 3) << 6) | (((lane >> 4) & 1) << 5) | (((lane >> 5) & 1) << 8); }
constexpr int v_rd_off(int d0, int ks, int half) { return d0 * 512 + ks * 4096 + half * 2048; }
template <int OFF> __device__ __forceinline__ s16x4 tr_read(int vb) { s16x4 r; asm volatile("ds_read_b64_tr_b16 %0, %1 offset:%2" : "=&v"(r) : "v"(vb), "i"(OFF) : "memory"); return r; }
template <int D0> __device__ __forceinline__ void pv_one(f32x16& od, int vb, bf16x8 pa0, bf16x8 pa1, bf16x8 pa2, bf16x8 pa3) {
    const s16x4 l0 = tr_read<v_rd_off(D0, 0, 0)>(vb), h0 = tr_read<v_rd_off(D0, 0, 1)>(vb), l1 = tr_read<v_rd_off(D0, 1, 0)>(vb), h1 = tr_read<v_rd_off(D0, 1, 1)>(vb);
    const s16x4 l2 = tr_read<v_rd_off(D0, 2, 0)>(vb), h2 = tr_read<v_rd_off(D0, 2, 1)>(vb), l3 = tr_read<v_rd_off(D0, 3, 0)>(vb), h3 = tr_read<v_rd_off(D0, 3, 1)>(vb);
    asm volatile("s_waitcnt lgkmcnt(0)" ::: "memory"); SBAR();
#define ATT_PK(L, H) (bf16x8){L[0], L[1], L[2], L[3], H[0], H[1], H[2], H[3]}
    od = __builtin_amdgcn_mfma_f32_32x32x16_bf16(pa0, ATT_PK(l0, h0), od, 0, 0, 0);
    od = __builtin_amdgcn_mfma_f32_32x32x16_bf16(pa1, ATT_PK(l1, h1), od, 0, 0, 0);
    od = __builtin_amdgcn_mfma_f32_32x32x16_bf16(pa2, ATT_PK(l2, h2), od, 0, 0, 0);
    od = __builtin_amdgcn_mfma_f32_32x32x16_bf16(pa3, ATT_PK(l3, h3), od, 0, 0, 0);
#undef ATT_PK
}
template <int VAR> __device__ __forceinline__ void pv_d0(f32x16 (&o)[4], int vb, bf16x8 pa0, bf16x8 pa1, bf16x8 pa2, bf16x8 pa3) {
    if (VAR == 2) { asm volatile("" :: "v"(pa0), "v"(pa1), "v"(pa2), "v"(pa3)); return; }
    pv_one<0>(o[0], vb, pa0, pa1, pa2, pa3); pv_one<1>(o[1], vb, pa0, pa1, pa2, pa3); pv_one<2>(o[2], vb, pa0, pa1, pa2, pa3); pv_one<3>(o[3], vb, pa0, pa1, pa2, pa3);
}
#define ATT_PK4(P, BASE, OUT) do { unsigned a0 = cvt_pk_bf16(P[BASE + 0], P[BASE + 1]), a1 = cvt_pk_bf16(P[BASE + 2], P[BASE + 3]); \
    unsigned b0 = cvt_pk_bf16(P[BASE + 4], P[BASE + 5]), b1 = cvt_pk_bf16(P[BASE + 6], P[BASE + 7]); \
    auto r0 = __builtin_amdgcn_permlane32_swap(a0, b0, false, false); auto r1 = __builtin_amdgcn_permlane32_swap(a1, b1, false, false); \
    v4u w = {r0[0], r1[0], r0[1], r1[1]}; OUT = *reinterpret_cast<bf16x8*>(&w); } while (0)
template <int VAR> __device__ __forceinline__ void half_a(f32x16& p, float& ps, bf16x8& pa0, bf16x8& pa1) {
    if (VAR != 1) {
#pragma unroll
    for (int r = 0; r < 16; ++r) p[r] = __builtin_amdgcn_exp2f(p[r]); }
    float s = 0.f;
#pragma unroll
    for (int r = 0; r < 16; ++r) s += p[r];
    ps = s;
    ATT_PK4(p, 0, pa0); ATT_PK4(p, 8, pa1);
}
template <int VAR> __device__ __forceinline__ void half_b(f32x16& p, float ps, float& l_reg, bf16x8& pa2, bf16x8& pa3) {
    if (VAR != 1) {
#pragma unroll
    for (int r = 0; r < 16; ++r) p[r] = __builtin_amdgcn_exp2f(p[r]); }
#pragma unroll
    for (int r = 0; r < 16; ++r) ps += p[r];
    { auto rr = __builtin_amdgcn_permlane32_swap(__float_as_uint(ps), __float_as_uint(ps), false, false); ps = __uint_as_float(rr[0]) + __uint_as_float(rr[1]); }
    l_reg += ps;
    ATT_PK4(p, 0, pa2); ATT_PK4(p, 8, pa3);
}
__device__ __forceinline__ void qkt(f32x16& p0, f32x16& p1, const LAS unsigned char* Ks, const bf16x8 (&qr)[4], int r32, int hi) {
    p0 = f32x16{}; p1 = f32x16{};
    const int swz = (r32 >> 1) & 7;
#pragma unroll
    for (int d0 = 0; d0 < 4; ++d0) { const int off = r32 * 128 + (((d0 * 2 + hi) ^ swz) << 4);
        const bf16x8 b0 = *(const LAS bf16x8*)(Ks + off), b1 = *(const LAS bf16x8*)(Ks + 4096 + off);
        p0 = __builtin_amdgcn_mfma_f32_32x32x16_bf16(b0, qr[d0], p0, 0, 0, 0);
        p1 = __builtin_amdgcn_mfma_f32_32x32x16_bf16(b1, qr[d0], p1, 0, 0, 0); }
}
}

template <int VAR>
__device__ __forceinline__ void attn_fast(const Frame& F, const bf16* Q, const bf16* Kb, const bf16* Vb, bf16* ON, const float* subln, const float* lamv, bool with_ctx) {
    using namespace att;
    LAS unsigned char* lds = F.lds;
    const int tid = F.tid, wid = F.wave, lane = F.lane, r32 = lane & 31, hi = lane >> 5, comp = wid >> 2, wq = wid & 3;
    LAS float* li_l = (LAS float*)(lds + OFF_WS) + wid * 64;
    const int sr = tid >> 4, sc = (tid & 15) * 8, vst0 = v_st(sr, sc);
    const int krow = tid >> 3, kst = krow * 128 + (((tid & 7) ^ ((krow >> 1) & 7)) << 4);
    const int vb0 = (int)(uintptr_t)(lds + ST_V) + v_rd_base(lane);
    const unsigned koffb = (unsigned)tid * 16u, voffb = (unsigned)(sr * 128 + sc) * 2u;
    const LAS unsigned char* Kl = lds + comp * ST_K1;
    const float lam = lamv[0], oscale = lamv[1];
    const int n_lat = NB * NH * (SEQ / 128), n_ctx = with_ctx ? NB * NH * (CTXL / 128) : 0;
    for (int unit = F.vcu; unit < n_lat + n_ctx; unit += F.G) {
        int b, h, t0, NT;
        if (unit < n_lat) { const int bh = unit >> 5; b = bh >> 3; h = bh & 7; t0 = CTXL + (unit & 31) * 128; NT = TK / 64; }
        else { const int uu = unit - n_lat, bh = uu >> 1; b = bh >> 3; h = bh & 7; t0 = (uu & 1) * 128; NT = CTXL / 64; }
        const char* K0u = (const char*)(Kb + (size_t)((b * NH + h) * 2) * TK * 64); const char* K1u = K0u + (size_t)TK * 128;
        const char* V0u = (const char*)(Vb + (size_t)(b * NH + h) * TK * 128); const char* V1u = V0u + 32 * 256;
        bf16x8 qr[4];
        { const bf16* Qw = Q + ((size_t)((b * NH + h) * 2 + comp) * TK + t0 + wq * 32 + r32) * 64 + hi * 8;
#pragma unroll
          for (int d0 = 0; d0 < 4; ++d0) qr[d0] = *(const bf16x8*)(Qw + d0 * 16); }
        float l_reg = 0.f; f32x16 o[4] = {};
        struct { bf16x8 vs0, vs1, ks0, ks1; } st_[2];
#define ATT_SLOAD(i, k0) do { st_[i].vs0 = *(const bf16x8*)(V0u + (size_t)(k0) * 256 + voffb); st_[i].vs1 = *(const bf16x8*)(V1u + (size_t)(k0) * 256 + voffb); \
        st_[i].ks0 = *(const bf16x8*)(K0u + (size_t)(k0) * 128 + koffb); st_[i].ks1 = *(const bf16x8*)(K1u + (size_t)(k0) * 128 + koffb); } while (0)
#define ATT_SWRITE(so, i) do { *(LAS bf16x8*)(lds + (so) + ST_V + vst0) = st_[i].vs0; *(LAS bf16x8*)(lds + (so) + ST_V + 8192 + vst0) = st_[i].vs1; \
        *(LAS bf16x8*)(lds + (so) + kst) = st_[i].ks0; *(LAS bf16x8*)(lds + (so) + ST_K1 + kst) = st_[i].ks1; } while (0)
        f32x16 pA0, pA1, pB0, pB1; bf16x8 pa0, pa1, pa2, pa3; float ps;
#define ATT_ITER(c0, c1, n0, n1, WS, LS) do { \
        SBAR(); qkt(n0, n1, Kl + sN, qr, r32, hi); half_b<VAR>(c1, ps, l_reg, pa2, pa3); SBAR(); \
        if (j + 3 < NT) ATT_SLOAD(LS, (j + 3) * 64); SBAR(); \
        pv_d0<VAR>(o, vb0 + sC, pa0, pa1, pa2, pa3); half_a<VAR>(n0, ps, pa0, pa1); \
        if (j + 2 < NT) { if (j + 3 < NT) asm volatile("s_waitcnt vmcnt(4)" ::: "memory"); else asm volatile("s_waitcnt vmcnt(0)" ::: "memory"); ATT_SWRITE(sW, WS); } \
        __syncthreads(); { const int t_ = sC; sC = sN; sN = sW; sW = t_; } ++j; } while (0)
        int sC = 0, sN = STAGE, sW = 2 * STAGE, j = 0;
        ATT_SLOAD(0, 0); ATT_SLOAD(1, 64); asm volatile("s_waitcnt vmcnt(0)" ::: "memory"); ATT_SWRITE(0, 0); ATT_SWRITE(STAGE, 1);
        ATT_SLOAD(0, 128); __syncthreads();
        qkt(pA0, pA1, Kl, qr, r32, hi); half_a<VAR>(pA0, ps, pa0, pa1);
        while (j + 2 < NT) {
            ATT_ITER(pA0, pA1, pB0, pB1, 0, 1);
            ATT_ITER(pB0, pB1, pA0, pA1, 1, 0);
        }
        ATT_ITER(pA0, pA1, pB0, pB1, 0, 1);
        half_b<VAR>(pB1, ps, l_reg, pa2, pa3); SBAR();
        pv_d0<VAR>(o, vb0 + sC, pa0, pa1, pa2, pa3);
#undef ATT_ITER
#undef ATT_SLOAD
#undef ATT_SWRITE
        if (hi == 0) li_l[r32] = l_reg;
        __syncthreads();
        float rli[16];
#pragma unroll
        for (int r = 0; r < 16; ++r) rli[r] = __builtin_amdgcn_rcpf(li_l[crow(r, hi)]);
        LAS float* X = (LAS float*)lds;
        if (comp == 1) {
#pragma unroll
            for (int r = 0; r < 16; ++r) { const int row = wq * 32 + crow(r, hi); const float sc1 = rli[r] * lam;
#pragma unroll
                for (int d0 = 0; d0 < 4; ++d0) X[row * 128 + d0 * 32 + r32] = o[d0][r] * sc1; }
        }
        __syncthreads();
        if (comp == 0) {
            float ss[16];
#pragma unroll
            for (int r = 0; r < 16; ++r) { const int row = wq * 32 + crow(r, hi); float s = 0.f;
#pragma unroll
                for (int d0 = 0; d0 < 4; ++d0) { const float v = o[d0][r] * rli[r] - X[row * 128 + d0 * 32 + r32]; o[d0][r] = v; s += v * v; }
                ss[r] = s; }
#pragma unroll
            for (int r = 0; r < 16; ++r) {
#pragma unroll
                for (int m = 1; m < 32; m <<= 1) ss[r] += __shfl_xor(ss[r], m); }
            float g[4];
#pragma unroll
            for (int d0 = 0; d0 < 4; ++d0) g[d0] = subln[d0 * 32 + r32] * oscale;
#pragma unroll
            for (int r = 0; r < 16; ++r) { const float rinv = 1.f / sqrtf(ss[r] * (1.f / 128.f) + EPS);
                const int t = t0 + wq * 32 + crow(r, hi), row = t >= CTXL ? b * SEQ + (t - CTXL) : RL + b * CTXL + t;
                bf16* op = ON + (size_t)row * 1024 + h * 128 + r32;
#pragma unroll
                for (int d0 = 0; d0 < 4; ++d0) if (VAR == 0 || lam == 12345.f) op[d0 * 32] = (bf16)(cvt_pk_bf16(o[d0][r] * rinv * g[d0], 0.f) & 0xffffu); }
        }
        __syncthreads();
    }
}


namespace a16 {
__device__ __forceinline__ int off_a(int row, int ch) { return 2048 * (row >> 3) + 512 * (ch >> 2) + 64 * (row & 7) + 16 * ((ch & 3) ^ ((row >> 2) & 3)); }
__device__ __forceinline__ int fK(int key) { return ((key >> 1) & 1) | (((key >> 3) & 1) << 1) | (((key >> 4) & 1) << 2); }
__device__ __forceinline__ void qkt16(f32x4 (&S)[2][2][2], const LAS unsigned char* Kt, int kb0, int kb1, const bf16x8 (&qf)[2][2]) {
#pragma unroll
    for (int ks2 = 0; ks2 < 2; ++ks2) {
        if (ks2) SBAR();
#pragma unroll
        for (int u = 0; u < 2; ++u) {
            const bf16x8 k0 = *(const LAS bf16x8*)(Kt + kb0 + 4096 * ks2 + 512 * u), k1 = *(const LAS bf16x8*)(Kt + kb1 + 4096 * ks2 + 512 * u);
#pragma unroll
            for (int qb = 0; qb < 2; ++qb) { f32x4 acc = (f32x4){0.f, 0.f, 0.f, 0.f};
                acc = __builtin_amdgcn_mfma_f32_16x16x32_bf16(k0, qf[qb][0], acc, 0, 0, 0); S[ks2][u][qb] = __builtin_amdgcn_mfma_f32_16x16x32_bf16(k1, qf[qb][1], acc, 0, 0, 0); }
        }
    }
}
__device__ __forceinline__ void half16(f32x4 (&Sh)[2][2], float (&ls)[2], bf16x8 (&pf)[2]) {
#pragma unroll
    for (int qb = 0; qb < 2; ++qb) {
#pragma unroll
        for (int u = 0; u < 2; ++u)
#pragma unroll
            for (int r = 0; r < 4; ++r) Sh[u][qb][r] = __builtin_amdgcn_exp2f(Sh[u][qb][r]);
        ls[qb] += ((Sh[0][qb][0] + Sh[0][qb][1]) + (Sh[0][qb][2] + Sh[0][qb][3])) + ((Sh[1][qb][0] + Sh[1][qb][1]) + (Sh[1][qb][2] + Sh[1][qb][3]));
        v4u w; w.x = cvt_pk_bf16(Sh[0][qb][0], Sh[0][qb][1]); w.y = cvt_pk_bf16(Sh[0][qb][2], Sh[0][qb][3]); w.z = cvt_pk_bf16(Sh[1][qb][0], Sh[1][qb][1]); w.w = cvt_pk_bf16(Sh[1][qb][2], Sh[1][qb][3]);
        pf[qb] = *reinterpret_cast<bf16x8*>(&w); }
}
template <int CP, bool PVSYNC = false> __device__ __forceinline__ void pv16(f32x4 (&O)[8][2], int vb00, int vb01, int vb10, int vb11, const bf16x8 (&pf)[2][2]) {
#define tr_read16(OFF, vb) __builtin_amdgcn_ds_read_tr16_b64_v4i16((LAS s16x4*)((LAS unsigned char*)(uintptr_t)(unsigned)(vb) + (OFF)))
    const s16x4 a0 = tr_read16(512 * CP, vb00), a1 = tr_read16(512 * CP, vb01), a2 = tr_read16(8192 + 512 * CP, vb00), a3 = tr_read16(8192 + 512 * CP, vb01);
    const s16x4 b0 = tr_read16(512 * CP, vb10), b1 = tr_read16(512 * CP, vb11), b2 = tr_read16(8192 + 512 * CP, vb10), b3 = tr_read16(8192 + 512 * CP, vb11);
    if (PVSYNC) { asm volatile("s_waitcnt lgkmcnt(0)" ::: "memory"); SBAR(); }
#define A16_PK(L, H) (bf16x8){L[0], L[1], L[2], L[3], H[0], H[1], H[2], H[3]}
    const bf16x8 ve0 = A16_PK(a0, a1), ve1 = A16_PK(a2, a3), vo0 = A16_PK(b0, b1), vo1 = A16_PK(b2, b3);
#pragma unroll
    for (int qb = 0; qb < 2; ++qb) {
        O[2 * CP][qb] = __builtin_amdgcn_mfma_f32_16x16x32_bf16(ve0, pf[0][qb], O[2 * CP][qb], 0, 0, 0);
        O[2 * CP + 1][qb] = __builtin_amdgcn_mfma_f32_16x16x32_bf16(vo0, pf[0][qb], O[2 * CP + 1][qb], 0, 0, 0);
        O[2 * CP][qb] = __builtin_amdgcn_mfma_f32_16x16x32_bf16(ve1, pf[1][qb], O[2 * CP][qb], 0, 0, 0);
        O[2 * CP + 1][qb] = __builtin_amdgcn_mfma_f32_16x16x32_bf16(vo1, pf[1][qb], O[2 * CP + 1][qb], 0, 0, 0); }
#undef A16_PK
#undef tr_read16
}
}

__device__ __forceinline__ void attn16(const Frame& F, const bf16* Q, const bf16* Kb, const bf16* Vb, bf16* ON, const float* subln, const float* lamv, bool with_ctx) {
    using namespace att; using namespace a16;
    LAS unsigned char* lds = F.lds;
    const int tid = F.tid, wid = F.wave, lane = F.lane, l15 = lane & 15, g = lane >> 4, comp = wid >> 2, wq = wid & 3;
    const int vrl = 8 * (tid >> 7) + ((tid >> 2) & 7);
    const unsigned ksrc = (unsigned)((tid >> 3) * 128 + (((tid & 7) ^ fK(tid >> 3)) << 4));
    const unsigned vsrc = (unsigned)(vrl * 256 + (((((tid >> 5) & 3) << 2) | ((tid & 3) ^ ((vrl >> 2) & 3))) << 4));
    const unsigned ldsw = (unsigned)__builtin_amdgcn_readfirstlane(wid) * 1024u;
    const int ki = 8 * (l15 >> 2) + (l15 & 3), kf = fK(ki);
    const int kb0 = ki * 128 + (((0 + g) ^ kf) << 4), kb1 = ki * 128 + (((4 + g) ^ kf) << 4);
    const int tq = l15 >> 2, tp = lane & 3;
    const int vr0 = (int)(uintptr_t)(lds + ST_V);
    int v00 = vr0 + off_a(8 * g + tq, 0 + (tp >> 1)) + 8 * (tp & 1), v01 = vr0 + off_a(8 * g + 4 + tq, 0 + (tp >> 1)) + 8 * (tp & 1);
    int v10 = vr0 + off_a(8 * g + tq, 2 + (tp >> 1)) + 8 * (tp & 1), v11 = vr0 + off_a(8 * g + 4 + tq, 2 + (tp >> 1)) + 8 * (tp & 1);
    const LAS unsigned char* Kl = lds + comp * ST_K1;
    const float lam = lamv[0], oscale = lamv[1];
    const int n_lat = NB * NH * (SEQ / 128), n_ctx = with_ctx ? NB * NH * (CTXL / 128) : 0;
    for (int unit = F.vcu; unit < n_lat + n_ctx; unit += F.G) {
        int b, h, t0, NT;
        if (unit < n_lat) { const int bh = unit >> 5; b = bh >> 3; h = bh & 7; t0 = CTXL + (unit & 31) * 128; NT = TK / 64; }
        else { const int uu = unit - n_lat, bh = uu >> 1; b = bh >> 3; h = bh & 7; t0 = (uu & 1) * 128; NT = CTXL / 64; }
        const char* K0u = (const char*)(Kb + (size_t)((b * NH + h) * 2) * TK * 64); const char* K1u = K0u + (size_t)TK * 128;
        const char* V0u = (const char*)(Vb + (size_t)(b * NH + h) * TK * 128); const char* V1u = V0u + 32 * 256;
        bf16x8 qf[2][2];
        { const bf16* Qw = Q + ((size_t)((b * NH + h) * 2 + comp) * TK + t0 + wq * 32 + l15) * 64 + 8 * g;
#pragma unroll
          for (int qb = 0; qb < 2; ++qb)
#pragma unroll
              for (int sdim = 0; sdim < 2; ++sdim) qf[qb][sdim] = *(const bf16x8*)(Qw + (size_t)qb * 16 * 64 + 32 * sdim); }
        f32x4 O[8][2];
#pragma unroll
        for (int c = 0; c < 8; ++c) { O[c][0] = (f32x4){0.f, 0.f, 0.f, 0.f}; O[c][1] = (f32x4){0.f, 0.f, 0.f, 0.f}; }
        float ls[2] = {0.f, 0.f};
#define A16_DMA1(gp, voff, ldsa) asm volatile("s_mov_b32 m0, %2\n\ts_nop 0\n\tglobal_load_lds_dwordx4 %0, %1" :: "v"(voff), "s"(gp), "s"(ldsa) : "memory", "m0")
#define A16_DMA(so, k0) do { const unsigned la_ = (unsigned)(uintptr_t)(lds + (so)) + ldsw; \
        A16_DMA1(K0u + (size_t)(k0) * 128, ksrc, la_); A16_DMA1(K1u + (size_t)(k0) * 128, ksrc, la_ + ST_K1); \
        A16_DMA1(V0u + (size_t)(k0) * 256, vsrc, la_ + ST_V); A16_DMA1(V1u + (size_t)(k0) * 256, vsrc, la_ + ST_V + 8192); } while (0)
        f32x4 SA[2][2][2], SB[2][2][2]; bf16x8 pf[2][2], pf2[2];
#define A16_ITER(SC, SNX) do { \
        if (j + 2 < NT) A16_DMA(sW, (j + 2) * 64); \
        SBAR(); qkt16(SNX, Kl + sN, kb0, kb1, qf); half16(SC[1], ls, pf[1]); SBAR(); \
        asm volatile("" : "+v"(SNX[0][0][0]), "+v"(SNX[0][0][1]), "+v"(SNX[0][1][0]), "+v"(SNX[0][1][1]));     \
        pv16<0>(O, v00, v01, v10, v11, pf); pv16<1>(O, v00, v01, v10, v11, pf); \
        pv16<2>(O, v00, v01, v10, v11, pf); pv16<3>(O, v00, v01, v10, v11, pf); \
        half16(SNX[0], ls, pf2); pf[0][0] = pf2[0]; pf[0][1] = pf2[1]; \
        asm volatile("s_waitcnt vmcnt(0)" ::: "memory"); \
        __syncthreads(); { const int d_ = sN - sC; v00 += d_; v01 += d_; v10 += d_; v11 += d_; const int t_ = sC; sC = sN; sN = sW; sW = t_; } ++j; } while (0)
        int sC = 0, sN = STAGE, sW = 2 * STAGE, j = 0;
        A16_DMA(0, 0); A16_DMA(STAGE, 64);
        asm volatile("s_waitcnt vmcnt(0)" ::: "memory"); __syncthreads();
        qkt16(SA, Kl, kb0, kb1, qf); half16(SA[0], ls, pf[0]);
        while (j + 2 < NT) { A16_ITER(SA, SB); A16_ITER(SB, SA); }
        A16_ITER(SA, SB);
        half16(SB[1], ls, pf[1]); SBAR();
        pv16<0>(O, v00, v01, v10, v11, pf); pv16<1>(O, v00, v01, v10, v11, pf);
        pv16<2>(O, v00, v01, v10, v11, pf); pv16<3>(O, v00, v01, v10, v11, pf);
        v00 -= sC; v01 -= sC; v10 -= sC; v11 -= sC;
#undef A16_ITER
#undef A16_DMA
#undef A16_DMA1
#pragma unroll
        for (int qb = 0; qb < 2; ++qb) { ls[qb] += __shfl_xor(ls[qb], 16); ls[qb] += __shfl_xor(ls[qb], 32); }
        __syncthreads();
        LAS float* X = (LAS float*)lds;
        if (comp == 1) {
#pragma unroll
            for (int qb = 0; qb < 2; ++qb) { const float sc1 = lam * __builtin_amdgcn_rcpf(ls[qb]); LAS float* xr = X + (wq * 32 + qb * 16 + l15) * 128 + 4 * g;
#pragma unroll
                for (int c = 0; c < 8; ++c) *(LAS f32x4*)(xr + 16 * c) = O[c][qb] * sc1; }
        }
        __syncthreads();
        if (comp == 0) {
#pragma unroll
            for (int qb = 0; qb < 2; ++qb) { const float i0 = __builtin_amdgcn_rcpf(ls[qb]); const LAS float* xr = X + (wq * 32 + qb * 16 + l15) * 128 + 4 * g; float sq = 0.f;
#pragma unroll
                for (int c = 0; c < 8; ++c) { const f32x4 v = O[c][qb] * i0 - *(const LAS f32x4*)(xr + 16 * c); O[c][qb] = v; sq += (v[0] * v[0] + v[1] * v[1]) + (v[2] * v[2] + v[3] * v[3]); }
                sq += __shfl_xor(sq, 16); sq += __shfl_xor(sq, 32);
                const float rinv = 1.f / sqrtf(sq * (1.f / 128.f) + EPS) * oscale;
                const int t = t0 + wq * 32 + qb * 16 + l15, row = t >= CTXL ? b * SEQ + (t - CTXL) : RL + b * CTXL + t;
                bf16* op = ON + (size_t)row * 1024 + h * 128 + 4 * g;
#pragma unroll
                for (int c = 0; c < 8; ++c) { const f32x4 gg = *(const f32x4*)(subln + 16 * c + 4 * g); const f32x4 y = O[c][qb] * rinv * gg;
                    v2u w; w.x = cvt_pk_bf16(y[0], y[1]); w.y = cvt_pk_bf16(y[2], y[3]); *(v2u*)(op + 16 * c) = w; } }
        }
        __syncthreads();
    }
}

__device__ __forceinline__ void cvt_item(const float* s0, const float* s1, int srcN, int mode, int K, int N, bf16* dst, int item, LAS float* scr, int lane) {
    const int nblk = N / 64, kb = item / nblk, nb = item % nblk, k0 = 64 * kb, n0 = 64 * nb;
    const int v = n0 + lane; const float* sp = s0; int c = v;
    if (mode == 1) { const int kind = (v >> 2) & 1, ch = ((v >> 3) << 2) | (v & 3); sp = kind ? s1 : s0; c = ch; }
    else if (mode == 2) { if (v >= 3072 && v < 5120) { const int vv = v - 3072, kind = (vv >> 2) & 1, ch = ((vv >> 3) << 2) | (vv & 3); c = 3072 + kind * 1024 + ch; }
        else if (v < 2048) c = qk_src_col(v); }
    sp += (size_t)k0 * srcN + c;
#pragma unroll 16
    for (int kk = 0; kk < 64; ++kk) scr[kk * 64 + (lane ^ (((kk >> 3) & 7) << 2))] = sp[(size_t)kk * srcN];
    LDS_WAIT(); asm volatile("" ::: "memory");
    const int c8 = lane & 7, sw = c8 << 2;
#pragma unroll
    for (int j = 0; j < 8; ++j) { const int n = (lane >> 3) + 8 * j; const LAS float* q = scr + (8 * c8) * 64 + (n ^ sw);
        v4u o; o.x = cvt_pk_bf16(q[0 * 64], q[1 * 64]); o.y = cvt_pk_bf16(q[2 * 64], q[3 * 64]); o.z = cvt_pk_bf16(q[4 * 64], q[5 * 64]); o.w = cvt_pk_bf16(q[6 * 64], q[7 * 64]);
        *(v4u*)(dst + (size_t)(n0 + n) * K + k0 + 8 * c8) = o; }
    LDS_WAIT(); asm volatile("" ::: "memory");
}

__device__ __forceinline__ void phase_prologue(const Frame& F, const Args& a) {
    unsigned char* ws = a.ws;
    {
        LAS float* sv = (LAS float*)F.lds; LAS float* part = sv + 5 * 1024;
        for (int idx = F.tid; idx < 5 * 1024; idx += 512) { const int v = idx >> 10, k = idx & 1023; const float x = v < 4 ? a.in[I_C][v * 1024 + k] : a.in[I_CCTX][k]; sv[idx] = x * sigm(x); }
        __syncthreads();
        float* MOD = (float*)(ws + WS_MOD);
        for (int unit = F.vcu; unit < 192; unit += F.G) {
            const int l = unit / 96, n0 = (unit % 96) * 64; const float* W = a.in[I_WMOD] + (size_t)l * 1024 * 6144 + n0 + F.lane;
            float acc[5] = {0, 0, 0, 0, 0};
#pragma unroll 16
            for (int k = F.wave * 128; k < F.wave * 128 + 128; ++k) { const float wv = W[(size_t)k * 6144];
#pragma unroll
                for (int v = 0; v < 5; ++v) acc[v] += sv[v * 1024 + k] * wv; }
#pragma unroll
            for (int v = 0; v < 5; ++v) part[(F.wave * 5 + v) * 64 + F.lane] = acc[v];
            __syncthreads();
            if (F.tid < 320) { const int v = F.tid >> 6, ln = F.tid & 63; float s = a.in[I_BMOD][l * 6144 + n0 + ln];
#pragma unroll
                for (int w = 0; w < 8; ++w) s += part[(w * 5 + v) * 64 + ln];
                MOD[(size_t)(l * 5 + v) * 6144 + n0 + ln] = s; }
            __syncthreads();
        }
    }
    if (F.vcu == F.G - 1) {
        float* ROPE = (float*)(ws + WS_ROPE); float* LAMV = (float*)(ws + WS_LAM);
        for (int idx = F.tid; idx < 1024; idx += 512) { const int pos = idx >> 4, i = idx & 15; const float inv = __builtin_amdgcn_exp2f(-(float)(2 * i) * (13.287712379549449f / 32.f)), ang = (float)pos * inv; const float kq = rintf(ang * 0.15915494309189535f); float rr = fmaf(-kq, 6.2831854820251465f, ang); rr = fmaf(-kq, -1.7484555e-7f, rr); ROPE[idx] = __cosf(rr); ROPE[1024 + idx] = __sinf(rr); }
        if (F.tid < 2) { const int l = F.tid; float s1 = 0.f, s2 = 0.f;
            for (int d = 0; d < 64; ++d) { s1 += a.in[I_LQ1][l * 64 + d] * a.in[I_LK1][l * 64 + d]; s2 += a.in[I_LQ2][l * 64 + d] * a.in[I_LK2][l * 64 + d]; }
            const float lam_init = l == 0 ? 0.2f : 0.35550906759f; LAMV[l * 2 + 0] = __expf(s1) - __expf(s2) + lam_init; LAMV[l * 2 + 1] = 1.f - lam_init; }
    }
    {
        LAS float* scr = (LAS float*)(F.lds + F.wave * 16384);
        const int gw = F.vcu * 8 + F.wave, NGW = F.G * 8;
        constexpr int I_IN = 16 * 112, I_SQ = 16 * 16, I_GU0 = 16 * 88, I_D0 = 44 * 16, I_EGU = 16 * 112, I_ED = 56 * 16;
        constexpr int NITEMS = 2 * I_IN + 6 * I_SQ + I_GU0 + I_D0 + 8 * I_EGU + 8 * I_ED;
        for (int it = gw; it < NITEMS; it += NGW) {
            int r = it;
            if (r < 2 * I_IN) { const int l = r / I_IN; cvt_item(a.in[I_WIN] + (size_t)l * 1024 * INW, nullptr, INW, 2, 1024, INW, (bf16*)(ws + WS_WIN) + (size_t)l * INW * 1024, r % I_IN, scr, F.lane); continue; } r -= 2 * I_IN;
            if (r < 6 * I_SQ) { const int m = r / I_SQ, l = m / 3, w = m % 3; const float* src = a.in[w == 0 ? I_WATTNO : (w == 1 ? I_WCONVO : I_WOUT)] + (size_t)l * 1024 * 1024;
                bf16* dst = (bf16*)(ws + (w == 0 ? WS_WA : (w == 1 ? WS_WC : WS_WO)) + (size_t)l * 6 * MiB); cvt_item(src, nullptr, 1024, 0, 1024, 1024, dst, r % I_SQ, scr, F.lane); continue; } r -= 6 * I_SQ;
            if (r < I_GU0) { cvt_item(a.in[I_WFFG], a.in[I_WFFU], DFF, 1, 1024, 2 * DFF, (bf16*)(ws + WS_WGU0), r, scr, F.lane); continue; } r -= I_GU0;
            if (r < I_D0) { cvt_item(a.in[I_WFFD], nullptr, 1024, 0, DFF, 1024, (bf16*)(ws + WS_WD0), r, scr, F.lane); continue; } r -= I_D0;
            if (r < 8 * I_EGU) { const int e = r / I_EGU; cvt_item(a.in[I_WEG] + (size_t)e * 1024 * DFE, a.in[I_WEU] + (size_t)e * 1024 * DFE, DFE, 1, 1024, 2 * DFE, (bf16*)(ws + WS_WEGU) + (size_t)e * 2 * DFE * 1024, r % I_EGU, scr, F.lane); continue; } r -= 8 * I_EGU;
            { const int e = r / I_ED; cvt_item(a.in[I_WED] + (size_t)e * DFE * 1024, nullptr, 1024, 0, DFE, 1024, (bf16*)(ws + WS_WED) + (size_t)e * 1024 * DFE, r % I_ED, scr, F.lane); }
        }
    }
}

__device__ __forceinline__ void phase_rmsmod(const Frame& F, const float* src_lat, const float* src_ctx, int nrows, const float* g, const float* modl, int shift_idx, bf16* H) {
    const int gw = F.vcu * 8 + F.wave, NGW = F.G * 8;
    for (int row = gw; row < nrows; row += 2 * NGW) {
        const int row2 = row + NGW; const bool has2 = row2 < nrows;
        const float* srcA = row < RL ? src_lat + (size_t)row * 1024 : src_ctx + (size_t)(row - RL) * 1024;
        const float* srcB = has2 ? (row2 < RL ? src_lat + (size_t)row2 * 1024 : src_ctx + (size_t)(row2 - RL) * 1024) : srcA;
        f32x4 va[4], vb[4]; float sa = 0.f, sb = 0.f;
#pragma unroll
        for (int j = 0; j < 4; ++j) { va[j] = *(const f32x4*)(srcA + 4 * (F.lane + 64 * j)); vb[j] = *(const f32x4*)(srcB + 4 * (F.lane + 64 * j)); }
#pragma unroll
        for (int j = 0; j < 4; ++j) { sa += (va[j][0] * va[j][0] + va[j][1] * va[j][1]) + (va[j][2] * va[j][2] + va[j][3] * va[j][3]); sb += (vb[j][0] * vb[j][0] + vb[j][1] * vb[j][1]) + (vb[j][2] * vb[j][2] + vb[j][3] * vb[j][3]); }
        const float ra = 1.f / sqrtf(wave_sum(sa) * (1.f / 1024.f) + EPS), rb = 1.f / sqrtf(wave_sum(sb) * (1.f / 1024.f) + EPS);
        const float* shA = modl + row_mi(row) * 6144 + shift_idx * 1024; const float* shB = modl + row_mi(has2 ? row2 : row) * 6144 + shift_idx * 1024;
#pragma unroll
        for (int j = 0; j < 4; ++j) { const int col = 4 * (F.lane + 64 * j); const f32x4 gg = *(const f32x4*)(g + col);
            { const f32x4 s4 = *(const f32x4*)(shA + 1024 + col), h4 = *(const f32x4*)(shA + col); const f32x4 y = va[j] * ra * gg * (1.f + s4) + h4;
              v2u w; w.x = cvt_pk_bf16(y[0], y[1]); w.y = cvt_pk_bf16(y[2], y[3]); *(v2u*)(H + (size_t)row * 1024 + col) = w; }
            if (has2) { const f32x4 s4 = *(const f32x4*)(shB + 1024 + col), h4 = *(const f32x4*)(shB + col); const f32x4 y = vb[j] * rb * gg * (1.f + s4) + h4;
              v2u w; w.x = cvt_pk_bf16(y[0], y[1]); w.y = cvt_pk_bf16(y[2], y[3]); *(v2u*)(H + (size_t)row2 * 1024 + col) = w; } }
    }
}

__device__ __forceinline__ void phase_qknorm(const Frame& F, bf16* Q, bf16* Kb, const float* qg, const float* kg, const float* rope, int mode) {
    constexpr int HALFV = NB * NH * 2 * TK;
    const int total = mode ? NB * NH * 2 * CTXL : 2 * HALFV;
    const int j8 = F.tid & 7;
    for (int vec = (F.vcu * 512 + F.tid) >> 3; vec < total; vec += F.G * 64) {
        const bool isK = mode ? true : (vec >= HALFV); const int vv = mode ? (vec >> 8) * TK + (vec & 255) : (isK ? vec - HALFV : vec), t = vv % TK;
        bf16* p = (isK ? Kb : Q) + (size_t)vv * 64 + j8 * 8;
        f32x4 x0, x1; unpack8(*(const v4u*)p, x0, x1);
        float ss = (x0[0] * x0[0] + x0[1] * x0[1]) + (x0[2] * x0[2] + x0[3] * x0[3]) + (x1[0] * x1[0] + x1[1] * x1[1]) + (x1[2] * x1[2] + x1[3] * x1[3]);
        ss += __shfl_xor(ss, 1); ss += __shfl_xor(ss, 2); ss += __shfl_xor(ss, 4);
        const float rinv = 1.f / sqrtf(ss * (1.f / 64.f) + EPS);
        const float* gp = (isK ? kg : qg) + j8 * 8; const f32x4 g0 = *(const f32x4*)gp, g1 = *(const f32x4*)(gp + 4);
        f32x4 y0 = x0 * rinv * g0, y1 = x1 * rinv * g1;
        f32x4 p0, p1;
#pragma unroll
        for (int e = 0; e < 4; ++e) { p0[e] = __shfl_xor(y0[e], 2); p1[e] = __shfl_xor(y1[e], 2); }
        if (t >= CTXL) {
            const int s = t - CTXL, pos = (j8 >> 2) ? (s & 63) : (s >> 6), i0 = (j8 & 1) * 8; const float sgn = ((j8 >> 1) & 1) ? 1.f : -1.f;
            const float* cp = rope + pos * 16 + i0; const float* sp = cp + 1024;
            const f32x4 c0 = *(const f32x4*)cp, c1 = *(const f32x4*)(cp + 4), s0 = *(const f32x4*)sp, s1 = *(const f32x4*)(sp + 4);
            y0 = y0 * c0 + p0 * s0 * sgn; y1 = y1 * c1 + p1 * s1 * sgn;
        }
        if (!isK) { y0 = y0 * QSCALE; y1 = y1 * QSCALE; }
        *(v4u*)p = pack8(y0, y1);
    }
}

__device__ __forceinline__ void phase_conv(const Frame& F, const bf16* U0, bf16* U1, const float* dww, const float* dwb, const float* lng, const float* lnb, int nrows) {
    constexpr int RPU = 8, NIN = RPU + CK - 1;
    LAS float* red = (LAS float*)F.lds;
    const int half = F.tid >> 8, t8 = F.tid & 255, ch = 4 * t8, wv = F.wave & 3;
    const f32x4 bias = *(const f32x4*)(dwb + ch), g4 = *(const f32x4*)(lng + ch), b4 = *(const f32x4*)(lnb + ch);
    const int nunits = nrows / RPU;
    for (int u0 = F.vcu * 2; u0 < nunits; u0 += F.G * 2) {
        asm volatile("" ::: "memory");
        const int r0 = (u0 + half) * RPU;
        int seg_lo, seg_hi; if (r0 < RL) { seg_lo = r0 & ~4095; seg_hi = seg_lo + 4096; } else { seg_lo = RL + ((r0 - RL) & ~255); seg_hi = seg_lo + 256; }
        v2u xp[NIN];
#pragma unroll
        for (int i = 0; i < NIN; ++i) { const int rr = r0 - 15 + i; xp[i] = (rr >= seg_lo && rr < seg_hi) ? *(const v2u*)(U0 + (size_t)rr * 1024 + ch) : (v2u){0u, 0u}; }
        f32x4 acc[RPU];
#pragma unroll
        for (int r = 0; r < RPU; ++r) acc[r] = bias;
#pragma unroll
        for (int j = 0; j < CK; ++j) { const f32x4 wj = *(const f32x4*)(dww + j * 1024 + ch);
#pragma unroll
            for (int r = 0; r < RPU; ++r) { const v2u x = xp[r + j]; acc[r] += wj * (f32x4){bflo(x.x), bfhi(x.x), bflo(x.y), bfhi(x.y)}; } }
        float sv[RPU];
#pragma unroll
        for (int r = 0; r < RPU; ++r) sv[r] = wave_sum((acc[r][0] + acc[r][1]) + (acc[r][2] + acc[r][3]));
        __syncthreads();
        if (F.lane < RPU) { float v = sv[0];
#pragma unroll
            for (int r = 1; r < RPU; ++r) v = (F.lane == r) ? sv[r] : v;
            red[(half * 4 + wv) * RPU + F.lane] = v; }
        __syncthreads();
        float mean[RPU];
#pragma unroll
        for (int r = 0; r < RPU; ++r) mean[r] = ((red[(half * 4 + 0) * RPU + r] + red[(half * 4 + 1) * RPU + r]) + (red[(half * 4 + 2) * RPU + r] + red[(half * 4 + 3) * RPU + r])) * (1.f / 1024.f);
#pragma unroll
        for (int r = 0; r < RPU; ++r) { acc[r] = acc[r] - mean[r]; sv[r] = wave_sum((acc[r][0] * acc[r][0] + acc[r][1] * acc[r][1]) + (acc[r][2] * acc[r][2] + acc[r][3] * acc[r][3])); }
        if (F.lane < RPU) { float v = sv[0];
#pragma unroll
            for (int r = 1; r < RPU; ++r) v = (F.lane == r) ? sv[r] : v;
            red[128 + (half * 4 + wv) * RPU + F.lane] = v; }
        __syncthreads();
#pragma unroll
        for (int r = 0; r < RPU; ++r) { const float q = (red[128 + (half * 4 + 0) * RPU + r] + red[128 + (half * 4 + 1) * RPU + r]) + (red[128 + (half * 4 + 2) * RPU + r] + red[128 + (half * 4 + 3) * RPU + r]);
            const float rstd = 1.f / sqrtf(q * (1.f / 1024.f) + EPS);
            const f32x4 y = acc[r] * rstd * g4 + b4; v2u w; w.x = cvt_pk_bf16(y[0] * sigm(y[0]), y[1] * sigm(y[1])); w.y = cvt_pk_bf16(y[2] * sigm(y[2]), y[3] * sigm(y[3]));
            *(v2u*)(U1 + (size_t)(r0 + r) * 1024 + ch) = w; }
    }
    __syncthreads();
}

__device__ __forceinline__ void phase_router(const Frame& F, const float* x1, const float* g, const float* modl, const float* wr, bf16* H2, unsigned* BC, unsigned* TOK) {
    const int TPB = (RL + F.G - 1) / F.G, tbase = F.vcu * TPB;
    LAS int* le = (LAS int*)F.lds;
    for (int tl = F.wave; tl < TPB; tl += 8) {
        const int row = tbase + tl;
        if (row >= RL) { if (F.lane == 0) { le[tl * 2] = -1; le[tl * 2 + 1] = -1; } continue; }
        const float* src = x1 + (size_t)row * 1024;
        f32x4 v[4]; float ss = 0.f;
#pragma unroll
        for (int j = 0; j < 4; ++j) { v[j] = *(const f32x4*)(src + 4 * (F.lane + 64 * j)); ss += (v[j][0] * v[j][0] + v[j][1] * v[j][1]) + (v[j][2] * v[j][2] + v[j][3] * v[j][3]); }
        const float rinv = 1.f / sqrtf(wave_sum(ss) * (1.f / 1024.f) + EPS);
        const float* sh = modl + (row >> 12) * 6144 + 3 * 1024; const float* sc = sh + 1024;
        float lg[8] = {0, 0, 0, 0, 0, 0, 0, 0};
#pragma unroll
        for (int j = 0; j < 4; ++j) { const int col = 4 * (F.lane + 64 * j); const f32x4 gg = *(const f32x4*)(g + col), s4 = *(const f32x4*)(sc + col), h4 = *(const f32x4*)(sh + col);
            const f32x4 y = v[j] * rinv * gg * (1.f + s4) + h4; v2u w; w.x = cvt_pk_bf16(y[0], y[1]); w.y = cvt_pk_bf16(y[2], y[3]); *(v2u*)(H2 + (size_t)row * 1024 + col) = w;
#pragma unroll
            for (int e4 = 0; e4 < 4; ++e4) { const f32x4 wa = *(const f32x4*)(wr + (size_t)(col + e4) * 8), wb = *(const f32x4*)(wr + (size_t)(col + e4) * 8 + 4);
#pragma unroll
                for (int e = 0; e < 4; ++e) { lg[e] += y[e4] * wa[e]; lg[4 + e] += y[e4] * wb[e]; } } }
#pragma unroll
        for (int e = 0; e < 8; ++e) lg[e] = wave_sum(lg[e]);
        if (F.lane == 0) {
            int e0 = 0; float v0 = lg[0];
#pragma unroll
            for (int e = 1; e < 8; ++e) if (lg[e] > v0) { v0 = lg[e]; e0 = e; }
            int e1 = e0 == 0 ? 1 : 0; float v1 = lg[e1];
#pragma unroll
            for (int e = 0; e < 8; ++e) if (e != e0 && lg[e] > v1) { v1 = lg[e]; e1 = e; }
            const float w0 = 1.f / (1.f + __expf(v1 - v0)), w1 = 1.f - w0;
            unsigned* tk = TOK + (size_t)row * 8; tk[0] = (unsigned)e0; tk[1] = (unsigned)e1; tk[4] = __float_as_uint(w0); tk[5] = __float_as_uint(w1);
            le[tl * 2] = e0; le[tl * 2 + 1] = e1;
        }
    }
    __syncthreads();
    if (F.tid < 8) { unsigned c = 0; for (int tl = 0; tl < TPB; ++tl) c += (le[tl * 2] == F.tid) + (le[tl * 2 + 1] == F.tid); BC[F.vcu * 8 + F.tid] = c; }
    __syncthreads();
}
__device__ __forceinline__ void phase_moe_lists(const Frame& F, const unsigned* BC, unsigned* cnt, unsigned* TOK, int* slist) {
    const int TPB = (RL + F.G - 1) / F.G, tbase = F.vcu * TPB;
    LAS int* le = (LAS int*)F.lds; LAS unsigned* tot = (LAS unsigned*)(F.lds + 4096); LAS unsigned* pre = tot + 8;
    for (int i = F.tid; i < TPB * 2; i += 512) { const int row = tbase + (i >> 1); le[i] = row < RL ? (int)TOK[(size_t)row * 8 + (i & 1)] : -1; }
    LAS unsigned* bcl = pre + 8;
    for (int i = F.tid; i < F.G * 8; i += 512) bcl[i] = BC[i];
    __syncthreads();
    if (F.tid < 8) { unsigned t = 0, p = 0; for (int b = 0; b < F.G; ++b) { const unsigned c = bcl[b * 8 + F.tid]; t += c; p += (b < F.vcu) ? c : 0u; } tot[F.tid] = t; pre[F.tid] = p; }
    __syncthreads();
    if (F.tid < 8) {
        unsigned run = pre[F.tid]; for (int e = 0; e < F.tid; ++e) run += tot[e];
        if (F.vcu == 0) cnt[64 * F.tid] = tot[F.tid];
        for (int tl = 0; tl < TPB; ++tl) { const int row = tbase + tl;
            if (le[tl * 2] == F.tid) { TOK[(size_t)row * 8 + 6] = run; slist[run] = row; ++run; }
            if (le[tl * 2 + 1] == F.tid) { TOK[(size_t)row * 8 + 7] = run; slist[run] = row; ++run; } }
    }
    __syncthreads();
}
__device__ __forceinline__ int moe_build_table(const Frame& F, const unsigned* cnt, LAS int* tab) {
    LAS int* scan = tab + 4 * 160; LAS int* offl = scan + 132;
    if (F.tid == 0) { int o = 0; for (int e = 0; e < 8; ++e) { offl[e] = o; o += (int)__hip_atomic_load(cnt + 64 * e, __ATOMIC_RELAXED, __HIP_MEMORY_SCOPE_AGENT); } offl[8] = o; }
    __syncthreads();
    int nmine = 0;
    if (F.tid < 128) { const int base = F.tid * 256;
        for (int e = 0; e < 8; ++e) { const int lo = max(base, offl[e]), hi = min(base + 256, offl[e + 1]); if (lo < hi) ++nmine; }
        scan[F.tid] = nmine; }
    __syncthreads();
    if (F.tid == 0) { int o = 0; for (int t = 0; t < 128; ++t) { const int n = scan[t]; scan[t] = o; o += n; } scan[128] = o; }
    __syncthreads();
    if (F.tid < 128) { const int base = F.tid * 256; int o = scan[F.tid];
        for (int e = 0; e < 8; ++e) { const int lo = max(base, offl[e]), hi = min(base + 256, offl[e + 1]); if (lo < hi) { tab[o * 4 + 0] = F.tid; tab[o * 4 + 1] = e; tab[o * 4 + 2] = lo; tab[o * 4 + 3] = hi; ++o; } } }
    __syncthreads();
    return scan[128];
}
__device__ __forceinline__ void phase_moe_final(const Frame& F, float* out, const bf16* Ys, const unsigned* TOK, const float* gate5) {
    const int gw = F.vcu * 8 + F.wave, NGW = F.G * 8;
    for (int row = gw; row < RL; row += 2 * NGW) {
        const int row2 = (row + NGW < RL) ? row + NGW : row;
        const unsigned* tka = TOK + (size_t)row * 8; const unsigned* tkb = TOK + (size_t)row2 * 8;
        const float wa0 = __uint_as_float(tka[4]), wa1 = __uint_as_float(tka[5]), wb0 = __uint_as_float(tkb[4]), wb1 = __uint_as_float(tkb[5]);
        const size_t pa0 = tka[6], pa1 = tka[7], pb0 = tkb[6], pb1 = tkb[7];
        const float* ga = gate5 + (row >> 12) * 6144; const float* gb = gate5 + (row2 >> 12) * 6144;
        v2u ya0[4], ya1[4], yb0[4], yb1[4]; f32x4 xa[4], xb[4];
#pragma unroll
        for (int j = 0; j < 4; ++j) { const int col = 4 * (F.lane + 64 * j);
            ya0[j] = *(const v2u*)(Ys + pa0 * 1024 + col); ya1[j] = *(const v2u*)(Ys + pa1 * 1024 + col); yb0[j] = *(const v2u*)(Ys + pb0 * 1024 + col); yb1[j] = *(const v2u*)(Ys + pb1 * 1024 + col);
            xa[j] = *(const f32x4*)(out + (size_t)row * 1024 + col); xb[j] = *(const f32x4*)(out + (size_t)row2 * 1024 + col); }
#pragma unroll
        for (int j = 0; j < 4; ++j) { const int col = 4 * (F.lane + 64 * j); const f32x4 gga = *(const f32x4*)(ga + col), ggb = *(const f32x4*)(gb + col);
            f32x4 x = xa[j];
            x[0] += gga[0] * (wa0 * bflo(ya0[j].x) + wa1 * bflo(ya1[j].x)); x[1] += gga[1] * (wa0 * bfhi(ya0[j].x) + wa1 * bfhi(ya1[j].x)); x[2] += gga[2] * (wa0 * bflo(ya0[j].y) + wa1 * bflo(ya1[j].y)); x[3] += gga[3] * (wa0 * bfhi(ya0[j].y) + wa1 * bfhi(ya1[j].y));
            *(f32x4*)(out + (size_t)row * 1024 + col) = x;
            if (row2 != row) { f32x4 y = xb[j];
                y[0] += ggb[0] * (wb0 * bflo(yb0[j].x) + wb1 * bflo(yb1[j].x)); y[1] += ggb[1] * (wb0 * bfhi(yb0[j].x) + wb1 * bfhi(yb1[j].x)); y[2] += ggb[2] * (wb0 * bflo(yb0[j].y) + wb1 * bflo(yb1[j].y)); y[3] += ggb[3] * (wb0 * bfhi(yb0[j].y) + wb1 * bfhi(yb1[j].y));
                *(f32x4*)(out + (size_t)row2 * 1024 + col) = y; } }
    }
}

#ifndef REP_MASK
#define REP_MASK 0u
#endif
#define REP(j) (1 + ((REP_MASK >> (j)) & 1u))
#ifndef PH_MASK
#define PH_MASK 0xffffffffu
#endif
#define IN(k) (lo <= (k) && (k) < hi)
#define ON(j) ((PH_MASK >> (j)) & 1u)
#define SEAM(k) do { if (IN(k) && IN((k) + 1)) xcd_barrier(bar); } while (0)
template <int l>
__device__ __forceinline__ void layer_body(const Frame& F, const Args& a, const XcdBarrier& bar, unsigned char* ws, unsigned* ctl, const int lo, const int hi) {
    const int G = F.G, cb = (int)blockIdx.x;
    const float* MOD = (const float*)(ws + WS_MOD);
    bf16* A0 = (bf16*)(ws + WS_A0); bf16* A1 = (bf16*)(ws + WS_A1); bf16* A2 = (bf16*)(ws + WS_A2); bf16* A3 = (bf16*)(ws + WS_A3); bf16* A4 = (bf16*)(ws + WS_A4); bf16* A5 = (bf16*)(ws + WS_A5);
    float* XB = (float*)(ws + WS_XB);
    {
        const int pb = 1 + l * 9;
        const float* modl = MOD + (size_t)l * 5 * 6144;
        const float* xs_lat = l == 0 ? a.in[I_X] : XB; const float* xs_ctx = l == 0 ? a.in[I_CTX] : XB + (size_t)RL * 1024;
        if (ON(1) && IN(pb + 0)) for (int rep_ = 0; rep_ < (int)REP(1); ++rep_) phase_rmsmod(F, xs_lat, xs_ctx, R, a.in[I_GMIX] + l * 1024, modl, 0, A0);
        SEAM(pb + 0);
        if (ON(2) && IN(pb + 1)) {
            SchedPlain S{(const char*)A0, (const char*)(ws + WS_WIN + (size_t)l * 14 * MiB), (l == 0 ? R : RL) / 256, INW / 256, 1024, G, cb};
            EpiInProj E{A1, A2, A3, A4, A5, a.in[I_QG] + l * 64, a.in[I_KG] + l * 64, (const float*)(ws + WS_ROPE)};
            for (int rep_ = 0; rep_ < (int)REP(2); ++rep_) run_gemm<false>(F.lds, 1024, S, E);
            if (l == 1) {
                for (int t = F.vcu; t < 512; t += G) { const int tm = t >> 5, tn = t & 31; Unit u{};
                    gemm_small_tile(F.lds, A0 + (size_t)(RL + 64 * tm) * 1024, (const bf16*)(ws + WS_WIN + (size_t)14 * MiB) + (size_t)(1024 + 64 * tn) * 1024, 1024, RL + 64 * tm, 1024 + 64 * tn, u, E); }
            }
        }
        SEAM(pb + 1);
        if (ON(3) && IN(pb + 2)) {
#if FAST_GEMM
            if (l == 1) phase_qknorm(F, A1, A2, a.in[I_QG] + l * 64, a.in[I_KG] + l * 64, (const float*)(ws + WS_ROPE), 1);
#else
            phase_qknorm(F, A1, A2, a.in[I_QG] + l * 64, a.in[I_KG] + l * 64, (const float*)(ws + WS_ROPE), 0);
#endif
#ifndef SKIP_CONV
            for (int rep_ = 0; rep_ < (int)REP(3); ++rep_) phase_conv(F, A4, A0, a.in[I_DWW] + (size_t)l * CK * 1024, a.in[I_DWB] + l * 1024, a.in[I_CLNG] + l * 1024, a.in[I_CLNB] + l * 1024, l == 0 ? R : RL);
#endif
        }
        SEAM(pb + 2);
        if (ON(4) && IN(pb + 3)) {
#ifndef SKIP_ATTN
#if FAST_ATTN
#ifdef ATT_XVAR
            attn_fast<ATT_XVAR>(F, A1, A2, A3, A4, a.in[I_SUBLN] + l * 128, (const float*)(ws + WS_LAM) + l * 2, l == 0);
#endif
            attn16(F, A1, A2, A3, A4, a.in[I_SUBLN] + l * 128, (const float*)(ws + WS_LAM) + l * 2, l == 0);
#else
            attn_naive(F, A1, A2, A3, A4, a.in[I_SUBLN] + l * 128, (const float*)(ws + WS_LAM) + l * 2, l == 0);
#endif
#endif
        }
        SEAM(pb + 3);
        if (ON(5) && IN(pb + 4)) {
            SchedMerge S{(const char*)A4, (const char*)(ws + WS_WA + (size_t)l * 6 * MiB), (const char*)A0, (const char*)(ws + WS_WC + (size_t)l * 6 * MiB), RL / 256, 4, 1024, G, cb};
            EpiMerge E{A5, A2, A1};
            for (int rep_ = 0; rep_ < (int)REP(5); ++rep_) run_gemm<false>(F.lds, 1024, S, E);
            if (l == 0) {
                for (int t = F.vcu; t < 256; t += G) { const int tm = t >> 4, tn = t & 15; Unit u{};
                    u.aux = 0; gemm_small_tile(F.lds, A4 + (size_t)(RL + 64 * tm) * 1024, (const bf16*)(ws + WS_WA) + (size_t)(64 * tn) * 1024, 1024, RL + 64 * tm, 64 * tn, u, E);
                    u.aux = 1; gemm_small_tile(F.lds, A0 + (size_t)(RL + 64 * tm) * 1024, (const bf16*)(ws + WS_WC) + (size_t)(64 * tn) * 1024, 1024, RL + 64 * tm, 64 * tn, u, E); }
            }
        }
        SEAM(pb + 4);
        if (ON(6) && IN(pb + 5)) {
            SchedPlain S{(const char*)A1, (const char*)(ws + WS_WO + (size_t)l * 6 * MiB), RL / 256, 4, 1024, G, cb};
            EpiResid E{xs_lat, xs_ctx, l == 0 ? XB : a.out, modl + 2 * 1024};
            for (int rep_ = 0; rep_ < (int)REP(6); ++rep_) run_gemm<false>(F.lds, 1024, S, E);
            if (l == 0) { for (int t = F.vcu; t < 256; t += G) { const int tm = t >> 4, tn = t & 15; Unit u{};
                    gemm_small_tile(F.lds, A1 + (size_t)(RL + 64 * tm) * 1024, (const bf16*)(ws + WS_WO) + (size_t)(64 * tn) * 1024, 1024, RL + 64 * tm, 64 * tn, u, E); } }
        }
        SEAM(pb + 5);
        if (l == 0) {
            if (ON(7) && IN(pb + 6)) for (int rep_ = 0; rep_ < (int)REP(7); ++rep_) phase_rmsmod(F, XB, XB + (size_t)RL * 1024, R, a.in[I_GFFN], modl, 3, A0);
            SEAM(pb + 6);
            if (ON(8) && IN(pb + 7)) {
                SchedPlain S{(const char*)A0, (const char*)(ws + WS_WGU0), R / 256, 2 * DFF / 256, 1024, G, cb};
                EpiSwiglu E{A1, DFF};
                for (int rep_ = 0; rep_ < (int)REP(8); ++rep_) run_gemm<false>(F.lds, 1024, S, E);
            }
            SEAM(pb + 7);
            if (ON(9) && IN(pb + 8)) {
                SchedPlain S{(const char*)A1, (const char*)(ws + WS_WD0), RL / 256, 4, DFF, G, cb};
                EpiResid E{XB, XB + (size_t)RL * 1024, XB, modl + 5 * 1024};
                run_gemm<false>(F.lds, DFF, S, E);
                for (int t = F.vcu; t < 256; t += G) { const int tm = t >> 4, tn = t & 15; Unit u{};
                    gemm_small_tile(F.lds, A1 + (size_t)(RL + 64 * tm) * DFF, (const bf16*)(ws + WS_WD0) + (size_t)(64 * tn) * DFF, DFF, RL + 64 * tm, 64 * tn, u, E); }
            }
            SEAM(pb + 8);
        } else {
            unsigned* cnt = ctl + CW_CNT; unsigned* TOK = (unsigned*)(ws + WS_TOK); int* slist = (int*)(ws + WS_SLIST);
            LAS int* tab = (LAS int*)(F.lds + MOETAB_OFF);
#ifndef SKIP_ROUTER
            if (ON(16) && IN(16)) phase_router(F, a.out, a.in[I_GFFN] + 1024, modl, a.in[I_WR], A0, (unsigned*)(ws + WS_BC), TOK);
#endif
            SEAM(16);
            if (ON(17) && IN(17)) phase_moe_lists(F, (const unsigned*)(ws + WS_BC), cnt, TOK, slist);
            SEAM(17);
            if (ON(18) && IN(18)) {
                const int NU = moe_build_table(F, cnt, tab);
                SchedMoe S{(const char*)A0, (const char*)(ws + WS_WEGU), slist, tab, NU, 2 * DFE / 256, 1024, G, cb, (size_t)2 * DFE * 1024 * 2, 1, NU * (2 * DFE / 256)};
                EpiSwiglu E{A1, DFE};
                for (int rep_ = 0; rep_ < (int)REP(18); ++rep_) run_gemm<true>(F.lds, 1024, S, E);
            }
            SEAM(18);
            if (ON(19) && IN(19)) {
                const int NU = moe_build_table(F, cnt, tab);
                const int total = NU * 4; int whole = (total / G) * G, left = total - whole;
                if (left > 0) { whole = total; left = 0; }
                SchedMoe S{(const char*)A1, (const char*)(ws + WS_WED), slist, tab, NU, 4, DFE, G, cb, (size_t)1024 * DFE * 2, 0, whole};
                EpiBf16Plain E{(bf16*)XB, 1024};
                for (int rep_ = 0; rep_ < (int)REP(19); ++rep_) run_gemm<false>(F.lds, DFE, S, E);
                for (int sidx = F.vcu; sidx < left * 16; sidx += G) {
                    const int L = whole + (sidx >> 4), sm = (sidx >> 2) & 3, sn = sidx & 3; int pm, pn; tile_of(L, NU, 4, pm, pn);
                    Unit u{}; const int tile = tab[pm * 4 + 0], e = tab[pm * 4 + 1]; u.lo = tab[pm * 4 + 2]; u.hi = tab[pm * 4 + 3];
                    const int r0 = tile * 256 + 64 * sm;
                    if (r0 + 64 > u.lo && r0 < u.hi)
                        gemm_small_tile<true>(F.lds, A1 + (size_t)r0 * DFE, (const bf16*)(ws + WS_WED) + ((size_t)e * 1024 + pn * 256 + 64 * sn) * DFE, DFE, r0, pn * 256 + 64 * sn, u, E);
                }
            }
            SEAM(19);
            if (ON(20) && IN(20)) phase_moe_final(F, a.out, (const bf16*)XB, TOK, modl + 5 * 1024);
        }
        }
}

constexpr int N_PHASES = 21;
__global__ void __launch_bounds__(512, 2) fwd_kernel(Args a) {
    extern __shared__ __attribute__((aligned(16))) unsigned char lds_raw[];
    Frame F; F.lds = (LAS unsigned char*)lds_raw; F.tid = threadIdx.x; F.lane = F.tid & 63; F.wave = __builtin_amdgcn_readfirstlane(F.tid >> 6);
    F.G = gridDim.x; { const int bx = blockIdx.x; F.vcu = (F.G % 8 == 0) ? (bx % 8) * (F.G / 8) + bx / 8 : bx; }
    unsigned char* ws = a.ws;
    unsigned* ctl = (unsigned*)(ws + WS_CTL);
    for (int u = F.tid; u < (LDS_BYTES - LDSCTL_OFF) / 4; u += 512) ((LAS unsigned*)(F.lds + LDSCTL_OFF))[u] = 0u;
    __syncthreads();
    volatile LAS unsigned* MISC = (volatile LAS unsigned*)(F.lds + MISC_OFF);
    XcdBarrier bar = xcd_barrier_post(ctl + CW_BAR, MISC + 8);
    const int lo = a.ph_lo, hi = a.ph_hi;

    const int G = F.G, cb = (int)blockIdx.x;
    const float* MOD = (const float*)(ws + WS_MOD);
    bf16* A0 = (bf16*)(ws + WS_A0); bf16* A1 = (bf16*)(ws + WS_A1); bf16* A2 = (bf16*)(ws + WS_A2); bf16* A3 = (bf16*)(ws + WS_A3); bf16* A4 = (bf16*)(ws + WS_A4); bf16* A5 = (bf16*)(ws + WS_A5);
    float* XB = (float*)(ws + WS_XB);

    #ifndef SKIP_PRO
    if (ON(0) && IN(0)) { for (int rep_ = 0; rep_ < (int)REP(0); ++rep_) phase_prologue(F, a); }
#endif
    SEAM(0);

    layer_body<0>(F, a, bar, ws, ctl, lo, hi);
    layer_body<1>(F, a, bar, ws, ctl, lo, hi);
#undef IN
#undef SEAM
}

extern "C" void kernel_launch(void* const* d_in, const int* in_sizes, int n_in, void* d_out, int out_size, void* d_ws, size_t ws_size, hipStream_t stream) {
    static int grid = 0;
    if (grid == 0) {
        if (n_in != N_IN || out_size != RL * D || ws_size < WS_END) { fprintf(stderr, "kernel_launch: unexpected shapes (n_in %d out %d ws %zu)\n", n_in, out_size, ws_size); grid = -1; return; }
        int dev = 0, cus = 0, per_cu = 0;
        if (hipGetDevice(&dev) != hipSuccess || hipDeviceGetAttribute(&cus, hipDeviceAttributeMultiprocessorCount, dev) != hipSuccess) { grid = -1; return; }
        if (hipFuncSetAttribute((const void*)fwd_kernel, hipFuncAttributeMaxDynamicSharedMemorySize, LDS_BYTES) != hipSuccess) { fprintf(stderr, "kernel_launch: hipFuncSetAttribute failed\n"); grid = -1; return; }
        if (hipOccupancyMaxActiveBlocksPerMultiprocessor(&per_cu, (const void*)fwd_kernel, 512, LDS_BYTES) != hipSuccess || per_cu < 1) fprintf(stderr, "kernel_launch: occupancy query reports %d\n", per_cu);
        (void)hipGetLastError();
        grid = cus;
    }
    if (grid < 0) return;
    (void)hipMemsetAsync((char*)d_ws + WS_CTL, 0, CTL_ZERO_BYTES, stream);
    Args a{};
    for (int i = 0; i < N_IN; ++i) a.in[i] = (const float*)d_in[i];
    a.out = (float*)d_out; a.ws = (unsigned char*)d_ws; a.ph_lo = 0; a.ph_hi = N_PHASES;
    hipLaunchKernelGGL(fwd_kernel, dim3(grid), dim3(512), LDS_BYTES, stream, a);
}
```

```cpp
#include <hip/hip_runtime.h>
#include <cstdio>
#include <cstdint>

#ifndef FAST_GEMM
#define FAST_GEMM 1
#endif
#ifndef FAST_ATTN
#define FAST_ATTN 1
#define ATT_STAGGER 0
#endif

#define GAS __attribute__((address_space(1)))
#define LAS __attribute__((address_space(3)))
typedef unsigned short bf16;
typedef unsigned v4u __attribute__((ext_vector_type(4)));
typedef unsigned v2u __attribute__((ext_vector_type(2)));
typedef float f32x4 __attribute__((ext_vector_type(4)));
typedef float f32x2 __attribute__((ext_vector_type(2)));
typedef float f32x16 __attribute__((ext_vector_type(16)));
typedef short bf16x8 __attribute__((ext_vector_type(8)));
typedef short s16x4 __attribute__((ext_vector_type(4)));

constexpr int D = 1024, NB = 4, SEQ = 4096, CTXL = 256, TK = SEQ + CTXL, RL = NB * SEQ, RC = NB * CTXL, R = RL + RC;
constexpr int NH = 8, HD = 64, VD = 128, INW = 7168, DFF = 2816, NE = 8, DFE = 3584, CK = 31;
constexpr float EPS = 1e-6f;
constexpr float QSCALE = 0.125f * 1.4426950408889634f;
enum { I_X = 0, I_C, I_CTX, I_CCTX, I_WMOD, I_BMOD, I_GMIX, I_WIN, I_QG, I_KG, I_LQ1, I_LK1, I_LQ2, I_LK2, I_SUBLN, I_WATTNO, I_DWW, I_DWB, I_CLNG, I_CLNB, I_WCONVO, I_WOUT, I_GFFN,
       I_WFFG, I_WFFU, I_WFFD, I_WR, I_WEG, I_WEU, I_WED, N_IN };

constexpr size_t MiB = 1u << 20;
constexpr size_t WS_CTL = 0, CTL_ZERO_BYTES = 1 * MiB;
constexpr size_t WS_MOD = 1 * MiB;
constexpr size_t WS_ROPE = 1 * MiB + 256 * 1024;
constexpr size_t WS_LAM = 1 * MiB + 300 * 1024;
constexpr size_t WS_BC = 1 * MiB + 320 * 1024;
constexpr size_t WS_TOK = 2 * MiB;
constexpr size_t WS_SLIST = 2 * MiB + 512 * 1024;
constexpr size_t WS_WIN = 3 * MiB;
constexpr size_t WS_WA = 31 * MiB, WS_WC = 33 * MiB, WS_WO = 35 * MiB;
constexpr size_t WS_WGU0 = 43 * MiB, WS_WD0 = 54 * MiB;
constexpr size_t WS_WEGU = 60 * MiB, WS_WED = 172 * MiB;
constexpr size_t WS_XB = 228 * MiB;
constexpr size_t WS_A0 = 296 * MiB;
constexpr size_t WS_A1 = 330 * MiB;
constexpr size_t WS_A2 = 364 * MiB;
constexpr size_t WS_A3 = 398 * MiB;
constexpr size_t WS_A4 = 432 * MiB;
constexpr size_t WS_A5 = 466 * MiB;
constexpr size_t WS_END = 554 * MiB;
constexpr int CW_BAR = 4096;
constexpr int CW_CNT = 16384;

constexpr int RING_BYTES = 131072, LDSCTL_OFF = RING_BYTES, MISC_OFF = LDSCTL_OFF + 320, MOETAB_OFF = LDSCTL_OFF + 1024, LDS_BYTES = 147456;

#define LDS_WAIT() asm volatile("s_waitcnt lgkmcnt(0)" ::: "memory")
#define VM_WAIT() asm volatile("s_waitcnt vmcnt(0)" ::: "memory")
typedef float f32x2_t __attribute__((ext_vector_type(2)));
typedef __bf16 bf16x2_t __attribute__((ext_vector_type(2)));
__device__ __forceinline__ unsigned cvt_pk_bf16_pin(float lo, float hi) { unsigned r; asm volatile("v_cvt_pk_bf16_f32 %0, %1, %2" : "=v"(r) : "v"(lo), "v"(hi)); return r; }
__device__ __forceinline__ unsigned cvt_pk_bf16(float lo, float hi) { const f32x2_t v = {lo, hi}; const bf16x2_t b = __builtin_convertvector(v, bf16x2_t); return __builtin_bit_cast(unsigned, b); }
__device__ __forceinline__ float bflo(unsigned w) { return __uint_as_float(w << 16); }
__device__ __forceinline__ float bfhi(unsigned w) { return __uint_as_float(w & 0xffff0000u); }
__device__ __forceinline__ float sigm(float x) { return 1.f / (1.f + __expf(-x)); }
__device__ __forceinline__ float sigf(float x) { return __builtin_amdgcn_rcpf(1.f + __builtin_amdgcn_exp2f(x * -1.4426950408889634f)); }
__device__ __forceinline__ float wave_sum(float v) {
#pragma unroll
    for (int o = 1; o < 64; o <<= 1) v += __shfl_xor(v, o);
    return v;
}
__device__ __forceinline__ int row_mi(int row) { return row < RL ? (row >> 12) : 4; }
__device__ __forceinline__ int row_b(int row) { return row < RL ? (row >> 12) : ((row - RL) >> 8); }
__device__ __forceinline__ int row_t(int row) { return row < RL ? (CTXL + (row & 4095)) : ((row - RL) & 255); }

#define XB_TMO      128
#define XB_XCNT(j)  (256  + 64 * (j))
#define XB_XSUB(j)  (1280 + 64 * (j))
#define XB_XGEN(j)  (2304 + 64 * (j))
#define XB_TOP      3328
#define XB_TOPGEN   3392
#define XCD_BAR_WORDS 3456
#define XB_SPIN_CAP (1u << 22)
__device__ __forceinline__ unsigned xb_ld(unsigned* p)              { return __hip_atomic_load(p, __ATOMIC_RELAXED, __HIP_MEMORY_SCOPE_AGENT); }
__device__ __forceinline__ unsigned xb_add(unsigned* p, unsigned v) { return __hip_atomic_fetch_add(p, v, __ATOMIC_RELAXED, __HIP_MEMORY_SCOPE_AGENT); }
__device__ __forceinline__ unsigned xb_xcc_id() { return (unsigned)__builtin_amdgcn_s_getreg((3 << 11) | 20) & 0xFu; }
#define XB_SPIN(cond, bar) do { unsigned _sp = 0; while (cond) { __builtin_amdgcn_s_sleep(1); \
    if ((++_sp & 255u) == 0u) { if (xb_ld(&(bar)[XB_TMO])) break; if (_sp > XB_SPIN_CAP) { atomicAdd(&(bar)[XB_TMO], 1u); break; } } } } while (0)
struct XcdBarrier { unsigned* bar; unsigned x; volatile LAS unsigned* st; };
__device__ __forceinline__ XcdBarrier xcd_barrier_post(unsigned* bar, volatile LAS unsigned* st) {
    XcdBarrier b; b.bar = bar; b.x = xb_xcc_id(); b.st = st;
    if (threadIdx.x == 0) (void)xb_add(&bar[XB_XCNT(b.x)], 1u);
    return b;
}
__device__ __forceinline__ void xcd_barrier_complete(unsigned* bar, unsigned x, unsigned& nloc, unsigned& nx) {
    const unsigned G = gridDim.x * gridDim.y * gridDim.z;
    unsigned sum, cnt, mine, sp = 0u;
    for (;;) {
        sum = 0u; cnt = 0u; mine = 0u;
#pragma unroll
        for (unsigned j = 0; j < 16; ++j) { const unsigned c = xb_ld(&bar[XB_XCNT(j)]); sum += c; cnt += (c > 0u) ? 1u : 0u; mine = (j == x) ? c : mine; }
        if (sum == G) break;
        __builtin_amdgcn_s_sleep(1);
        if ((++sp & 255u) == 0u) { if (xb_ld(&bar[XB_TMO])) break; if (sp > XB_SPIN_CAP) { atomicAdd(&bar[XB_TMO], 1u); break; } }
    }
    nloc = mine > 0u ? mine : 1u; nx = cnt > 0u ? cnt : 1u;
}
__device__ __forceinline__ void xcd_barrier(const XcdBarrier& b) {
    asm volatile("s_waitcnt vmcnt(0)" ::: "memory");
    __syncthreads();
    if (threadIdx.x == 0) {
        unsigned* bar = b.bar;
        __builtin_amdgcn_s_waitcnt(0);
        unsigned nloc = b.st[0], nx = b.st[1];
        if (nloc == 0u) { xcd_barrier_complete(bar, b.x, nloc, nx); b.st[0] = nloc; b.st[1] = nx; }
        const unsigned old = xb_add(&bar[XB_XSUB(b.x)], 1u);
        const unsigned gen = old / nloc;
        if (old + 1u == (gen + 1u) * nloc) {
            __builtin_amdgcn_fence(__ATOMIC_RELEASE, "agent");
            asm volatile("s_waitcnt vmcnt(0)" ::: "memory");
            const unsigned og = xb_add(&bar[XB_TOP], 1u);
            const unsigned tg = og / nx;
            if (og + 1u == (tg + 1u) * nx) xb_add(&bar[XB_TOPGEN], 1u);
            else XB_SPIN(xb_ld(&bar[XB_TOPGEN]) == tg, bar);
            __builtin_amdgcn_fence(__ATOMIC_ACQUIRE, "agent");
            xb_add(&bar[XB_XGEN(b.x)], 1u);
            asm volatile("s_waitcnt vmcnt(0)" ::: "memory");
        } else {
            XB_SPIN(xb_ld(&bar[XB_XGEN(b.x)]) == gen, bar);
            __builtin_amdgcn_fence(__ATOMIC_ACQUIRE, "agent");
            asm volatile("s_waitcnt vmcnt(0)" ::: "memory");
        }
    }
    __syncthreads();
}

struct Unit { const char* A; const char* B; const int* rows; int row0, col0, lo, hi, aux; };

__device__ __forceinline__ void tile_of(int wgid, int nM, int nN, int& pm, int& pn) {
    const int nwg = nM * nN;
    { const int q = nwg / 8, r = nwg % 8, xcd = wgid % 8, off = wgid / 8; wgid = (xcd < r ? xcd * (q + 1) : r * (q + 1) + (xcd - r) * q) + off; }
    const int nig = 8 * nN, gid = wgid / nig, fm = gid * 8, gsz = (nM - fm) < 8 ? (nM - fm) : 8;
    pm = fm + ((wgid % nig) % gsz); pn = (wgid % nig) / gsz;
}
struct SchedPlain {
    const char* A; const char* Bt; int nM, nN, K, G, c;
    __device__ __forceinline__ bool next(int i, Unit& u) const {
        const int L = i * G + c; if (L >= nM * nN) return false;
        int pm, pn; tile_of(L, nM, nN, pm, pn);
        u.A = A + (size_t)pm * 256 * K * 2; u.B = Bt + (size_t)pn * 256 * K * 2; u.rows = nullptr; u.row0 = pm * 256; u.col0 = pn * 256; u.lo = 0; u.hi = 0x7fffffff; u.aux = 0; return true;
    }
};
struct SchedMerge {
    const char* A0; const char* B0; const char* A1; const char* B1; int nM, nN, K, G, c;
    __device__ __forceinline__ bool next(int i, Unit& u) const {
        const int L = (i >> 1) * G + c; if (L >= nM * nN) return false;
        int pm, pn; tile_of(L, nM, nN, pm, pn); const int pass = i & 1;
        u.A = (pass ? A1 : A0) + (size_t)pm * 256 * K * 2; u.B = (pass ? B1 : B0) + (size_t)pn * 256 * K * 2; u.rows = nullptr; u.row0 = pm * 256; u.col0 = pn * 256; u.lo = 0; u.hi = 0x7fffffff; u.aux = pass; return true;
    }
};
struct SchedMoe {
    const char* A; const char* Bt; const int* slist; const LAS int* tab; int NU, nN, K, G, c; size_t bstride; int gather; int Lmax;
    __device__ __forceinline__ bool next(int i, Unit& u) const {
        const int L = i * G + c; if (L >= Lmax) return false;
        int pm, pn; tile_of(L, NU, nN, pm, pn);
        const int tile = __builtin_amdgcn_readfirstlane(tab[pm * 4 + 0]), e = __builtin_amdgcn_readfirstlane(tab[pm * 4 + 1]);
        u.lo = __builtin_amdgcn_readfirstlane(tab[pm * 4 + 2]); u.hi = __builtin_amdgcn_readfirstlane(tab[pm * 4 + 3]);
        u.A = gather ? A : A + (size_t)tile * 256 * K * 2; u.rows = gather ? slist + tile * 256 : nullptr;
        u.B = Bt + (size_t)e * bstride + (size_t)pn * 256 * K * 2; u.row0 = tile * 256; u.col0 = pn * 256; u.aux = e; return true;
    }
};

__device__ __forceinline__ int qk_vec_of(int v) { return ((v >> 8) << 2) | ((v >> 5) & 3); }
__device__ __forceinline__ int qk_dim_of(int v) { const int j = v & 31; return (((v >> 7) & 1) << 5) | (((j >> 2) & 1) << 4) | ((j >> 3) << 2) | (j & 3); }
__device__ __forceinline__ int qk_src_col(int v) { return qk_vec_of(v) * 64 + qk_dim_of(v); }
__device__ __forceinline__ v4u pack8(f32x4 a, f32x4 b) { v4u w; w.x = cvt_pk_bf16(a[0], a[1]); w.y = cvt_pk_bf16(a[2], a[3]); w.z = cvt_pk_bf16(b[0], b[1]); w.w = cvt_pk_bf16(b[2], b[3]); return w; }
__device__ __forceinline__ void unpack8(v4u w, f32x4& a, f32x4& b) { a = (f32x4){bflo(w.x), bfhi(w.x), bflo(w.y), bfhi(w.y)}; b = (f32x4){bflo(w.z), bfhi(w.z), bflo(w.w), bfhi(w.w)}; }
struct EpiInProj {
    static constexpr bool ROW16 = true;
    bf16 *Q, *K, *V, *U0, *GT; const float *qg, *kg, *rope;
    __device__ __forceinline__ void store8(const Unit&, int row, int col, f32x4 v0, f32x4 v1) const {
        if (col < 3072) {
            const int b = row_b(row), t = row_t(row);
            if (col < 2048) {
                const int vec = qk_vec_of(col), d0 = qk_dim_of(col); bf16* base = (vec < 16 ? Q : K) + ((size_t)(((b * NH) * 2 + (vec & 15)) * TK + t) * 64 + d0);
                v2u w0, w1; w0.x = cvt_pk_bf16(v0[0], v0[1]); w0.y = cvt_pk_bf16(v0[2], v0[3]); w1.x = cvt_pk_bf16(v1[0], v1[1]); w1.y = cvt_pk_bf16(v1[2], v1[3]);
                *(v2u*)base = w0; *(v2u*)(base + 16) = w1; }
            else { const v4u w = pack8(v0, v1); const int cc = col - 2048, h = cc >> 7, dv = cc & 127; *(v4u*)(V + ((size_t)((b * NH + h) * TK + t) * 128 + dv)) = w; }
        } else if (col < 5120) {
            const int ch = (col - 3072) >> 1; v2u w; w.x = cvt_pk_bf16(v0[0] * sigf(v1[0]), v0[1] * sigf(v1[1])); w.y = cvt_pk_bf16(v0[2] * sigf(v1[2]), v0[3] * sigf(v1[3]));
            *(v2u*)(U0 + (size_t)row * 1024 + ch) = w;
        } else {
            f32x4 a, b;
#pragma unroll
            for (int j = 0; j < 4; ++j) { a[j] = sigf(v0[j]); b[j] = sigf(v1[j]); }
            *(v4u*)(GT + (size_t)row * 2048 + (col - 5120)) = pack8(a, b);
        }
    }
    __device__ __forceinline__ void store16(const Unit& u, int row, int col, f32x4 a0, f32x4 a1, f32x4 b0, f32x4 b1) const {
        if (col >= 2048) { store8(u, row, col, a0, a1); store8(u, row, col + 128, b0, b1); return; }
        const int b = row_b(row), t = row_t(row), vec = qk_vec_of(col), q4 = ((col & 31) >> 3) << 2;
        float ss = 0.f;
#pragma unroll
        for (int r = 0; r < 4; ++r) ss += (a0[r] * a0[r] + a1[r] * a1[r]) + (b0[r] * b0[r] + b1[r] * b1[r]);
        ss += __shfl_xor(ss, 16); ss += __shfl_xor(ss, 32);
        const float rinv = 1.f / sqrtf(ss * (1.f / 64.f) + EPS) * (vec < 16 ? QSCALE : 1.f);
        const float* g = (vec < 16 ? qg : kg) + q4;
        a0 = a0 * rinv * *(const f32x4*)g; a1 = a1 * rinv * *(const f32x4*)(g + 16); b0 = b0 * rinv * *(const f32x4*)(g + 32); b1 = b1 * rinv * *(const f32x4*)(g + 48);
        if (t >= CTXL) { const int sq = t - CTXL; const float* c0p = rope + (sq >> 6) * 16 + q4; const float* c1p = rope + (sq & 63) * 16 + q4;
            const f32x4 c0 = *(const f32x4*)c0p, s0 = *(const f32x4*)(c0p + 1024), c1 = *(const f32x4*)c1p, s1 = *(const f32x4*)(c1p + 1024);
            const f32x4 x0 = a0 * c0 - a1 * s0, x1 = a1 * c0 + a0 * s0, y0 = b0 * c1 - b1 * s1, y1 = b1 * c1 + b0 * s1; a0 = x0; a1 = x1; b0 = y0; b1 = y1; }
        bf16* base = (vec < 16 ? Q : K) + ((size_t)(((b * NH) * 2 + (vec & 15)) * TK + t) * 64 + q4);
        v2u w; w.x = cvt_pk_bf16(a0[0], a0[1]); w.y = cvt_pk_bf16(a0[2], a0[3]); *(v2u*)base = w;
        w.x = cvt_pk_bf16(a1[0], a1[1]); w.y = cvt_pk_bf16(a1[2], a1[3]); *(v2u*)(base + 16) = w;
        w.x = cvt_pk_bf16(b0[0], b0[1]); w.y = cvt_pk_bf16(b0[2], b0[3]); *(v2u*)(base + 32) = w;
        w.x = cvt_pk_bf16(b1[0], b1[1]); w.y = cvt_pk_bf16(b1[2], b1[3]); *(v2u*)(base + 48) = w;
    }
};
struct EpiMerge {
    static constexpr bool ROW16 = false;
    const bf16* GT; bf16* TF; bf16* M1;
    __device__ __forceinline__ void store8(const Unit& u, int row, int col, f32x4 v0, f32x4 v1) const {
        f32x4 g0, g1; unpack8(*(const v4u*)(GT + (size_t)row * 2048 + u.aux * 1024 + col), g0, g1);
        if (u.aux == 0) { *(v4u*)(TF + (size_t)row * 1024 + col) = pack8(g0 * v0, g1 * v1); }
        else { f32x4 t0, t1; unpack8(*(const v4u*)(TF + (size_t)row * 1024 + col), t0, t1); *(v4u*)(M1 + (size_t)row * 1024 + col) = pack8(t0 + g0 * v0, t1 + g1 * v1); }
    }
};
struct EpiResid {
    static constexpr bool ROW16 = false;
    const float* src_lat; const float* src_ctx; float* dst; const float* gate;
    __device__ __forceinline__ void store8(const Unit&, int row, int col, f32x4 v0, f32x4 v1) const {
        const float* s = (row < RL ? src_lat + (size_t)row * 1024 : src_ctx + (size_t)(row - RL) * 1024) + col; const float* g = gate + row_mi(row) * 6144 + col;
        const f32x4 s0 = *(const f32x4*)s, s1 = *(const f32x4*)(s + 4), g0 = *(const f32x4*)g, g1 = *(const f32x4*)(g + 4);
        float* d = dst + (size_t)row * 1024 + col; *(f32x4*)d = s0 + g0 * v0; *(f32x4*)(d + 4) = s1 + g1 * v1;
    }
};
struct EpiSwiglu {
    static constexpr bool ROW16 = false;
    bf16* ACT; int ld;
    __device__ __forceinline__ void store8(const Unit&, int row, int col, f32x4 v0, f32x4 v1) const {
        v2u w; w.x = cvt_pk_bf16(v0[0] * sigf(v0[0]) * v1[0], v0[1] * sigf(v0[1]) * v1[1]); w.y = cvt_pk_bf16(v0[2] * sigf(v0[2]) * v1[2], v0[3] * sigf(v0[3]) * v1[3]);
        *(v2u*)(ACT + (size_t)row * ld + (col >> 1)) = w;
    }
};
struct EpiBf16Plain { bf16* O; int ld;
    static constexpr bool ROW16 = false;
    __device__ __forceinline__ void store8(const Unit&, int row, int col, f32x4 v0, f32x4 v1) const { *(v4u*)(O + (size_t)row * ld + col) = pack8(v0, v1); }
};

template <class Epi, class Sched>
__device__ __forceinline__ void gemm_naive(LAS unsigned char* lds, const int K, const Sched& S, const Epi& E) {
    LAS float* As = (LAS float*)lds; LAS float* Bs = As + 32 * 132;
    const int tid = threadIdx.x, ty = tid >> 4, tx = tid & 15, lr = tid >> 2, kc = (tid & 3) * 8;
    Unit u;
    for (int i = 0; S.next(i, u); ++i) {
        for (int sub = 0; sub < 4; ++sub) {
            const int rm = (sub >> 1) * 128, cn = (sub & 1) * 128;
            const size_t arow = u.rows ? (size_t)u.rows[rm + lr] : (size_t)(rm + lr);
            const bf16* ap = (const bf16*)u.A + arow * K + kc; const bf16* bp = (const bf16*)u.B + (size_t)(cn + lr) * K + kc;
            float acc[4][8];
#pragma unroll
            for (int r = 0; r < 4; ++r)
#pragma unroll
                for (int c = 0; c < 8; ++c) acc[r][c] = 0.f;
            for (int k0 = 0; k0 < K; k0 += 32) {
                const v4u av = *(const v4u*)(ap + k0), bv = *(const v4u*)(bp + k0);
                f32x4 a0, a1, b0, b1; unpack8(av, a0, a1); unpack8(bv, b0, b1);
#pragma unroll
                for (int j = 0; j < 4; ++j) { As[(kc + j) * 132 + lr] = a0[j]; As[(kc + 4 + j) * 132 + lr] = a1[j]; Bs[(kc + j) * 132 + lr] = b0[j]; Bs[(kc + 4 + j) * 132 + lr] = b1[j]; }
                __syncthreads();
#pragma unroll 4
                for (int kk = 0; kk < 32; ++kk) {
                    const f32x4 a = *(const LAS f32x4*)(As + kk * 132 + ty * 4), p = *(const LAS f32x4*)(Bs + kk * 132 + tx * 8), q = *(const LAS f32x4*)(Bs + kk * 132 + tx * 8 + 4);
#pragma unroll
                    for (int r = 0; r < 4; ++r) {
#pragma unroll
                        for (int c = 0; c < 4; ++c) { acc[r][c] += a[r] * p[c]; acc[r][4 + c] += a[r] * q[c]; } }
                }
                __syncthreads();
            }
#pragma unroll
            for (int r = 0; r < 4; ++r) { const int row = u.row0 + rm + ty * 4 + r;
                if (row >= u.lo && row < u.hi) E.store8(u, row, u.col0 + cn + tx * 8, (f32x4){acc[r][0], acc[r][1], acc[r][2], acc[r][3]}, (f32x4){acc[r][4], acc[r][5], acc[r][6], acc[r][7]}); }
        }
    }
}

namespace pg8 {
constexpr int BM = 256, BK = 64, HALF = 128, HTB = HALF * BK * 2, STAGE_BYTES = 8 * HTB;
__device__ __forceinline__ int lds_byte(int r, int c) { const int st = (r >> 4) * 2 + (c >> 5), rr = r & 15, cc = c & 31, ob = rr * 64 + cc * 2; return st * 1024 + (ob ^ (((ob >> 9) & 1) << 5)); }
__device__ __forceinline__ void stage_rc(int b, int& R_, int& C_) { const int st = b / 1024, sb = b % 1024, swz = sb ^ (((sb >> 9) & 1) << 5); R_ = (st >> 1) * 16 + swz / 64; C_ = (st & 1) * 32 + (swz % 64) / 2; }
__device__ __forceinline__ int perm32(int rho) { const int n = rho >> 4, i = rho & 15; return 8 * (i >> 2) + 4 * n + (i & 3); }

template <class Epi, class Sched, bool GATHER>
__device__ __forceinline__ void gemm_phase(LAS unsigned char* lds, const int K, const Sched& S, const Epi& E) {
    const int tid = threadIdx.x, wid = __builtin_amdgcn_readfirstlane(tid >> 6), lane = tid & 63, wr = wid >> 2, wc = wid & 3, fr = lane & 15, fq = lane >> 4;
    const int nt = K / BK;
    int Rr[2], Cc[2]; unsigned voffB[2];
#pragma unroll
    for (int i = 0; i < 2; ++i) { stage_rc(tid * 16 + i * 8192, Rr[i], Cc[i]); const int Rb = (Rr[i] & ~31) + perm32(Rr[i] & 31); voffB[i] = (unsigned)(Rb * K + Cc[i]) * 2u; }
    const size_t kstep = (size_t)(BK * 2), hstep = (size_t)HALF * K * 2;
    const unsigned ldsw = (unsigned)wid * 1024u;
    const int aoff = lds_byte(wr * 64 + fr, fq * 8), boff = lds_byte(wc * 32 + fr, fq * 8);
#define PG8_SA(b, h) (((b) * 2 + (h)) * HTB)
#define PG8_SB(b, h) ((4 + (b) * 2 + (h)) * HTB)
#define PG8_STAGE2(bufoff, gbase, o0, o1) do { \
        __builtin_amdgcn_global_load_lds((const unsigned*)((const char*)(gbase) + (o0)), (LAS unsigned*)(lds + (bufoff) + ldsw), 16, 0, 0); \
        __builtin_amdgcn_global_load_lds((const unsigned*)((const char*)(gbase) + (o1)), (LAS unsigned*)(lds + (bufoff) + ldsw + 8192), 16, 0, 0); } while (0)
#define PG8_STAGEB(bufoff, gbase) PG8_STAGE2(bufoff, gbase, voffB[0], voffB[1])
#define PG8_LDA(dst, b, h) do { _Pragma("unroll") for (int m = 0; m < 4; ++m) _Pragma("unroll") for (int k = 0; k < 2; ++k) dst[m][k] = *(const LAS bf16x8*)(lds + PG8_SA(b, h) + aoff + m * 2048 + k * 1024); } while (0)
#define PG8_LDB(dst, b, h) do { _Pragma("unroll") for (int n = 0; n < 2; ++n) _Pragma("unroll") for (int k = 0; k < 2; ++k) dst[n][k] = *(const LAS bf16x8*)(lds + PG8_SB(b, h) + boff + n * 2048 + k * 1024); } while (0)
#define PG8_MMA(ai, bj, At, Bt) do { __builtin_amdgcn_s_setprio(1); _Pragma("unroll") for (int m = 0; m < 4; ++m) _Pragma("unroll") for (int n = 0; n < 2; ++n) _Pragma("unroll") for (int k = 0; k < 2; ++k) \
        acc[ai][bj][m][n] = __builtin_amdgcn_mfma_f32_16x16x32_bf16(Bt[n][k], At[m][k], acc[ai][bj][m][n], 0, 0, 0); __builtin_amdgcn_s_setprio(0); } while (0)
#define PG8_WAIT_V(n) asm volatile("s_waitcnt vmcnt(" #n ")" ::: "memory")
#define PG8_WAIT_L(n) asm volatile("s_waitcnt lgkmcnt(" #n ")" ::: "memory")
#define PG8_BAR __builtin_amdgcn_s_barrier()
#define PG8_SCHED __builtin_amdgcn_sched_barrier(0)
#define PG8_OFFS(u, o0, o1) do { _Pragma("unroll") for (int _i = 0; _i < 2; ++_i) { \
        if (GATHER && (u).rows) { const unsigned r0_ = (unsigned)(u).rows[Rr[_i]], r1_ = (unsigned)(u).rows[Rr[_i] + HALF]; o0[_i] = (r0_ * (unsigned)K + (unsigned)Cc[_i]) * 2u; o1[_i] = (r1_ * (unsigned)K + (unsigned)Cc[_i]) * 2u; } \
        else { o0[_i] = (unsigned)(Rr[_i] * K + Cc[_i]) * 2u; o1[_i] = o0[_i] + (unsigned)hstep; } } } while (0)
    Unit cur, nxt; int ui = 0;
    if (!S.next(0, cur)) return;
    f32x4 acc[2][2][4][2];
#pragma unroll
    for (int a = 0; a < 2; ++a)
#pragma unroll
        for (int b = 0; b < 2; ++b)
#pragma unroll
            for (int m = 0; m < 4; ++m)
#pragma unroll
                for (int n = 0; n < 2; ++n) acc[a][b][m][n] = (f32x4){0.f, 0.f, 0.f, 0.f};
    bf16x8 At[4][2], B0[2][2], B1[2][2];
    unsigned vA0[2], vA1[2], nA0[2], nA1[2];
    PG8_OFFS(cur, vA0, vA1);
    const char* cA = cur.A; const char* cB = cur.B;
    PG8_STAGEB(PG8_SB(0, 0), cB); PG8_STAGEB(PG8_SB(0, 1), cB + hstep); PG8_STAGE2(PG8_SA(0, 0), cA, vA0[0], vA0[1]); PG8_STAGE2(PG8_SA(0, 1), cA, vA1[0], vA1[1]);
    if (wr == 1) PG8_BAR;
    PG8_WAIT_V(2); PG8_BAR;
    PG8_STAGEB(PG8_SB(1, 0), cB + kstep); PG8_STAGE2(PG8_SA(1, 0), cA + kstep, vA0[0], vA0[1]); PG8_STAGEB(PG8_SB(1, 1), cB + hstep + kstep);
    PG8_WAIT_V(6); PG8_BAR;
    for (;;) {
        const bool has_next = S.next(ui + 1, nxt);
        const char* nA = has_next ? nxt.A : cA; const char* nB = has_next ? nxt.B : cB;
        if (GATHER) { if (has_next) { PG8_OFFS(nxt, nA0, nA1); } else {
#pragma unroll
            for (int i = 0; i < 2; ++i) { nA0[i] = vA0[i]; nA1[i] = vA1[i]; } } }
        for (int t = 0; t < nt; t += 2) {
            const bool last = (t == nt - 2);
            const char* a1 = cA + (size_t)(t + 1) * kstep;
            const char* a2 = last ? nA : cA + (size_t)(t + 2) * kstep; const char* b2 = last ? nB : cB + (size_t)(t + 2) * kstep;
            const char* a3 = a2 + kstep; const char* b3 = b2 + kstep;
            unsigned x00 = vA0[0], x01 = vA0[1], x10 = vA1[0], x11 = vA1[1];
            if (GATHER) { if (last) { x00 = nA0[0]; x01 = nA0[1]; x10 = nA1[0]; x11 = nA1[1]; } }
            PG8_LDB(B0, 0, 0); PG8_LDB(B1, 0, 1); PG8_SCHED; PG8_LDA(At, 0, 0); PG8_STAGE2(PG8_SA(1, 1), a1, vA1[0], vA1[1]);
            PG8_WAIT_V(8); PG8_WAIT_L(0); PG8_BAR; PG8_MMA(0, 0, At, B0); PG8_MMA(0, 1, At, B1); PG8_BAR; PG8_SCHED;
            PG8_LDA(At, 0, 1); PG8_STAGEB(PG8_SB(0, 0), b2); PG8_STAGEB(PG8_SB(0, 1), b2 + hstep); PG8_STAGE2(PG8_SA(0, 0), a2, x00, x01);
            PG8_WAIT_V(8); PG8_WAIT_L(0); PG8_BAR; PG8_MMA(1, 0, At, B0); PG8_MMA(1, 1, At, B1); PG8_BAR; PG8_SCHED;
            PG8_LDB(B0, 1, 0); PG8_LDB(B1, 1, 1); PG8_SCHED; PG8_LDA(At, 1, 0); PG8_STAGE2(PG8_SA(0, 1), a2, x10, x11);
            PG8_WAIT_V(8); PG8_WAIT_L(0); PG8_BAR; PG8_MMA(0, 0, At, B0); PG8_MMA(0, 1, At, B1); PG8_BAR; PG8_SCHED;
            PG8_LDA(At, 1, 1); PG8_STAGEB(PG8_SB(1, 0), b3); PG8_STAGEB(PG8_SB(1, 1), b3 + hstep); PG8_STAGE2(PG8_SA(1, 0), a3, x00, x01);
            PG8_WAIT_V(8); PG8_WAIT_L(0); PG8_BAR; PG8_MMA(1, 0, At, B0); PG8_MMA(1, 1, At, B1); PG8_BAR; PG8_SCHED;
        }
        if (wr == 0) PG8_BAR;
        {
            const int row0 = cur.row0 + wr * 64 + fr, colb = cur.col0 + wc * 32 + 8 * fq;
#pragma unroll
            for (int ai = 0; ai < 2; ++ai)
#pragma unroll
                for (int m = 0; m < 4; ++m) { const int row = row0 + ai * HALF + m * 16;
                    if (row >= cur.lo && row < cur.hi) {
                        if constexpr (Epi::ROW16) E.store16(cur, row, colb, acc[ai][0][m][0], acc[ai][0][m][1], acc[ai][1][m][0], acc[ai][1][m][1]);
                        else {
#pragma unroll
                            for (int bj = 0; bj < 2; ++bj) E.store8(cur, row, colb + bj * HALF, acc[ai][bj][m][0], acc[ai][bj][m][1]); } } }
        }
        if (!has_next) break;
#pragma unroll
        for (int a = 0; a < 2; ++a)
#pragma unroll
            for (int b = 0; b < 2; ++b)
#pragma unroll
                for (int m = 0; m < 4; ++m)
#pragma unroll
                    for (int n = 0; n < 2; ++n) acc[a][b][m][n] = (f32x4){0.f, 0.f, 0.f, 0.f};
        cur = nxt; cA = nA; cB = nB; ++ui;
        if (GATHER) {
#pragma unroll
            for (int i = 0; i < 2; ++i) { vA0[i] = nA0[i]; vA1[i] = nA1[i]; } }
        if (wr == 1) PG8_BAR;
    }
    PG8_WAIT_V(0);
    PG8_BAR;
#undef PG8_SA
#undef PG8_SB
#undef PG8_STAGE2
#undef PG8_STAGEB
#undef PG8_LDA
#undef PG8_LDB
#undef PG8_MMA
#undef PG8_WAIT_V
#undef PG8_WAIT_L
#undef PG8_BAR
#undef PG8_SCHED
#undef PG8_OFFS
}
}


template <bool MASK = false, class Epi>
__device__ __forceinline__ void gemm_small_tile(LAS unsigned char* lds, const bf16* A, const bf16* Bt, int K, int row_abs0, int col_abs0, const Unit& u, const Epi& E) {
    const int tid = threadIdx.x, wid = __builtin_amdgcn_readfirstlane(tid >> 6), lane = tid & 63, fr = lane & 15, fq = lane >> 4;
    const int kw = K >> 3, kbeg = wid * kw;
    f32x4 acc[4][2][2];
#pragma unroll
    for (int m = 0; m < 4; ++m)
#pragma unroll
        for (int g = 0; g < 2; ++g)
#pragma unroll
            for (int n = 0; n < 2; ++n) acc[m][g][n] = (f32x4){0.f, 0.f, 0.f, 0.f};
    const bf16* ap = A + (size_t)fr * K + kbeg + 8 * fq;
    const bf16* bp = Bt + (size_t)(8 * (fr >> 2) + (fr & 3)) * K + kbeg + 8 * fq;
#pragma unroll 4
    for (int k0 = 0; k0 < kw; k0 += 32) {
        bf16x8 af[4], bfr[2][2];
#pragma unroll
        for (int m = 0; m < 4; ++m) af[m] = *(const bf16x8*)(ap + (size_t)(16 * m) * K + k0);
#pragma unroll
        for (int g = 0; g < 2; ++g)
#pragma unroll
            for (int n = 0; n < 2; ++n) bfr[g][n] = *(const bf16x8*)(bp + (size_t)(32 * g + 4 * n) * K + k0);
#pragma unroll
        for (int m = 0; m < 4; ++m)
#pragma unroll
            for (int g = 0; g < 2; ++g)
#pragma unroll
                for (int n = 0; n < 2; ++n) acc[m][g][n] = __builtin_amdgcn_mfma_f32_16x16x32_bf16(bfr[g][n], af[m], acc[m][g][n], 0, 0, 0);
    }
    LAS float* P = (LAS float*)lds + wid * 4096;
#pragma unroll
    for (int m = 0; m < 4; ++m)
#pragma unroll
        for (int g = 0; g < 2; ++g)
#pragma unroll
            for (int n = 0; n < 2; ++n) *(LAS f32x4*)(P + (16 * m + fr) * 64 + 32 * g + 8 * fq + 4 * n) = acc[m][g][n];
    __syncthreads();
    { const int r = tid >> 3, c8 = (tid & 7) * 8; f32x4 v0 = (f32x4){0.f, 0.f, 0.f, 0.f}, v1 = v0;
#pragma unroll
      for (int w = 0; w < 8; ++w) { const LAS float* q = (const LAS float*)lds + w * 4096 + r * 64 + c8; v0 += *(const LAS f32x4*)q; v1 += *(const LAS f32x4*)(q + 4); }
      if (!MASK || (row_abs0 + r >= u.lo && row_abs0 + r < u.hi)) E.store8(u, row_abs0 + r, col_abs0 + c8, v0, v1); }
    __syncthreads();
}

template <bool GATHER, class Epi, class Sched>
__device__ __forceinline__ void run_gemm(LAS unsigned char* lds, int K, const Sched& S, const Epi& E) {
#if FAST_GEMM
    pg8::gemm_phase<Epi, Sched, GATHER>(lds, K, S, E);
#else
    gemm_naive<Epi, Sched>(lds, K, S, E);
    __syncthreads();
#endif
}

struct Args { const float* in[N_IN]; float* out; unsigned char* ws; int ph_lo, ph_hi; };
struct Frame { LAS unsigned char* lds; int tid, lane, wave, vcu, G; };

__device__ __forceinline__ void attn_naive(const Frame& F, const bf16* Q, const bf16* Kb, const bf16* Vb, bf16* ON, const float* subln, const float* lamv, bool with_ctx) {
    LAS float* Qs = (LAS float*)F.lds;
    LAS float* Ks = Qs + 16 * 128;
    LAS float* Vs = Ks + 2 * 64 * 65;
    LAS float* Ps = Vs + 64 * 128;
    const int tid = F.tid, qi = tid >> 5, sl = tid & 31;
    const float lam = lamv[0], oscale = lamv[1];
    const int n_lat = NB * NH * (SEQ / 16), n_ctx = with_ctx ? NB * NH * (CTXL / 16) : 0;
    for (int unit = F.vcu; unit < n_lat + n_ctx; unit += F.G) {
        int b, h, t0, nkeys;
        if (unit < n_lat) { b = unit / (NH * (SEQ / 16)); const int r = unit % (NH * (SEQ / 16)); h = r / (SEQ / 16); t0 = CTXL + (r % (SEQ / 16)) * 16; nkeys = TK; }
        else { const int uu = unit - n_lat; b = uu / (NH * (CTXL / 16)); const int r = uu % (NH * (CTXL / 16)); h = r / (CTXL / 16); t0 = (r % (CTXL / 16)) * 16; nkeys = CTXL; }
        __syncthreads();
        for (int idx = tid; idx < 16 * 128; idx += 512) { const int q = idx >> 7, cd = idx & 127, c = cd >> 6, d = cd & 63;
            Qs[idx] = __uint_as_float((unsigned)Q[(size_t)(((b * NH + h) * 2 + c) * TK + t0 + q) * 64 + d] << 16); }
        float o0[4] = {0, 0, 0, 0}, o1[4] = {0, 0, 0, 0}, l0 = 0.f, l1 = 0.f;
        for (int k0 = 0; k0 < nkeys; k0 += 64) {
            __syncthreads();
            for (int idx = tid; idx < 2 * 64 * 64; idx += 512) { const int c = idx >> 12, key = (idx >> 6) & 63, d = idx & 63;
                Ks[(c * 64 + key) * 65 + d] = __uint_as_float((unsigned)Kb[(size_t)(((b * NH + h) * 2 + c) * TK + k0 + key) * 64 + d] << 16); }
            for (int idx = tid; idx < 64 * 128; idx += 512) { const int key = idx >> 7, dv = idx & 127;
                Vs[idx] = __uint_as_float((unsigned)Vb[(size_t)((b * NH + h) * TK + k0 + key) * 128 + dv] << 16); }
            __syncthreads();
#pragma unroll
            for (int c = 0; c < 2; ++c)
#pragma unroll
                for (int kk = 0; kk < 2; ++kk) { const int key = sl + 32 * kk; float s = 0.f;
                    for (int d = 0; d < 64; ++d) s += Qs[qi * 128 + c * 64 + d] * Ks[(c * 64 + key) * 65 + d];
                    Ps[(c * 16 + qi) * 64 + key] = __builtin_amdgcn_exp2f(s); }
            __syncthreads();
            for (int key = 0; key < 64; ++key) { const float p0 = Ps[qi * 64 + key], p1 = Ps[(16 + qi) * 64 + key]; const f32x4 v = *(const LAS f32x4*)(Vs + key * 128 + sl * 4);
                l0 += p0; l1 += p1;
#pragma unroll
                for (int j = 0; j < 4; ++j) { o0[j] += p0 * v[j]; o1[j] += p1 * v[j]; } }
        }
        const float i0 = 1.f / l0, i1 = lam / l1; float o[4], ss = 0.f;
#pragma unroll
        for (int j = 0; j < 4; ++j) { o[j] = o0[j] * i0 - o1[j] * i1; ss += o[j] * o[j]; }
#pragma unroll
        for (int m = 1; m < 32; m <<= 1) ss += __shfl_xor(ss, m);
        const float rinv = 1.f / sqrtf(ss * (1.f / 128.f) + EPS) * oscale;
        const int t = t0 + qi, row = t >= CTXL ? b * SEQ + (t - CTXL) : RL + b * CTXL + t;
        const f32x4 g = *(const f32x4*)(subln + sl * 4);
        v2u w; w.x = cvt_pk_bf16(o[0] * rinv * g[0], o[1] * rinv * g[1]); w.y = cvt_pk_bf16(o[2] * rinv * g[2], o[3] * rinv * g[3]);
        *(v2u*)(ON + (size_t)row * 1024 + h * 128 + sl * 4) = w;
    }
    __syncthreads();
}


namespace att {
#define SBAR() __builtin_amdgcn_sched_barrier(0)
constexpr int STAGE = 32768, ST_K1 = 8192, ST_V = 16384, OFF_WS = 3 * STAGE;
__device__ __forceinline__ int crow(int r, int hi) { return (r & 3) + 8 * (r >> 2) + 4 * hi; }
__device__ __forceinline__ int v_st(int k, int c) { const int kk = (k & ~0xC) | ((k & 4) << 1) | ((k & 8) >> 1); return ((kk >> 3) * 4 + (c >> 5)) * 512 + ((kk & 7) * 32 + (c & 31)) * 2; }
__device__ __forceinline__ int v_rd_base(int lane) { return ((lane & 3) << 3) | (((lane >> 2) & 3) << 6) | (((lane >> 4) & 1) << 5) | (((lane >> 5) & 1) << 8); }
constexpr int v_rd_off(int d0, int ks, int half) { return d0 * 512 + ks * 4096 + half * 2048; }
template <int OFF> __device__ __forceinline__ s16x4 tr_read(int vb) { s16x4 r; asm volatile("ds_read_b64_tr_b16 %0, %1 offset:%2" : "=&v"(r) : "v"(vb), "i"(OFF) : "memory"); return r; }
template <int D0> __device__ __forceinline__ void pv_one(f32x16& od, int vb, bf16x8 pa0, bf16x8 pa1, bf16x8 pa2, bf16x8 pa3) {
    const s16x4 l0 = tr_read<v_rd_off(D0, 0, 0)>(vb), h0 = tr_read<v_rd_off(D0, 0, 1)>(vb), l1 = tr_read<v_rd_off(D0, 1, 0)>(vb), h1 = tr_read<v_rd_off(D0, 1, 1)>(vb);
    const s16x4 l2 = tr_read<v_rd_off(D0, 2, 0)>(vb), h2 = tr_read<v_rd_off(D0, 2, 1)>(vb), l3 = tr_read<v_rd_off(D0, 3, 0)>(vb), h3 = tr_read<v_rd_off(D0, 3, 1)>(vb);
    asm volatile("s_waitcnt lgkmcnt(0)" ::: "memory"); SBAR();
#define ATT_PK(L, H) (bf16x8){L[0], L[1], L[2], L[3], H[0], H[1], H[2], H[3]}
    od = __builtin_amdgcn_mfma_f32_32x32x16_bf16(pa0, ATT_PK(l0, h0), od, 0, 0, 0);
    od = __builtin_amdgcn_mfma_f32_32x32x16_bf16(pa1, ATT_PK(l1, h1), od, 0, 0, 0);
    od = __builtin_amdgcn_mfma_f32_32x32x16_bf16(pa2, ATT_PK(l2, h2), od, 0, 0, 0);
    od = __builtin_amdgcn_mfma_f32_32x32x16_bf16(pa3, ATT_PK(l3, h3), od, 0, 0, 0);
#undef ATT_PK
}
template <int VAR> __device__ __forceinline__ void pv_d0(f32x16 (&o)[4], int vb, bf16x8 pa0, bf16x8 pa1, bf16x8 pa2, bf16x8 pa3) {
    if (VAR == 2) { asm volatile("" :: "v"(pa0), "v"(pa1), "v"(pa2), "v"(pa3)); return; }
    pv_one<0>(o[0], vb, pa0, pa1, pa2, pa3); pv_one<1>(o[1], vb, pa0, pa1, pa2, pa3); pv_one<2>(o[2], vb, pa0, pa1, pa2, pa3); pv_one<3>(o[3], vb, pa0, pa1, pa2, pa3);
}
#define ATT_PK4(P, BASE, OUT) do { unsigned a0 = cvt_pk_bf16(P[BASE + 0], P[BASE + 1]), a1 = cvt_pk_bf16(P[BASE + 2], P[BASE + 3]); \
    unsigned b0 = cvt_pk_bf16(P[BASE + 4], P[BASE + 5]), b1 = cvt_pk_bf16(P[BASE + 6], P[BASE + 7]); \
    auto r0 = __builtin_amdgcn_permlane32_swap(a0, b0, false, false); auto r1 = __builtin_amdgcn_permlane32_swap(a1, b1, false, false); \
    v4u w = {r0[0], r1[0], r0[1], r1[1]}; OUT = *reinterpret_cast<bf16x8*>(&w); } while (0)
template <int VAR> __device__ __forceinline__ void half_a(f32x16& p, float& ps, bf16x8& pa0, bf16x8& pa1) {
    if (VAR != 1) {
#pragma unroll
    for (int r = 0; r < 16; ++r) p[r] = __builtin_amdgcn_exp2f(p[r]); }
    float s = 0.f;
#pragma unroll
    for (int r = 0; r < 16; ++r) s += p[r];
    ps = s;
    ATT_PK4(p, 0, pa0); ATT_PK4(p, 8, pa1);
}
template <int VAR> __device__ __forceinline__ void half_b(f32x16& p, float ps, float& l_reg, bf16x8& pa2, bf16x8& pa3) {
    if (VAR != 1) {
#pragma unroll
    for (int r = 0; r < 16; ++r) p[r] = __builtin_amdgcn_exp2f(p[r]); }
#pragma unroll
    for (int r = 0; r < 16; ++r) ps += p[r];
    { auto rr = __builtin_amdgcn_permlane32_swap(__float_as_uint(ps), __float_as_uint(ps), false, false); ps = __uint_as_float(rr[0]) + __uint_as_float(rr[1]); }
    l_reg += ps;
    ATT_PK4(p, 0, pa2); ATT_PK4(p, 8, pa3);
}
__device__ __forceinline__ void qkt(f32x16& p0, f32x16& p1, const LAS unsigned char* Ks, const bf16x8 (&qr)[4], int r32, int hi) {
    p0 = f32x16{}; p1 = f32x16{};
    const int swz = (r32 >> 1) & 7;
#pragma unroll
    for (int d0 = 0; d0 < 4; ++d0) { const int off = r32 * 128 + (((d0 * 2 + hi) ^ swz) << 4);
        const bf16x8 b0 = *(const LAS bf16x8*)(Ks + off), b1 = *(const LAS bf16x8*)(Ks + 4096 + off);
        p0 = __builtin_amdgcn_mfma_f32_32x32x16_bf16(b0, qr[d0], p0, 0, 0, 0);
        p1 = __builtin_amdgcn_mfma_f32_32x32x16_bf16(b1, qr[d0], p1, 0, 0, 0); }
}
}

template <int VAR>
__device__ __forceinline__ void attn_fast(const Frame& F, const bf16* Q, const bf16* Kb, const bf16* Vb, bf16* ON, const float* subln, const float* lamv, bool with_ctx) {
    using namespace att;
    LAS unsigned char* lds = F.lds;
    const int tid = F.tid, wid = F.wave, lane = F.lane, r32 = lane & 31, hi = lane >> 5, comp = wid >> 2, wq = wid & 3;
    LAS float* li_l = (LAS float*)(lds + OFF_WS) + wid * 64;
    const int sr = tid >> 4, sc = (tid & 15) * 8, vst0 = v_st(sr, sc);
    const int krow = tid >> 3, kst = krow * 128 + (((tid & 7) ^ ((krow >> 1) & 7)) << 4);
    const int vb0 = (int)(uintptr_t)(lds + ST_V) + v_rd_base(lane);
    const unsigned koffb = (unsigned)tid * 16u, voffb = (unsigned)(sr * 128 + sc) * 2u;
    const LAS unsigned char* Kl = lds + comp * ST_K1;
    const float lam = __builtin_bit_cast(float, __builtin_amdgcn_readfirstlane(__builtin_bit_cast(int, lamv[0]))), oscale = __builtin_bit_cast(float, __builtin_amdgcn_readfirstlane(__builtin_bit_cast(int, lamv[1])));
    const int n_lat = NB * NH * (SEQ / 128), n_ctx = with_ctx ? NB * NH * (CTXL / 128) : 0;
    for (int unit = F.vcu; unit < n_lat + n_ctx; unit += F.G) {
        int b, h, t0, NT;
        if (unit < n_lat) { const int bh = unit >> 5; b = bh >> 3; h = bh & 7; t0 = CTXL + (unit & 31) * 128; NT = TK / 64; }
        else { const int uu = unit - n_lat, bh = uu >> 1; b = bh >> 3; h = bh & 7; t0 = (uu & 1) * 128; NT = CTXL / 64; }
        const char* K0u = (const char*)(Kb + (size_t)((b * NH + h) * 2) * TK * 64); const char* K1u = K0u + (size_t)TK * 128;
        const char* V0u = (const char*)(Vb + (size_t)(b * NH + h) * TK * 128); const char* V1u = V0u + 32 * 256;
        bf16x8 qr[4];
        { const bf16* Qw = Q + ((size_t)((b * NH + h) * 2 + comp) * TK + t0 + wq * 32 + r32) * 64 + hi * 8;
#pragma unroll
          for (int d0 = 0; d0 < 4; ++d0) qr[d0] = *(const bf16x8*)(Qw + d0 * 16); }
        float l_reg = 0.f; f32x16 o[4] = {};
        struct { bf16x8 vs0, vs1, ks0, ks1; } st_[2];
#define ATT_SLOAD(i, k0) do { st_[i].vs0 = *(const bf16x8*)(V0u + (size_t)(k0) * 256 + voffb); st_[i].vs1 = *(const bf16x8*)(V1u + (size_t)(k0) * 256 + voffb); \
        st_[i].ks0 = *(const bf16x8*)(K0u + (size_t)(k0) * 128 + koffb); st_[i].ks1 = *(const bf16x8*)(K1u + (size_t)(k0) * 128 + koffb); } while (0)
#define ATT_SWRITE(so, i) do { *(LAS bf16x8*)(lds + (so) + ST_V + vst0) = st_[i].vs0; *(LAS bf16x8*)(lds + (so) + ST_V + 8192 + vst0) = st_[i].vs1; \
        *(LAS bf16x8*)(lds + (so) + kst) = st_[i].ks0; *(LAS bf16x8*)(lds + (so) + ST_K1 + kst) = st_[i].ks1; } while (0)
        f32x16 pA0, pA1, pB0, pB1; bf16x8 pa0, pa1, pa2, pa3; float ps;
#define ATT_ITER(c0, c1, n0, n1, WS, LS) do { \
        SBAR(); qkt(n0, n1, Kl + sN, qr, r32, hi); half_b<VAR>(c1, ps, l_reg, pa2, pa3); SBAR(); \
        if (j + 3 < NT) ATT_SLOAD(LS, (j + 3) * 64); SBAR(); \
        pv_d0<VAR>(o, vb0 + sC, pa0, pa1, pa2, pa3); half_a<VAR>(n0, ps, pa0, pa1); \
        if (j + 2 < NT) { if (j + 3 < NT) asm volatile("s_waitcnt vmcnt(4)" ::: "memory"); else asm volatile("s_waitcnt vmcnt(0)" ::: "memory"); ATT_SWRITE(sW, WS); } \
        __syncthreads(); { const int t_ = sC; sC = sN; sN = sW; sW = t_; } ++j; } while (0)
        int sC = 0, sN = STAGE, sW = 2 * STAGE, j = 0;
        ATT_SLOAD(0, 0); ATT_SLOAD(1, 64); asm volatile("s_waitcnt vmcnt(0)" ::: "memory"); ATT_SWRITE(0, 0); ATT_SWRITE(STAGE, 1);
        ATT_SLOAD(0, 128); __syncthreads();
        qkt(pA0, pA1, Kl, qr, r32, hi); half_a<VAR>(pA0, ps, pa0, pa1);
        while (j + 2 < NT) {
            ATT_ITER(pA0, pA1, pB0, pB1, 0, 1);
            ATT_ITER(pB0, pB1, pA0, pA1, 1, 0);
        }
        ATT_ITER(pA0, pA1, pB0, pB1, 0, 1);
        half_b<VAR>(pB1, ps, l_reg, pa2, pa3); SBAR();
        pv_d0<VAR>(o, vb0 + sC, pa0, pa1, pa2, pa3);
#undef ATT_ITER
#undef ATT_SLOAD
#undef ATT_SWRITE
        if (hi == 0) li_l[r32] = l_reg;
        __syncthreads();
        float rli[16];
#pragma unroll
        for (int r = 0; r < 16; ++r) rli[r] = __builtin_amdgcn_rcpf(li_l[crow(r, hi)]);
        LAS float* X = (LAS float*)lds;
        if (comp == 1) {
#pragma unroll
            for (int r = 0; r < 16; ++r) { const int row = wq * 32 + crow(r, hi); const float sc1 = rli[r] * lam;
#pragma unroll
                for (int d0 = 0; d0 < 4; ++d0) X[row * 128 + d0 * 32 + r32] = o[d0][r] * sc1; }
        }
        __syncthreads();
        if (comp == 0) {
            float ss[16];
#pragma unroll
            for (int r = 0; r < 16; ++r) { const int row = wq * 32 + crow(r, hi); float s = 0.f;
#pragma unroll
                for (int d0 = 0; d0 < 4; ++d0) { const float v = o[d0][r] * rli[r] - X[row * 128 + d0 * 32 + r32]; o[d0][r] = v; s += v * v; }
                ss[r] = s; }
#pragma unroll
            for (int r = 0; r < 16; ++r) {
#pragma unroll
                for (int m = 1; m < 32; m <<= 1) ss[r] += __shfl_xor(ss[r], m); }
            float g[4];
#pragma unroll
            for (int d0 = 0; d0 < 4; ++d0) g[d0] = subln[d0 * 32 + r32] * oscale;
#pragma unroll
            for (int r = 0; r < 16; ++r) { const float rinv = 1.f / sqrtf(ss[r] * (1.f / 128.f) + EPS);
                const int t = t0 + wq * 32 + crow(r, hi), row = t >= CTXL ? b * SEQ + (t - CTXL) : RL + b * CTXL + t;
                bf16* op = ON + (size_t)row * 1024 + h * 128 + r32;
#pragma unroll
                for (int d0 = 0; d0 < 4; ++d0) if (VAR == 0 || lam == 12345.f) op[d0 * 32] = (bf16)(cvt_pk_bf16(o[d0][r] * rinv * g[d0], 0.f) & 0xffffu); }
        }
        __syncthreads();
    }
}


namespace a16 {
__device__ __forceinline__ int off_a(int row, int ch) { return 2048 * (row >> 3) + 512 * (ch >> 2) + 64 * (row & 7) + 16 * ((ch & 3) ^ ((row >> 2) & 3)); }
__device__ __forceinline__ int fK(int key) { return ((key >> 1) & 1) | (((key >> 3) & 1) << 1) | (((key >> 4) & 1) << 2); }
__device__ __forceinline__ void qkt16(f32x4 (&S)[2][2][2], const LAS unsigned char* Kt, int kb0, int kb1, const bf16x8 (&qf)[2][2]) {
#pragma unroll
    for (int ks2 = 0; ks2 < 2; ++ks2) {
        if (ks2) SBAR();
#pragma unroll
        for (int u = 0; u < 2; ++u) {
            const bf16x8 k0 = *(const LAS bf16x8*)(Kt + kb0 + 4096 * ks2 + 512 * u), k1 = *(const LAS bf16x8*)(Kt + kb1 + 4096 * ks2 + 512 * u);
#pragma unroll
            for (int qb = 0; qb < 2; ++qb) { f32x4 acc = (f32x4){0.f, 0.f, 0.f, 0.f};
                acc = __builtin_amdgcn_mfma_f32_16x16x32_bf16(k0, qf[qb][0], acc, 0, 0, 0); S[ks2][u][qb] = __builtin_amdgcn_mfma_f32_16x16x32_bf16(k1, qf[qb][1], acc, 0, 0, 0); }
        }
    }
}
__device__ __forceinline__ void half16(f32x4 (&Sh)[2][2], float (&ls)[2], bf16x8 (&pf)[2]) {
#pragma unroll
    for (int qb = 0; qb < 2; ++qb) {
#pragma unroll
        for (int u = 0; u < 2; ++u)
#pragma unroll
            for (int r = 0; r < 4; ++r) Sh[u][qb][r] = __builtin_amdgcn_exp2f(Sh[u][qb][r]);
        ls[qb] += ((Sh[0][qb][0] + Sh[0][qb][1]) + (Sh[0][qb][2] + Sh[0][qb][3])) + ((Sh[1][qb][0] + Sh[1][qb][1]) + (Sh[1][qb][2] + Sh[1][qb][3]));
        v4u w; w.x = cvt_pk_bf16_pin(Sh[0][qb][0], Sh[0][qb][1]); w.y = cvt_pk_bf16_pin(Sh[0][qb][2], Sh[0][qb][3]); w.z = cvt_pk_bf16_pin(Sh[1][qb][0], Sh[1][qb][1]); w.w = cvt_pk_bf16_pin(Sh[1][qb][2], Sh[1][qb][3]);
        pf[qb] = *reinterpret_cast<bf16x8*>(&w); }
}
template <int CP, bool PVSYNC = false> __device__ __forceinline__ void pv16(f32x4 (&O)[8][2], int vb00, int vb01, int vb10, int vb11, const bf16x8 (&pf)[2][2]) {
#define tr_read16(OFF, vb) __builtin_amdgcn_ds_read_tr16_b64_v4i16((LAS s16x4*)((LAS unsigned char*)(uintptr_t)(unsigned)(vb) + (OFF)))
    const s16x4 a0 = tr_read16(512 * CP, vb00), a1 = tr_read16(512 * CP, vb01), a2 = tr_read16(8192 + 512 * CP, vb00), a3 = tr_read16(8192 + 512 * CP, vb01);
    const s16x4 b0 = tr_read16(512 * CP, vb10), b1 = tr_read16(512 * CP, vb11), b2 = tr_read16(8192 + 512 * CP, vb10), b3 = tr_read16(8192 + 512 * CP, vb11);
    if (PVSYNC) { asm volatile("s_waitcnt lgkmcnt(0)" ::: "memory"); SBAR(); }
#define A16_PK(L, H) (bf16x8){L[0], L[1], L[2], L[3], H[0], H[1], H[2], H[3]}
    const bf16x8 ve0 = A16_PK(a0, a1), ve1 = A16_PK(a2, a3), vo0 = A16_PK(b0, b1), vo1 = A16_PK(b2, b3);
#pragma unroll
    for (int qb = 0; qb < 2; ++qb) {
        O[2 * CP][qb] = __builtin_amdgcn_mfma_f32_16x16x32_bf16(ve0, pf[0][qb], O[2 * CP][qb], 0, 0, 0);
        O[2 * CP + 1][qb] = __builtin_amdgcn_mfma_f32_16x16x32_bf16(vo0, pf[0][qb], O[2 * CP + 1][qb], 0, 0, 0);
        O[2 * CP][qb] = __builtin_amdgcn_mfma_f32_16x16x32_bf16(ve1, pf[1][qb], O[2 * CP][qb], 0, 0, 0);
        O[2 * CP + 1][qb] = __builtin_amdgcn_mfma_f32_16x16x32_bf16(vo1, pf[1][qb], O[2 * CP + 1][qb], 0, 0, 0); }
#undef A16_PK
#undef tr_read16
}
}

__device__ __forceinline__ void attn16(const Frame& F, const bf16* Q, const bf16* Kb, const bf16* Vb, bf16* ON, const float* subln, const float* lamv, bool with_ctx) {
    using namespace att; using namespace a16;
    LAS unsigned char* lds = F.lds;
    const int tid = F.tid, wid = F.wave, lane = F.lane, l15 = lane & 15, g = lane >> 4, comp = wid >> 2, wq = wid & 3;
    const int vrl = 8 * (tid >> 7) + ((tid >> 2) & 7);
    const unsigned ksrc = (unsigned)((tid >> 3) * 128 + (((tid & 7) ^ fK(tid >> 3)) << 4));
    const unsigned vsrc = (unsigned)(vrl * 256 + (((((tid >> 5) & 3) << 2) | ((tid & 3) ^ ((vrl >> 2) & 3))) << 4));
    const unsigned ldsw = (unsigned)__builtin_amdgcn_readfirstlane(wid) * 1024u;
    const int ki = 8 * (l15 >> 2) + (l15 & 3), kf = fK(ki);
    const int kb0 = ki * 128 + (((0 + g) ^ kf) << 4), kb1 = ki * 128 + (((4 + g) ^ kf) << 4);
    const int tq = l15 >> 2, tp = lane & 3;
    const int vr0 = (int)(uintptr_t)(lds + ST_V);
    int v00 = vr0 + off_a(8 * g + tq, 0 + (tp >> 1)) + 8 * (tp & 1), v01 = vr0 + off_a(8 * g + 4 + tq, 0 + (tp >> 1)) + 8 * (tp & 1);
    int v10 = vr0 + off_a(8 * g + tq, 2 + (tp >> 1)) + 8 * (tp & 1), v11 = vr0 + off_a(8 * g + 4 + tq, 2 + (tp >> 1)) + 8 * (tp & 1);
    const LAS unsigned char* Kl = lds + comp * ST_K1;
    const float lam = __builtin_bit_cast(float, __builtin_amdgcn_readfirstlane(__builtin_bit_cast(int, lamv[0]))), oscale = __builtin_bit_cast(float, __builtin_amdgcn_readfirstlane(__builtin_bit_cast(int, lamv[1])));
    const int n_lat = NB * NH * (SEQ / 128), n_ctx = with_ctx ? NB * NH * (CTXL / 128) : 0;
    for (int unit = F.vcu; unit < n_lat + n_ctx; unit += F.G) {
        int b, h, t0, NT;
        if (unit < n_lat) { const int bh = unit >> 5; b = bh >> 3; h = bh & 7; t0 = CTXL + (unit & 31) * 128; NT = TK / 64; }
        else { const int uu = unit - n_lat, bh = uu >> 1; b = bh >> 3; h = bh & 7; t0 = (uu & 1) * 128; NT = CTXL / 64; }
        const char* K0u = (const char*)(Kb + (size_t)((b * NH + h) * 2) * TK * 64); const char* K1u = K0u + (size_t)TK * 128;
        const char* V0u = (const char*)(Vb + (size_t)(b * NH + h) * TK * 128); const char* V1u = V0u + 32 * 256;
        bf16x8 qf[2][2];
        { const bf16* Qw = Q + ((size_t)((b * NH + h) * 2 + comp) * TK + t0 + wq * 32 + l15) * 64 + 8 * g;
#pragma unroll
          for (int qb = 0; qb < 2; ++qb)
#pragma unroll
              for (int sdim = 0; sdim < 2; ++sdim) qf[qb][sdim] = *(const bf16x8*)(Qw + (size_t)qb * 16 * 64 + 32 * sdim); }
        f32x4 O[8][2];
#pragma unroll
        for (int c = 0; c < 8; ++c) { O[c][0] = (f32x4){0.f, 0.f, 0.f, 0.f}; O[c][1] = (f32x4){0.f, 0.f, 0.f, 0.f}; }
        float ls[2] = {0.f, 0.f};
#define A16_DMA1(gp, voff, ldsa) asm volatile("s_mov_b32 m0, %2\n\ts_nop 0\n\tglobal_load_lds_dwordx4 %0, %1" :: "v"(voff), "s"(gp), "s"(ldsa) : "memory", "m0")
#define A16_DMA(so, k0) do { const unsigned la_ = (unsigned)(uintptr_t)(lds + (so)) + ldsw; \
        A16_DMA1(K0u + (size_t)(k0) * 128, ksrc, la_); A16_DMA1(K1u + (size_t)(k0) * 128, ksrc, la_ + ST_K1); \
        A16_DMA1(V0u + (size_t)(k0) * 256, vsrc, la_ + ST_V); A16_DMA1(V1u + (size_t)(k0) * 256, vsrc, la_ + ST_V + 8192); } while (0)
        f32x4 SA[2][2][2], SB[2][2][2]; bf16x8 pf[2][2], pf2[2];
#define A16_ITER(SC, SNX) do { \
        if (j + 2 < NT) A16_DMA(sW, (j + 2) * 64); \
        SBAR(); qkt16(SNX, Kl + sN, kb0, kb1, qf); half16(SC[1], ls, pf[1]); SBAR(); \
        asm volatile("" : "+v"(SNX[0][0][0]), "+v"(SNX[0][0][1]), "+v"(SNX[0][1][0]), "+v"(SNX[0][1][1]));     \
        pv16<0>(O, v00, v01, v10, v11, pf); pv16<1>(O, v00, v01, v10, v11, pf); \
        pv16<2>(O, v00, v01, v10, v11, pf); pv16<3>(O, v00, v01, v10, v11, pf); \
        half16(SNX[0], ls, pf2); pf[0][0] = pf2[0]; pf[0][1] = pf2[1]; \
        asm volatile("s_waitcnt vmcnt(0)" ::: "memory"); \
        __syncthreads(); { const int d_ = sN - sC; v00 += d_; v01 += d_; v10 += d_; v11 += d_; const int t_ = sC; sC = sN; sN = sW; sW = t_; } ++j; } while (0)
        int sC = 0, sN = STAGE, sW = 2 * STAGE, j = 0;
        A16_DMA(0, 0); A16_DMA(STAGE, 64);
        asm volatile("s_waitcnt vmcnt(0)" ::: "memory"); __syncthreads();
        qkt16(SA, Kl, kb0, kb1, qf); half16(SA[0], ls, pf[0]);
        while (j + 2 < NT) { A16_ITER(SA, SB); A16_ITER(SB, SA); }
        A16_ITER(SA, SB);
        half16(SB[1], ls, pf[1]); SBAR();
        pv16<0>(O, v00, v01, v10, v11, pf); pv16<1>(O, v00, v01, v10, v11, pf);
        pv16<2>(O, v00, v01, v10, v11, pf); pv16<3>(O, v00, v01, v10, v11, pf);
        v00 -= sC; v01 -= sC; v10 -= sC; v11 -= sC;
#undef A16_ITER
#undef A16_DMA
#undef A16_DMA1
#pragma unroll
        for (int qb = 0; qb < 2; ++qb) { ls[qb] += __shfl_xor(ls[qb], 16); ls[qb] += __shfl_xor(ls[qb], 32); }
        __syncthreads();
        LAS float* X = (LAS float*)lds;
        if (comp == 1) {
#pragma unroll
            for (int qb = 0; qb < 2; ++qb) { const float sc1 = lam * __builtin_amdgcn_rcpf(ls[qb]); LAS float* xr = X + (wq * 32 + qb * 16 + l15) * 128 + 4 * g;
#pragma unroll
                for (int c = 0; c < 8; ++c) *(LAS f32x4*)(xr + 16 * c) = O[c][qb] * sc1; }
        }
        __syncthreads();
        if (comp == 0) {
#pragma unroll
            for (int qb = 0; qb < 2; ++qb) { const float i0 = __builtin_amdgcn_rcpf(ls[qb]); const LAS float* xr = X + (wq * 32 + qb * 16 + l15) * 128 + 4 * g; float sq = 0.f;
#pragma unroll
                for (int c = 0; c < 8; ++c) { const f32x4 v = O[c][qb] * i0 - *(const LAS f32x4*)(xr + 16 * c); O[c][qb] = v; sq += (v[0] * v[0] + v[1] * v[1]) + (v[2] * v[2] + v[3] * v[3]); }
                sq += __shfl_xor(sq, 16); sq += __shfl_xor(sq, 32);
                const float rinv = 1.f / sqrtf(sq * (1.f / 128.f) + EPS) * oscale;
                const int t = t0 + wq * 32 + qb * 16 + l15, row = t >= CTXL ? b * SEQ + (t - CTXL) : RL + b * CTXL + t;
                bf16* op = ON + (size_t)row * 1024 + h * 128 + 4 * g;
#pragma unroll
                for (int c = 0; c < 8; ++c) { const f32x4 gg = *(const f32x4*)(subln + 16 * c + 4 * g); const f32x4 y = O[c][qb] * rinv * gg;
                    v2u w; w.x = cvt_pk_bf16(y[0], y[1]); w.y = cvt_pk_bf16(y[2], y[3]); *(v2u*)(op + 16 * c) = w; } }
        }
        __syncthreads();
    }
}

__device__ __forceinline__ void cvt_item(const float* s0, const float* s1, int srcN, int mode, int K, int N, bf16* dst, int item, LAS float* scr, int lane) {
    const int nblk = N / 64, kb = item / nblk, nb = item % nblk, k0 = 64 * kb, n0 = 64 * nb;
    const int v = n0 + lane; const float* sp = s0; int c = v;
    if (mode == 1) { const int kind = (v >> 2) & 1, ch = ((v >> 3) << 2) | (v & 3); sp = kind ? s1 : s0; c = ch; }
    else if (mode == 2) { if (v >= 3072 && v < 5120) { const int vv = v - 3072, kind = (vv >> 2) & 1, ch = ((vv >> 3) << 2) | (vv & 3); c = 3072 + kind * 1024 + ch; }
        else if (v < 2048) c = qk_src_col(v); }
    sp += (size_t)k0 * srcN + c;
#pragma unroll 16
    for (int kk = 0; kk < 64; ++kk) scr[kk * 64 + (lane ^ (((kk >> 3) & 7) << 2))] = sp[(size_t)kk * srcN];
    LDS_WAIT(); asm volatile("" ::: "memory");
    const int c8 = lane & 7, sw = c8 << 2;
#pragma unroll
    for (int j = 0; j < 8; ++j) { const int n = (lane >> 3) + 8 * j; const LAS float* q = scr + (8 * c8) * 64 + (n ^ sw);
        v4u o; o.x = cvt_pk_bf16(q[0 * 64], q[1 * 64]); o.y = cvt_pk_bf16(q[2 * 64], q[3 * 64]); o.z = cvt_pk_bf16(q[4 * 64], q[5 * 64]); o.w = cvt_pk_bf16(q[6 * 64], q[7 * 64]);
        *(v4u*)(dst + (size_t)(n0 + n) * K + k0 + 8 * c8) = o; }
    LDS_WAIT(); asm volatile("" ::: "memory");
}

__device__ __forceinline__ void phase_prologue(const Frame& F, const Args& a) {
    unsigned char* ws = a.ws;
    {
        LAS float* sv = (LAS float*)F.lds; LAS float* part = sv + 5 * 1024;
        for (int idx = F.tid; idx < 5 * 1024; idx += 512) { const int v = idx >> 10, k = idx & 1023; const float x = v < 4 ? a.in[I_C][v * 1024 + k] : a.in[I_CCTX][k]; sv[idx] = x * sigm(x); }
        __syncthreads();
        float* MOD = (float*)(ws + WS_MOD);
        for (int unit = F.vcu; unit < 192; unit += F.G) {
            const int l = unit / 96, n0 = (unit % 96) * 64; const float* W = a.in[I_WMOD] + (size_t)l * 1024 * 6144 + n0 + F.lane;
            float acc[5] = {0, 0, 0, 0, 0};
#pragma unroll 16
            for (int k = F.wave * 128; k < F.wave * 128 + 128; ++k) { const float wv = W[(size_t)k * 6144];
#pragma unroll
                for (int v = 0; v < 5; ++v) acc[v] += sv[v * 1024 + k] * wv; }
#pragma unroll
            for (int v = 0; v < 5; ++v) part[(F.wave * 5 + v) * 64 + F.lane] = acc[v];
            __syncthreads();
            if (F.tid < 320) { const int v = F.tid >> 6, ln = F.tid & 63; float s = a.in[I_BMOD][l * 6144 + n0 + ln];
#pragma unroll
                for (int w = 0; w < 8; ++w) s += part[(w * 5 + v) * 64 + ln];
                MOD[(size_t)(l * 5 + v) * 6144 + n0 + ln] = s; }
            __syncthreads();
        }
    }
    if (F.vcu == F.G - 1) {
        float* ROPE = (float*)(ws + WS_ROPE); float* LAMV = (float*)(ws + WS_LAM);
        for (int idx = F.tid; idx < 1024; idx += 512) { const int pos = idx >> 4, i = idx & 15; const float inv = __builtin_amdgcn_exp2f(-(float)(2 * i) * (13.287712379549449f / 32.f)), ang = (float)pos * inv; const float kq = rintf(ang * 0.15915494309189535f); float rr = fmaf(-kq, 6.2831854820251465f, ang); rr = fmaf(-kq, -1.7484555e-7f, rr); ROPE[idx] = __cosf(rr); ROPE[1024 + idx] = __sinf(rr); }
        if (F.tid < 2) { const int l = F.tid; float s1 = 0.f, s2 = 0.f;
            for (int d = 0; d < 64; ++d) { s1 += a.in[I_LQ1][l * 64 + d] * a.in[I_LK1][l * 64 + d]; s2 += a.in[I_LQ2][l * 64 + d] * a.in[I_LK2][l * 64 + d]; }
            const float lam_init = l == 0 ? 0.2f : 0.35550906759f; LAMV[l * 2 + 0] = __expf(s1) - __expf(s2) + lam_init; LAMV[l * 2 + 1] = 1.f - lam_init; }
    }
    {
        LAS float* scr = (LAS float*)(F.lds + F.wave * 16384);
        const int gw = F.vcu * 8 + F.wave, NGW = F.G * 8;
        constexpr int I_IN = 16 * 112, I_SQ = 16 * 16, I_GU0 = 16 * 88, I_D0 = 44 * 16, I_EGU = 16 * 112, I_ED = 56 * 16;
        constexpr int NITEMS = 2 * I_IN + 6 * I_SQ + I_GU0 + I_D0 + 8 * I_EGU + 8 * I_ED;
        for (int it = gw; it < NITEMS; it += NGW) {
            int r = it;
            if (r < 2 * I_IN) { const int l = r / I_IN; cvt_item(a.in[I_WIN] + (size_t)l * 1024 * INW, nullptr, INW, 2, 1024, INW, (bf16*)(ws + WS_WIN) + (size_t)l * INW * 1024, r % I_IN, scr, F.lane); continue; } r -= 2 * I_IN;
            if (r < 6 * I_SQ) { const int m = r / I_SQ, l = m / 3, w = m % 3; const float* src = a.in[w == 0 ? I_WATTNO : (w == 1 ? I_WCONVO : I_WOUT)] + (size_t)l * 1024 * 1024;
                bf16* dst = (bf16*)(ws + (w == 0 ? WS_WA : (w == 1 ? WS_WC : WS_WO)) + (size_t)l * 6 * MiB); cvt_item(src, nullptr, 1024, 0, 1024, 1024, dst, r % I_SQ, scr, F.lane); continue; } r -= 6 * I_SQ;
            if (r < I_GU0) { cvt_item(a.in[I_WFFG], a.in[I_WFFU], DFF, 1, 1024, 2 * DFF, (bf16*)(ws + WS_WGU0), r, scr, F.lane); continue; } r -= I_GU0;
            if (r < I_D0) { cvt_item(a.in[I_WFFD], nullptr, 1024, 0, DFF, 1024, (bf16*)(ws + WS_WD0), r, scr, F.lane); continue; } r -= I_D0;
            if (r < 8 * I_EGU) { const int e = r / I_EGU; cvt_item(a.in[I_WEG] + (size_t)e * 1024 * DFE, a.in[I_WEU] + (size_t)e * 1024 * DFE, DFE, 1, 1024, 2 * DFE, (bf16*)(ws + WS_WEGU) + (size_t)e * 2 * DFE * 1024, r % I_EGU, scr, F.lane); continue; } r -= 8 * I_EGU;
            { const int e = r / I_ED; cvt_item(a.in[I_WED] + (size_t)e * DFE * 1024, nullptr, 1024, 0, DFE, 1024, (bf16*)(ws + WS_WED) + (size_t)e * 1024 * DFE, r % I_ED, scr, F.lane); }
        }
    }
}

__device__ __forceinline__ void phase_rmsmod(const Frame& F, const float* src_lat, const float* src_ctx, int nrows, const float* g, const float* modl, int shift_idx, bf16* H) {
    const int gw = F.vcu * 8 + F.wave, NGW = F.G * 8;
    for (int row = gw; row < nrows; row += 2 * NGW) {
        const int row2 = row + NGW; const bool has2 = row2 < nrows;
        const float* srcA = row < RL ? src_lat + (size_t)row * 1024 : src_ctx + (size_t)(row - RL) * 1024;
        const float* srcB = has2 ? (row2 < RL ? src_lat + (size_t)row2 * 1024 : src_ctx + (size_t)(row2 - RL) * 1024) : srcA;
        f32x4 va[4], vb[4]; float sa = 0.f, sb = 0.f;
#pragma unroll
        for (int j = 0; j < 4; ++j) { va[j] = *(const f32x4*)(srcA + 4 * (F.lane + 64 * j)); vb[j] = *(const f32x4*)(srcB + 4 * (F.lane + 64 * j)); }
#pragma unroll
        for (int j = 0; j < 4; ++j) { sa += (va[j][0] * va[j][0] + va[j][1] * va[j][1]) + (va[j][2] * va[j][2] + va[j][3] * va[j][3]); sb += (vb[j][0] * vb[j][0] + vb[j][1] * vb[j][1]) + (vb[j][2] * vb[j][2] + vb[j][3] * vb[j][3]); }
        const float ra = 1.f / sqrtf(wave_sum(sa) * (1.f / 1024.f) + EPS), rb = 1.f / sqrtf(wave_sum(sb) * (1.f / 1024.f) + EPS);
        const float* shA = modl + row_mi(row) * 6144 + shift_idx * 1024; const float* shB = modl + row_mi(has2 ? row2 : row) * 6144 + shift_idx * 1024;
#pragma unroll
        for (int j = 0; j < 4; ++j) { const int col = 4 * (F.lane + 64 * j); const f32x4 gg = *(const f32x4*)(g + col);
            { const f32x4 s4 = *(const f32x4*)(shA + 1024 + col), h4 = *(const f32x4*)(shA + col); const f32x4 y = va[j] * ra * gg * (1.f + s4) + h4;
              v2u w; w.x = cvt_pk_bf16(y[0], y[1]); w.y = cvt_pk_bf16(y[2], y[3]); *(v2u*)(H + (size_t)row * 1024 + col) = w; }
            if (has2) { const f32x4 s4 = *(const f32x4*)(shB + 1024 + col), h4 = *(const f32x4*)(shB + col); const f32x4 y = vb[j] * rb * gg * (1.f + s4) + h4;
              v2u w; w.x = cvt_pk_bf16(y[0], y[1]); w.y = cvt_pk_bf16(y[2], y[3]); *(v2u*)(H + (size_t)row2 * 1024 + col) = w; } }
    }
}

__device__ __forceinline__ void phase_qknorm(const Frame& F, bf16* Q, bf16* Kb, const float* qg, const float* kg, const float* rope, int mode) {
    constexpr int HALFV = NB * NH * 2 * TK;
    const int total = mode ? NB * NH * 2 * CTXL : 2 * HALFV;
    const int j8 = F.tid & 7;
    for (int vec = (F.vcu * 512 + F.tid) >> 3; vec < total; vec += F.G * 64) {
        const bool isK = mode ? true : (vec >= HALFV); const int vv = mode ? (vec >> 8) * TK + (vec & 255) : (isK ? vec - HALFV : vec), t = vv % TK;
        bf16* p = (isK ? Kb : Q) + (size_t)vv * 64 + j8 * 8;
        f32x4 x0, x1; unpack8(*(const v4u*)p, x0, x1);
        float ss = (x0[0] * x0[0] + x0[1] * x0[1]) + (x0[2] * x0[2] + x0[3] * x0[3]) + (x1[0] * x1[0] + x1[1] * x1[1]) + (x1[2] * x1[2] + x1[3] * x1[3]);
        ss += __shfl_xor(ss, 1); ss += __shfl_xor(ss, 2); ss += __shfl_xor(ss, 4);
        const float rinv = 1.f / sqrtf(ss * (1.f / 64.f) + EPS);
        const float* gp = (isK ? kg : qg) + j8 * 8; const f32x4 g0 = *(const f32x4*)gp, g1 = *(const f32x4*)(gp + 4);
        f32x4 y0 = x0 * rinv * g0, y1 = x1 * rinv * g1;
        f32x4 p0, p1;
#pragma unroll
        for (int e = 0; e < 4; ++e) { p0[e] = __shfl_xor(y0[e], 2); p1[e] = __shfl_xor(y1[e], 2); }
        if (t >= CTXL) {
            const int s = t - CTXL, pos = (j8 >> 2) ? (s & 63) : (s >> 6), i0 = (j8 & 1) * 8; const float sgn = ((j8 >> 1) & 1) ? 1.f : -1.f;
            const float* cp = rope + pos * 16 + i0; const float* sp = cp + 1024;
            const f32x4 c0 = *(const f32x4*)cp, c1 = *(const f32x4*)(cp + 4), s0 = *(const f32x4*)sp, s1 = *(const f32x4*)(sp + 4);
            y0 = y0 * c0 + p0 * s0 * sgn; y1 = y1 * c1 + p1 * s1 * sgn;
        }
        if (!isK) { y0 = y0 * QSCALE; y1 = y1 * QSCALE; }
        *(v4u*)p = pack8(y0, y1);
    }
}

__device__ __forceinline__ void phase_conv(const Frame& F, const bf16* U0, bf16* U1, const float* dww, const float* dwb, const float* lng, const float* lnb, int nrows) {
    constexpr int RPU = 8, NIN = RPU + CK - 1;
    LAS float* red = (LAS float*)F.lds;
    const int half = F.tid >> 8, t8 = F.tid & 255, ch = 4 * t8, wv = F.wave & 3;
    const f32x4 bias = *(const f32x4*)(dwb + ch), g4 = *(const f32x4*)(lng + ch), b4 = *(const f32x4*)(lnb + ch);
    const int nunits = nrows / RPU;
    for (int u0 = F.vcu * 2; u0 < nunits; u0 += F.G * 2) {
        asm volatile("" ::: "memory");
        const int r0 = (u0 + half) * RPU;
        int seg_lo, seg_hi; if (r0 < RL) { seg_lo = r0 & ~4095; seg_hi = seg_lo + 4096; } else { seg_lo = RL + ((r0 - RL) & ~255); seg_hi = seg_lo + 256; }
        v2u xp[NIN];
#pragma unroll
        for (int i = 0; i < NIN; ++i) { const int rr = r0 - 15 + i; xp[i] = (rr >= seg_lo && rr < seg_hi) ? *(const v2u*)(U0 + (size_t)rr * 1024 + ch) : (v2u){0u, 0u}; }
        f32x4 acc[RPU];
#pragma unroll
        for (int r = 0; r < RPU; ++r) acc[r] = bias;
#pragma unroll
        for (int j = 0; j < CK; ++j) { const f32x4 wj = *(const f32x4*)(dww + j * 1024 + ch);
#pragma unroll
            for (int r = 0; r < RPU; ++r) { const v2u x = xp[r + j]; acc[r] += wj * (f32x4){bflo(x.x), bfhi(x.x), bflo(x.y), bfhi(x.y)}; } }
        float sv[RPU];
#pragma unroll
        for (int r = 0; r < RPU; ++r) sv[r] = wave_sum((acc[r][0] + acc[r][1]) + (acc[r][2] + acc[r][3]));
        __syncthreads();
        if (F.lane < RPU) { float v = sv[0];
#pragma unroll
            for (int r = 1; r < RPU; ++r) v = (F.lane == r) ? sv[r] : v;
            red[(half * 4 + wv) * RPU + F.lane] = v; }
        __syncthreads();
        float mean[RPU];
#pragma unroll
        for (int r = 0; r < RPU; ++r) mean[r] = ((red[(half * 4 + 0) * RPU + r] + red[(half * 4 + 1) * RPU + r]) + (red[(half * 4 + 2) * RPU + r] + red[(half * 4 + 3) * RPU + r])) * (1.f / 1024.f);
#pragma unroll
        for (int r = 0; r < RPU; ++r) { acc[r] = acc[r] - mean[r]; sv[r] = wave_sum((acc[r][0] * acc[r][0] + acc[r][1] * acc[r][1]) + (acc[r][2] * acc[r][2] + acc[r][3] * acc[r][3])); }
        if (F.lane < RPU) { float v = sv[0];
#pragma unroll
            for (int r = 1; r < RPU; ++r) v = (F.lane == r) ? sv[r] : v;
            red[128 + (half * 4 + wv) * RPU + F.lane] = v; }
        __syncthreads();
#pragma unroll
        for (int r = 0; r < RPU; ++r) { const float q = (red[128 + (half * 4 + 0) * RPU + r] + red[128 + (half * 4 + 1) * RPU + r]) + (red[128 + (half * 4 + 2) * RPU + r] + red[128 + (half * 4 + 3) * RPU + r]);
            const float rstd = 1.f / sqrtf(q * (1.f / 1024.f) + EPS);
            const f32x4 y = acc[r] * rstd * g4 + b4; v2u w; w.x = cvt_pk_bf16(y[0] * sigf(y[0]), y[1] * sigf(y[1])); w.y = cvt_pk_bf16(y[2] * sigf(y[2]), y[3] * sigf(y[3]));
            *(v2u*)(U1 + (size_t)(r0 + r) * 1024 + ch) = w; }
    }
    __syncthreads();
}

__device__ __forceinline__ void phase_router(const Frame& F, const float* x1, const float* g, const float* modl, const float* wr, bf16* H2, unsigned* BC, unsigned* TOK) {
    const int TPB = (RL + F.G - 1) / F.G, tbase = F.vcu * TPB;
    LAS int* le = (LAS int*)F.lds;
    for (int tl = F.wave; tl < TPB; tl += 8) {
        const int row = tbase + tl;
        if (row >= RL) { if (F.lane == 0) { le[tl * 2] = -1; le[tl * 2 + 1] = -1; } continue; }
        const float* src = x1 + (size_t)row * 1024;
        f32x4 v[4]; float ss = 0.f;
#pragma unroll
        for (int j = 0; j < 4; ++j) { v[j] = *(const f32x4*)(src + 4 * (F.lane + 64 * j)); ss += (v[j][0] * v[j][0] + v[j][1] * v[j][1]) + (v[j][2] * v[j][2] + v[j][3] * v[j][3]); }
        const float rinv = 1.f / sqrtf(wave_sum(ss) * (1.f / 1024.f) + EPS);
        const float* sh = modl + (row >> 12) * 6144 + 3 * 1024; const float* sc = sh + 1024;
        float lg[8] = {0, 0, 0, 0, 0, 0, 0, 0};
#pragma unroll
        for (int j = 0; j < 4; ++j) { const int col = 4 * (F.lane + 64 * j); const f32x4 gg = *(const f32x4*)(g + col), s4 = *(const f32x4*)(sc + col), h4 = *(const f32x4*)(sh + col);
            const f32x4 y = v[j] * rinv * gg * (1.f + s4) + h4; v2u w; w.x = cvt_pk_bf16(y[0], y[1]); w.y = cvt_pk_bf16(y[2], y[3]); *(v2u*)(H2 + (size_t)row * 1024 + col) = w;
#pragma unroll
            for (int e4 = 0; e4 < 4; ++e4) { const f32x4 wa = *(const f32x4*)(wr + (size_t)(col + e4) * 8), wb = *(const f32x4*)(wr + (size_t)(col + e4) * 8 + 4);
#pragma unroll
                for (int e = 0; e < 4; ++e) { lg[e] += y[e4] * wa[e]; lg[4 + e] += y[e4] * wb[e]; } } }
#pragma unroll
        for (int e = 0; e < 8; ++e) lg[e] = wave_sum(lg[e]);
        if (F.lane == 0) {
            int e0 = 0; float v0 = lg[0];
#pragma unroll
            for (int e = 1; e < 8; ++e) if (lg[e] > v0) { v0 = lg[e]; e0 = e; }
            int e1 = e0 == 0 ? 1 : 0; float v1 = lg[e1];
#pragma unroll
            for (int e = 0; e < 8; ++e) if (e != e0 && lg[e] > v1) { v1 = lg[e]; e1 = e; }
            const float w0 = 1.f / (1.f + __expf(v1 - v0)), w1 = 1.f - w0;
            unsigned* tk = TOK + (size_t)row * 8; tk[0] = (unsigned)e0; tk[1] = (unsigned)e1; tk[4] = __float_as_uint(w0); tk[5] = __float_as_uint(w1);
            le[tl * 2] = e0; le[tl * 2 + 1] = e1;
        }
    }
    __syncthreads();
    if (F.tid < 8) { unsigned c = 0; for (int tl = 0; tl < TPB; ++tl) c += (le[tl * 2] == F.tid) + (le[tl * 2 + 1] == F.tid); BC[F.vcu * 8 + F.tid] = c; }
    __syncthreads();
}
__device__ __forceinline__ void phase_moe_lists(const Frame& F, const unsigned* BC, unsigned* cnt, unsigned* TOK, int* slist) {
    const int TPB = (RL + F.G - 1) / F.G, tbase = F.vcu * TPB;
    LAS int* le = (LAS int*)F.lds; LAS unsigned* tot = (LAS unsigned*)(F.lds + 4096); LAS unsigned* pre = tot + 8;
    for (int i = F.tid; i < TPB * 2; i += 512) { const int row = tbase + (i >> 1); le[i] = row < RL ? (int)TOK[(size_t)row * 8 + (i & 1)] : -1; }
    LAS unsigned* bcl = pre + 8;
    for (int i = F.tid; i < F.G * 8; i += 512) bcl[i] = BC[i];
    __syncthreads();
    if (F.tid < 8) { unsigned t = 0, p = 0; for (int b = 0; b < F.G; ++b) { const unsigned c = bcl[b * 8 + F.tid]; t += c; p += (b < F.vcu) ? c : 0u; } tot[F.tid] = t; pre[F.tid] = p; }
    __syncthreads();
    if (F.tid < 8) {
        unsigned run = pre[F.tid]; for (int e = 0; e < F.tid; ++e) run += tot[e];
        if (F.vcu == 0) cnt[64 * F.tid] = tot[F.tid];
        for (int tl = 0; tl < TPB; ++tl) { const int row = tbase + tl;
            if (le[tl * 2] == F.tid) { TOK[(size_t)row * 8 + 6] = run; slist[run] = row; ++run; }
            if (le[tl * 2 + 1] == F.tid) { TOK[(size_t)row * 8 + 7] = run; slist[run] = row; ++run; } }
    }
    __syncthreads();
}
__device__ __forceinline__ int moe_build_table(const Frame& F, const unsigned* cnt, LAS int* tab) {
    LAS int* scan = tab + 4 * 160; LAS int* offl = scan + 132;
    if (F.tid == 0) { int o = 0; for (int e = 0; e < 8; ++e) { offl[e] = o; o += (int)__hip_atomic_load(cnt + 64 * e, __ATOMIC_RELAXED, __HIP_MEMORY_SCOPE_AGENT); } offl[8] = o; }
    __syncthreads();
    int nmine = 0;
    if (F.tid < 128) { const int base = F.tid * 256;
        for (int e = 0; e < 8; ++e) { const int lo = max(base, offl[e]), hi = min(base + 256, offl[e + 1]); if (lo < hi) ++nmine; }
        scan[F.tid] = nmine; }
    __syncthreads();
    if (F.tid == 0) { int o = 0; for (int t = 0; t < 128; ++t) { const int n = scan[t]; scan[t] = o; o += n; } scan[128] = o; }
    __syncthreads();
    if (F.tid < 128) { const int base = F.tid * 256; int o = scan[F.tid];
        for (int e = 0; e < 8; ++e) { const int lo = max(base, offl[e]), hi = min(base + 256, offl[e + 1]); if (lo < hi) { tab[o * 4 + 0] = F.tid; tab[o * 4 + 1] = e; tab[o * 4 + 2] = lo; tab[o * 4 + 3] = hi; ++o; } } }
    __syncthreads();
    return scan[128];
}
__device__ __forceinline__ void phase_moe_final(const Frame& F, float* out, const bf16* Ys, const unsigned* TOK, const float* gate5) {
    const int gw = F.vcu * 8 + F.wave, NGW = F.G * 8;
    for (int row = gw; row < RL; row += 2 * NGW) {
        const int row2 = (row + NGW < RL) ? row + NGW : row;
        const unsigned* tka = TOK + (size_t)row * 8; const unsigned* tkb = TOK + (size_t)row2 * 8;
        const float wa0 = __uint_as_float(tka[4]), wa1 = __uint_as_float(tka[5]), wb0 = __uint_as_float(tkb[4]), wb1 = __uint_as_float(tkb[5]);
        const size_t pa0 = tka[6], pa1 = tka[7], pb0 = tkb[6], pb1 = tkb[7];
        const float* ga = gate5 + (row >> 12) * 6144; const float* gb = gate5 + (row2 >> 12) * 6144;
        v2u ya0[4], ya1[4], yb0[4], yb1[4]; f32x4 xa[4], xb[4];
#pragma unroll
        for (int j = 0; j < 4; ++j) { const int col = 4 * (F.lane + 64 * j);
            ya0[j] = *(const v2u*)(Ys + pa0 * 1024 + col); ya1[j] = *(const v2u*)(Ys + pa1 * 1024 + col); yb0[j] = *(const v2u*)(Ys + pb0 * 1024 + col); yb1[j] = *(const v2u*)(Ys + pb1 * 1024 + col);
            xa[j] = *(const f32x4*)(out + (size_t)row * 1024 + col); xb[j] = *(const f32x4*)(out + (size_t)row2 * 1024 + col); }
#pragma unroll
        for (int j = 0; j < 4; ++j) { const int col = 4 * (F.lane + 64 * j); const f32x4 gga = *(const f32x4*)(ga + col), ggb = *(const f32x4*)(gb + col);
            f32x4 x = xa[j];
            x[0] += gga[0] * (wa0 * bflo(ya0[j].x) + wa1 * bflo(ya1[j].x)); x[1] += gga[1] * (wa0 * bfhi(ya0[j].x) + wa1 * bfhi(ya1[j].x)); x[2] += gga[2] * (wa0 * bflo(ya0[j].y) + wa1 * bflo(ya1[j].y)); x[3] += gga[3] * (wa0 * bfhi(ya0[j].y) + wa1 * bfhi(ya1[j].y));
            *(f32x4*)(out + (size_t)row * 1024 + col) = x;
            if (row2 != row) { f32x4 y = xb[j];
                y[0] += ggb[0] * (wb0 * bflo(yb0[j].x) + wb1 * bflo(yb1[j].x)); y[1] += ggb[1] * (wb0 * bfhi(yb0[j].x) + wb1 * bfhi(yb1[j].x)); y[2] += ggb[2] * (wb0 * bflo(yb0[j].y) + wb1 * bflo(yb1[j].y)); y[3] += ggb[3] * (wb0 * bfhi(yb0[j].y) + wb1 * bfhi(yb1[j].y));
                *(f32x4*)(out + (size_t)row2 * 1024 + col) = y; } }
    }
}

#ifndef REP_MASK
#define REP_MASK 0u
#endif
#define REP(j) (1 + ((REP_MASK >> (j)) & 1u))
#ifndef PH_MASK
#define PH_MASK 0xffffffffu
#endif
#define IN(k) (lo <= (k) && (k) < hi)
#define ON(j) ((PH_MASK >> (j)) & 1u)
#define SEAM(k) do { if (IN(k) && IN((k) + 1)) xcd_barrier(bar); } while (0)
template <int l>
__device__ __forceinline__ void layer_body(const Frame& F, const Args& a, const XcdBarrier& bar, unsigned char* ws, unsigned* ctl, const int lo, const int hi) {
    const int G = F.G, cb = (int)blockIdx.x;
    const float* MOD = (const float*)(ws + WS_MOD);
    bf16* A0 = (bf16*)(ws + WS_A0); bf16* A1 = (bf16*)(ws + WS_A1); bf16* A2 = (bf16*)(ws + WS_A2); bf16* A3 = (bf16*)(ws + WS_A3); bf16* A4 = (bf16*)(ws + WS_A4); bf16* A5 = (bf16*)(ws + WS_A5);
    float* XB = (float*)(ws + WS_XB);
    {
        const int pb = 1 + l * 9;
        const float* modl = MOD + (size_t)l * 5 * 6144;
        const float* xs_lat = l == 0 ? a.in[I_X] : XB; const float* xs_ctx = l == 0 ? a.in[I_CTX] : XB + (size_t)RL * 1024;
        if (ON(1) && IN(pb + 0)) for (int rep_ = 0; rep_ < (int)REP(1); ++rep_) phase_rmsmod(F, xs_lat, xs_ctx, R, a.in[I_GMIX] + l * 1024, modl, 0, A0);
        SEAM(pb + 0);
        if (ON(2) && IN(pb + 1)) {
            SchedPlain S{(const char*)A0, (const char*)(ws + WS_WIN + (size_t)l * 14 * MiB), (l == 0 ? R : RL) / 256, INW / 256, 1024, G, cb};
            EpiInProj E{A1, A2, A3, A4, A5, a.in[I_QG] + l * 64, a.in[I_KG] + l * 64, (const float*)(ws + WS_ROPE)};
            for (int rep_ = 0; rep_ < (int)REP(2); ++rep_) run_gemm<false>(F.lds, 1024, S, E);
            if (l == 1) {
                for (int t = F.vcu; t < 512; t += G) { const int tm = t >> 5, tn = t & 31; Unit u{};
                    gemm_small_tile(F.lds, A0 + (size_t)(RL + 64 * tm) * 1024, (const bf16*)(ws + WS_WIN + (size_t)14 * MiB) + (size_t)(1024 + 64 * tn) * 1024, 1024, RL + 64 * tm, 1024 + 64 * tn, u, E); }
            }
        }
        SEAM(pb + 1);
        if (ON(3) && IN(pb + 2)) {
#if FAST_GEMM
            if (l == 1) phase_qknorm(F, A1, A2, a.in[I_QG] + l * 64, a.in[I_KG] + l * 64, (const float*)(ws + WS_ROPE), 1);
#else
            phase_qknorm(F, A1, A2, a.in[I_QG] + l * 64, a.in[I_KG] + l * 64, (const float*)(ws + WS_ROPE), 0);
#endif
#ifndef SKIP_CONV
            for (int rep_ = 0; rep_ < (int)REP(3); ++rep_) phase_conv(F, A4, A0, a.in[I_DWW] + (size_t)l * CK * 1024, a.in[I_DWB] + l * 1024, a.in[I_CLNG] + l * 1024, a.in[I_CLNB] + l * 1024, l == 0 ? R : RL);
#endif
        }
        SEAM(pb + 2);
        if (ON(4) && IN(pb + 3)) {
#ifndef SKIP_ATTN
#if FAST_ATTN
#ifdef ATT_XVAR
            attn_fast<ATT_XVAR>(F, A1, A2, A3, A4, a.in[I_SUBLN] + l * 128, (const float*)(ws + WS_LAM) + l * 2, l == 0);
#endif
            attn16(F, A1, A2, A3, A4, a.in[I_SUBLN] + l * 128, (const float*)(ws + WS_LAM) + l * 2, l == 0);
#else
            attn_naive(F, A1, A2, A3, A4, a.in[I_SUBLN] + l * 128, (const float*)(ws + WS_LAM) + l * 2, l == 0);
#endif
#endif
        }
        SEAM(pb + 3);
        if (ON(5) && IN(pb + 4)) {
            SchedMerge S{(const char*)A4, (const char*)(ws + WS_WA + (size_t)l * 6 * MiB), (const char*)A0, (const char*)(ws + WS_WC + (size_t)l * 6 * MiB), RL / 256, 4, 1024, G, cb};
            EpiMerge E{A5, A2, A1};
            for (int rep_ = 0; rep_ < (int)REP(5); ++rep_) run_gemm<false>(F.lds, 1024, S, E);
            if (l == 0) {
                for (int t = F.vcu; t < 256; t += G) { const int tm = t >> 4, tn = t & 15; Unit u{};
                    u.aux = 0; gemm_small_tile(F.lds, A4 + (size_t)(RL + 64 * tm) * 1024, (const bf16*)(ws + WS_WA) + (size_t)(64 * tn) * 1024, 1024, RL + 64 * tm, 64 * tn, u, E);
                    u.aux = 1; gemm_small_tile(F.lds, A0 + (size_t)(RL + 64 * tm) * 1024, (const bf16*)(ws + WS_WC) + (size_t)(64 * tn) * 1024, 1024, RL + 64 * tm, 64 * tn, u, E); }
            }
        }
        SEAM(pb + 4);
        if (ON(6) && IN(pb + 5)) {
            SchedPlain S{(const char*)A1, (const char*)(ws + WS_WO + (size_t)l * 6 * MiB), RL / 256, 4, 1024, G, cb};
            EpiResid E{xs_lat, xs_ctx, l == 0 ? XB : a.out, modl + 2 * 1024};
            for (int rep_ = 0; rep_ < (int)REP(6); ++rep_) run_gemm<false>(F.lds, 1024, S, E);
            if (l == 0) { for (int t = F.vcu; t < 256; t += G) { const int tm = t >> 4, tn = t & 15; Unit u{};
                    gemm_small_tile(F.lds, A1 + (size_t)(RL + 64 * tm) * 1024, (const bf16*)(ws + WS_WO) + (size_t)(64 * tn) * 1024, 1024, RL + 64 * tm, 64 * tn, u, E); } }
        }
        SEAM(pb + 5);
        if (l == 0) {
            if (ON(7) && IN(pb + 6)) for (int rep_ = 0; rep_ < (int)REP(7); ++rep_) phase_rmsmod(F, XB, XB + (size_t)RL * 1024, R, a.in[I_GFFN], modl, 3, A0);
            SEAM(pb + 6);
            if (ON(8) && IN(pb + 7)) {
                SchedPlain S{(const char*)A0, (const char*)(ws + WS_WGU0), R / 256, 2 * DFF / 256, 1024, G, cb};
                EpiSwiglu E{A1, DFF};
                for (int rep_ = 0; rep_ < (int)REP(8); ++rep_) run_gemm<false>(F.lds, 1024, S, E);
            }
            SEAM(pb + 7);
            if (ON(9) && IN(pb + 8)) {
                SchedPlain S{(const char*)A1, (const char*)(ws + WS_WD0), RL / 256, 4, DFF, G, cb};
                EpiResid E{XB, XB + (size_t)RL * 1024, XB, modl + 5 * 1024};
                run_gemm<false>(F.lds, DFF, S, E);
                for (int t = F.vcu; t < 256; t += G) { const int tm = t >> 4, tn = t & 15; Unit u{};
                    gemm_small_tile(F.lds, A1 + (size_t)(RL + 64 * tm) * DFF, (const bf16*)(ws + WS_WD0) + (size_t)(64 * tn) * DFF, DFF, RL + 64 * tm, 64 * tn, u, E); }
            }
            SEAM(pb + 8);
        } else {
            unsigned* cnt = ctl + CW_CNT; unsigned* TOK = (unsigned*)(ws + WS_TOK); int* slist = (int*)(ws + WS_SLIST);
            LAS int* tab = (LAS int*)(F.lds + MOETAB_OFF);
#ifndef SKIP_ROUTER
            if (ON(16) && IN(16)) phase_router(F, a.out, a.in[I_GFFN] + 1024, modl, a.in[I_WR], A0, (unsigned*)(ws + WS_BC), TOK);
#endif
            SEAM(16);
            if (ON(17) && IN(17)) phase_moe_lists(F, (const unsigned*)(ws + WS_BC), cnt, TOK, slist);
            SEAM(17);
            if (ON(18) && IN(18)) {
                const int NU = moe_build_table(F, cnt, tab);
                SchedMoe S{(const char*)A0, (const char*)(ws + WS_WEGU), slist, tab, NU, 2 * DFE / 256, 1024, G, cb, (size_t)2 * DFE * 1024 * 2, 1, NU * (2 * DFE / 256)};
                EpiSwiglu E{A1, DFE};
                for (int rep_ = 0; rep_ < (int)REP(18); ++rep_) run_gemm<true>(F.lds, 1024, S, E);
            }
            SEAM(18);
            if (ON(19) && IN(19)) {
                const int NU = moe_build_table(F, cnt, tab);
                const int total = NU * 4; int whole = (total / G) * G, left = total - whole;
                if (left > 0) { whole = total; left = 0; }
                SchedMoe S{(const char*)A1, (const char*)(ws + WS_WED), slist, tab, NU, 4, DFE, G, cb, (size_t)1024 * DFE * 2, 0, whole};
                EpiBf16Plain E{(bf16*)XB, 1024};
                for (int rep_ = 0; rep_ < (int)REP(19); ++rep_) run_gemm<false>(F.lds, DFE, S, E);
                for (int sidx = F.vcu; sidx < left * 16; sidx += G) {
                    const int L = whole + (sidx >> 4), sm = (sidx >> 2) & 3, sn = sidx & 3; int pm, pn; tile_of(L, NU, 4, pm, pn);
                    Unit u{}; const int tile = tab[pm * 4 + 0], e = tab[pm * 4 + 1]; u.lo = tab[pm * 4 + 2]; u.hi = tab[pm * 4 + 3];
                    const int r0 = tile * 256 + 64 * sm;
                    if (r0 + 64 > u.lo && r0 < u.hi)
                        gemm_small_tile<true>(F.lds, A1 + (size_t)r0 * DFE, (const bf16*)(ws + WS_WED) + ((size_t)e * 1024 + pn * 256 + 64 * sn) * DFE, DFE, r0, pn * 256 + 64 * sn, u, E);
                }
            }
            SEAM(19);
            if (ON(20) && IN(20)) phase_moe_final(F, a.out, (const bf16*)XB, TOK, modl + 5 * 1024);
        }
        }
}

constexpr int N_PHASES = 21;
__global__ void __launch_bounds__(512, 2) fwd_kernel(Args a) {
    extern __shared__ __attribute__((aligned(16))) unsigned char lds_raw[];
    Frame F; F.lds = (LAS unsigned char*)lds_raw; F.tid = threadIdx.x; F.lane = F.tid & 63; F.wave = __builtin_amdgcn_readfirstlane(F.tid >> 6);
    F.G = gridDim.x; { const int bx = blockIdx.x; F.vcu = (F.G % 8 == 0) ? (bx % 8) * (F.G / 8) + bx / 8 : bx; }
    unsigned char* ws = a.ws;
    unsigned* ctl = (unsigned*)(ws + WS_CTL);
    for (int u = F.tid; u < (LDS_BYTES - LDSCTL_OFF) / 4; u += 512) ((LAS unsigned*)(F.lds + LDSCTL_OFF))[u] = 0u;
    __syncthreads();
    volatile LAS unsigned* MISC = (volatile LAS unsigned*)(F.lds + MISC_OFF);
    XcdBarrier bar = xcd_barrier_post(ctl + CW_BAR, MISC + 8);
    const int lo = a.ph_lo, hi = a.ph_hi;

    const int G = F.G, cb = (int)blockIdx.x;
    const float* MOD = (const float*)(ws + WS_MOD);
    bf16* A0 = (bf16*)(ws + WS_A0); bf16* A1 = (bf16*)(ws + WS_A1); bf16* A2 = (bf16*)(ws + WS_A2); bf16* A3 = (bf16*)(ws + WS_A3); bf16* A4 = (bf16*)(ws + WS_A4); bf16* A5 = (bf16*)(ws + WS_A5);
    float* XB = (float*)(ws + WS_XB);

    #ifndef SKIP_PRO
    if (ON(0) && IN(0)) { for (int rep_ = 0; rep_ < (int)REP(0); ++rep_) phase_prologue(F, a); }
#endif
    SEAM(0);

    layer_body<0>(F, a, bar, ws, ctl, lo, hi);
    layer_body<1>(F, a, bar, ws, ctl, lo, hi);
#undef IN
#undef SEAM
}

extern "C" void kernel_launch(void* const* d_in, const int* in_sizes, int n_in, void* d_out, int out_size, void* d_ws, size_t ws_size, hipStream_t stream) {
    static int grid = 0;
    if (grid == 0) {
        if (n_in != N_IN || out_size != RL * D || ws_size < WS_END) { fprintf(stderr, "kernel_launch: unexpected shapes (n_in %d out %d ws %zu)\n", n_in, out_size, ws_size); grid = -1; return; }
        int dev = 0, cus = 0, per_cu = 0;
        if (hipGetDevice(&dev) != hipSuccess || hipDeviceGetAttribute(&cus, hipDeviceAttributeMultiprocessorCount, dev) != hipSuccess) { grid = -1; return; }
        if (hipFuncSetAttribute((const void*)fwd_kernel, hipFuncAttributeMaxDynamicSharedMemorySize, LDS_BYTES) != hipSuccess) { fprintf(stderr, "kernel_launch: hipFuncSetAttribute failed\n"); grid = -1; return; }
        if (hipOccupancyMaxActiveBlocksPerMultiprocessor(&per_cu, (const void*)fwd_kernel, 512, LDS_BYTES) != hipSuccess || per_cu < 1) fprintf(stderr, "kernel_launch: occupancy query reports %d\n", per_cu);
        (void)hipGetLastError();
        grid = cus;
    }
    if (grid < 0) return;
    (void)hipMemsetAsync((char*)d_ws + WS_CTL, 0, CTL_ZERO_BYTES, stream);
    Args a{};
    for (int i = 0; i < N_IN; ++i) a.in[i] = (const float*)d_in[i];
    a.out = (float*)d_out; a.ws = (unsigned char*)d_ws; a.ph_lo = 0; a.ph_hi = N_PHASES;
    hipLaunchKernelGGL(fwd_kernel, dim3(grid), dim3(512), LDS_BYTES, stream, a);
}
```

```cpp
#include <hip/hip_runtime.h>
#include <cstdio>
#include <cstdint>

#ifndef FAST_GEMM
#define FAST_GEMM 1
#endif
#ifndef FAST_ATTN
#define FAST_ATTN 1
#define ATT_STAGGER 0
#endif

#define GAS __attribute__((address_space(1)))
#define LAS __attribute__((address_space(3)))
typedef unsigned short bf16;
typedef unsigned v4u __attribute__((ext_vector_type(4)));
typedef unsigned v2u __attribute__((ext_vector_type(2)));
typedef float f32x4 __attribute__((ext_vector_type(4)));
typedef float f32x2 __attribute__((ext_vector_type(2)));
typedef float f32x16 __attribute__((ext_vector_type(16)));
typedef short bf16x8 __attribute__((ext_vector_type(8)));
typedef short s16x4 __attribute__((ext_vector_type(4)));

constexpr int D = 1024, NB = 4, SEQ = 4096, CTXL = 256, TK = SEQ + CTXL, RL = NB * SEQ, RC = NB * CTXL, R = RL + RC;
constexpr int NH = 8, HD = 64, VD = 128, INW = 7168, DFF = 2816, NE = 8, DFE = 3584, CK = 31;
constexpr float EPS = 1e-6f;
constexpr float QSCALE = 0.125f * 1.4426950408889634f;
enum { I_X = 0, I_C, I_CTX, I_CCTX, I_WMOD, I_BMOD, I_GMIX, I_WIN, I_QG, I_KG, I_LQ1, I_LK1, I_LQ2, I_LK2, I_SUBLN, I_WATTNO, I_DWW, I_DWB, I_CLNG, I_CLNB, I_WCONVO, I_WOUT, I_GFFN,
       I_WFFG, I_WFFU, I_WFFD, I_WR, I_WEG, I_WEU, I_WED, N_IN };

constexpr size_t MiB = 1u << 20;
constexpr size_t WS_CTL = 0, CTL_ZERO_BYTES = 1 * MiB;
constexpr size_t WS_MOD = 1 * MiB;
constexpr size_t WS_ROPE = 1 * MiB + 256 * 1024;
constexpr size_t WS_LAM = 1 * MiB + 300 * 1024;
constexpr size_t WS_BC = 1 * MiB + 320 * 1024;
constexpr size_t WS_TOK = 2 * MiB;
constexpr size_t WS_SLIST = 2 * MiB + 512 * 1024;
constexpr size_t WS_WIN = 3 * MiB;
constexpr size_t WS_WA = 31 * MiB, WS_WC = 33 * MiB, WS_WO = 35 * MiB;
constexpr size_t WS_WGU0 = 43 * MiB, WS_WD0 = 54 * MiB;
constexpr size_t WS_WEGU = 60 * MiB, WS_WED = 172 * MiB;
constexpr size_t WS_XB = 228 * MiB;
constexpr size_t WS_A0 = 296 * MiB;
constexpr size_t WS_A1 = 330 * MiB;
constexpr size_t WS_A2 = 364 * MiB;
constexpr size_t WS_A3 = 398 * MiB;
constexpr size_t WS_A4 = 432 * MiB;
constexpr size_t WS_A5 = 466 * MiB;
constexpr size_t WS_END = 554 * MiB;
constexpr int CW_BAR = 4096;
constexpr int CW_CNT = 16384;

constexpr int RING_BYTES = 131072, LDSCTL_OFF = RING_BYTES, MISC_OFF = LDSCTL_OFF + 320, MOETAB_OFF = LDSCTL_OFF + 1024, LDS_BYTES = 147456;

#define LDS_WAIT() asm volatile("s_waitcnt lgkmcnt(0)" ::: "memory")
#define VM_WAIT() asm volatile("s_waitcnt vmcnt(0)" ::: "memory")
typedef float f32x2_t __attribute__((ext_vector_type(2)));
typedef __bf16 bf16x2_t __attribute__((ext_vector_type(2)));
__device__ __forceinline__ unsigned cvt_pk_bf16_pin(float lo, float hi) { unsigned r; asm volatile("v_cvt_pk_bf16_f32 %0, %1, %2" : "=v"(r) : "v"(lo), "v"(hi)); return r; }
__device__ __forceinline__ unsigned cvt_pk_bf16(float lo, float hi) { const f32x2_t v = {lo, hi}; const bf16x2_t b = __builtin_convertvector(v, bf16x2_t); return __builtin_bit_cast(unsigned, b); }
__device__ __forceinline__ float bflo(unsigned w) { return __uint_as_float(w << 16); }
__device__ __forceinline__ float bfhi(unsigned w) { return __uint_as_float(w & 0xffff0000u); }
__device__ __forceinline__ float sigm(float x) { return 1.f / (1.f + __expf(-x)); }
__device__ __forceinline__ float sigf(float x) { return __builtin_amdgcn_rcpf(1.f + __builtin_amdgcn_exp2f(x * -1.4426950408889634f)); }
__device__ __forceinline__ float wave_sum(float v) {
#pragma unroll
    for (int o = 1; o < 64; o <<= 1) v += __shfl_xor(v, o);
    return v;
}
__device__ __forceinline__ int row_mi(int row) { return row < RL ? (row >> 12) : 4; }
__device__ __forceinline__ int row_b(int row) { return row < RL ? (row >> 12) : ((row - RL) >> 8); }
__device__ __forceinline__ int row_t(int row) { return row < RL ? (CTXL + (row & 4095)) : ((row - RL) & 255); }

#define XB_TMO      128
#define XB_XCNT(j)  (256  + 64 * (j))
#define XB_XSUB(j)  (1280 + 64 * (j))
#define XB_XGEN(j)  (2304 + 64 * (j))
#define XB_TOP      3328
#define XB_TOPGEN   3392
#define XCD_BAR_WORDS 3456
#define XB_SPIN_CAP (1u << 22)
__device__ __forceinline__ unsigned xb_ld(unsigned* p)              { return __hip_atomic_load(p, __ATOMIC_RELAXED, __HIP_MEMORY_SCOPE_AGENT); }
__device__ __forceinline__ unsigned xb_add(unsigned* p, unsigned v) { return __hip_atomic_fetch_add(p, v, __ATOMIC_RELAXED, __HIP_MEMORY_SCOPE_AGENT); }
__device__ __forceinline__ unsigned xb_xcc_id() { return (unsigned)__builtin_amdgcn_s_getreg((3 << 11) | 20) & 0xFu; }
#define XB_SPIN(cond, bar) do { unsigned _sp = 0; while (cond) { __builtin_amdgcn_s_sleep(1); \
    if ((++_sp & 255u) == 0u) { if (xb_ld(&(bar)[XB_TMO])) break; if (_sp > XB_SPIN_CAP) { atomicAdd(&(bar)[XB_TMO], 1u); break; } } } } while (0)
struct XcdBarrier { unsigned* bar; unsigned x; volatile LAS unsigned* st; };
__device__ __forceinline__ XcdBarrier xcd_barrier_post(unsigned* bar, volatile LAS unsigned* st) {
    XcdBarrier b; b.bar = bar; b.x = xb_xcc_id(); b.st = st;
    if (threadIdx.x == 0) (void)xb_add(&bar[XB_XCNT(b.x)], 1u);
    return b;
}
__device__ __forceinline__ void xcd_barrier_complete(unsigned* bar, unsigned x, unsigned& nloc, unsigned& nx) {
    const unsigned G = gridDim.x * gridDim.y * gridDim.z;
    unsigned sum, cnt, mine, sp = 0u;
    for (;;) {
        sum = 0u; cnt = 0u; mine = 0u;
#pragma unroll
        for (unsigned j = 0; j < 16; ++j) { const unsigned c = xb_ld(&bar[XB_XCNT(j)]); sum += c; cnt += (c > 0u) ? 1u : 0u; mine = (j == x) ? c : mine; }
        if (sum == G) break;
        __builtin_amdgcn_s_sleep(1);
        if ((++sp & 255u) == 0u) { if (xb_ld(&bar[XB_TMO])) break; if (sp > XB_SPIN_CAP) { atomicAdd(&bar[XB_TMO], 1u); break; } }
    }
    nloc = mine > 0u ? mine : 1u; nx = cnt > 0u ? cnt : 1u;
}
__device__ __forceinline__ void xcd_barrier(const XcdBarrier& b) {
    asm volatile("s_waitcnt vmcnt(0)" ::: "memory");
    __syncthreads();
    if (threadIdx.x == 0) {
        unsigned* bar = b.bar;
        __builtin_amdgcn_s_waitcnt(0);
        unsigned nloc = b.st[0], nx = b.st[1];
        if (nloc == 0u) { xcd_barrier_complete(bar, b.x, nloc, nx); b.st[0] = nloc; b.st[1] = nx; }
        const unsigned old = xb_add(&bar[XB_XSUB(b.x)], 1u);
        const unsigned gen = old / nloc;
        if (old + 1u == (gen + 1u) * nloc) {
            __builtin_amdgcn_fence(__ATOMIC_RELEASE, "agent");
            asm volatile("s_waitcnt vmcnt(0)" ::: "memory");
            const unsigned og = xb_add(&bar[XB_TOP], 1u);
            const unsigned tg = og / nx;
            if (og + 1u == (tg + 1u) * nx) xb_add(&bar[XB_TOPGEN], 1u);
            else XB_SPIN(xb_ld(&bar[XB_TOPGEN]) == tg, bar);
            __builtin_amdgcn_fence(__ATOMIC_ACQUIRE, "agent");
            xb_add(&bar[XB_XGEN(b.x)], 1u);
            asm volatile("s_waitcnt vmcnt(0)" ::: "memory");
        } else {
            XB_SPIN(xb_ld(&bar[XB_XGEN(b.x)]) == gen, bar);
            __builtin_amdgcn_fence(__ATOMIC_ACQUIRE, "agent");
            asm volatile("s_waitcnt vmcnt(0)" ::: "memory");
        }
    }
    __syncthreads();
}

struct Unit { const char* A; const char* B; const int* rows; int row0, col0, lo, hi, aux; };

__device__ __forceinline__ void tile_of(int wgid, int nM, int nN, int& pm, int& pn) {
    const int nwg = nM * nN;
    { const int q = nwg / 8, r = nwg % 8, xcd = wgid % 8, off = wgid / 8; wgid = (xcd < r ? xcd * (q + 1) : r * (q + 1) + (xcd - r) * q) + off; }
    const int nig = 8 * nN, gid = wgid / nig, fm = gid * 8, gsz = (nM - fm) < 8 ? (nM - fm) : 8;
    pm = fm + ((wgid % nig) % gsz); pn = (wgid % nig) / gsz;
}
struct SchedPlain {
    const char* A; const char* Bt; int nM, nN, K, G, c;
    __device__ __forceinline__ bool next(int i, Unit& u) const {
        const int L = i * G + c; if (L >= nM * nN) return false;
        int pm, pn; tile_of(L, nM, nN, pm, pn);
        u.A = A + (size_t)pm * 256 * K * 2; u.B = Bt + (size_t)pn * 256 * K * 2; u.rows = nullptr; u.row0 = pm * 256; u.col0 = pn * 256; u.lo = 0; u.hi = 0x7fffffff; u.aux = 0; return true;
    }
};
struct SchedMerge {
    const char* A0; const char* B0; const char* A1; const char* B1; int nM, nN, K, G, c;
    __device__ __forceinline__ bool next(int i, Unit& u) const {
        const int L = (i >> 1) * G + c; if (L >= nM * nN) return false;
        int pm, pn; tile_of(L, nM, nN, pm, pn); const int pass = i & 1;
        u.A = (pass ? A1 : A0) + (size_t)pm * 256 * K * 2; u.B = (pass ? B1 : B0) + (size_t)pn * 256 * K * 2; u.rows = nullptr; u.row0 = pm * 256; u.col0 = pn * 256; u.lo = 0; u.hi = 0x7fffffff; u.aux = pass; return true;
    }
};
struct SchedMoe {
    const char* A; const char* Bt; const int* slist; const LAS int* tab; int NU, nN, K, G, c; size_t bstride; int gather; int Lmax;
    __device__ __forceinline__ bool next(int i, Unit& u) const {
        const int L = i * G + c; if (L >= Lmax) return false;
        int pm, pn; tile_of(L, NU, nN, pm, pn);
        const int tile = __builtin_amdgcn_readfirstlane(tab[pm * 4 + 0]), e = __builtin_amdgcn_readfirstlane(tab[pm * 4 + 1]);
        u.lo = __builtin_amdgcn_readfirstlane(tab[pm * 4 + 2]); u.hi = __builtin_amdgcn_readfirstlane(tab[pm * 4 + 3]);
        u.A = gather ? A : A + (size_t)tile * 256 * K * 2; u.rows = gather ? slist + tile * 256 : nullptr;
        u.B = Bt + (size_t)e * bstride + (size_t)pn * 256 * K * 2; u.row0 = tile * 256; u.col0 = pn * 256; u.aux = e; return true;
    }
};

__device__ __forceinline__ int qk_vec_of(int v) { return ((v >> 8) << 2) | ((v >> 5) & 3); }
__device__ __forceinline__ int qk_dim_of(int v) { const int j = v & 31; return (((v >> 7) & 1) << 5) | (((j >> 2) & 1) << 4) | ((j >> 3) << 2) | (j & 3); }
__device__ __forceinline__ int qk_src_col(int v) { return qk_vec_of(v) * 64 + qk_dim_of(v); }
__device__ __forceinline__ v4u pack8(f32x4 a, f32x4 b) { v4u w; w.x = cvt_pk_bf16(a[0], a[1]); w.y = cvt_pk_bf16(a[2], a[3]); w.z = cvt_pk_bf16(b[0], b[1]); w.w = cvt_pk_bf16(b[2], b[3]); return w; }
__device__ __forceinline__ void unpack8(v4u w, f32x4& a, f32x4& b) { a = (f32x4){bflo(w.x), bfhi(w.x), bflo(w.y), bfhi(w.y)}; b = (f32x4){bflo(w.z), bfhi(w.z), bflo(w.w), bfhi(w.w)}; }
struct EpiInProj {
    static constexpr bool ROW16 = true;
    bf16 *Q, *K, *V, *U0, *GT; const float *qg, *kg, *rope;
    __device__ __forceinline__ void store8(const Unit&, int row, int col, f32x4 v0, f32x4 v1) const {
        if (col < 3072) {
            const int b = row_b(row), t = row_t(row);
            if (col < 2048) {
                const int vec = qk_vec_of(col), d0 = qk_dim_of(col); bf16* base = (vec < 16 ? Q : K) + ((size_t)(((b * NH) * 2 + (vec & 15)) * TK + t) * 64 + d0);
                v2u w0, w1; w0.x = cvt_pk_bf16(v0[0], v0[1]); w0.y = cvt_pk_bf16(v0[2], v0[3]); w1.x = cvt_pk_bf16(v1[0], v1[1]); w1.y = cvt_pk_bf16(v1[2], v1[3]);
                *(v2u*)base = w0; *(v2u*)(base + 16) = w1; }
            else { const v4u w = pack8(v0, v1); const int cc = col - 2048, h = cc >> 7, dv = cc & 127; *(v4u*)(V + ((size_t)((b * NH + h) * TK + t) * 128 + dv)) = w; }
        } else if (col < 5120) {
            const int ch = (col - 3072) >> 1; v2u w; w.x = cvt_pk_bf16(v0[0] * sigf(v1[0]), v0[1] * sigf(v1[1])); w.y = cvt_pk_bf16(v0[2] * sigf(v1[2]), v0[3] * sigf(v1[3]));
            *(v2u*)(U0 + (size_t)row * 1024 + ch) = w;
        } else {
            f32x4 a, b;
#pragma unroll
            for (int j = 0; j < 4; ++j) { a[j] = sigf(v0[j]); b[j] = sigf(v1[j]); }
            *(v4u*)(GT + (size_t)row * 2048 + (col - 5120)) = pack8(a, b);
        }
    }
    __device__ __forceinline__ void store16(const Unit& u, int row, int col, f32x4 a0, f32x4 a1, f32x4 b0, f32x4 b1) const {
        if (col >= 2048) { store8(u, row, col, a0, a1); store8(u, row, col + 128, b0, b1); return; }
        const int b = row_b(row), t = row_t(row), vec = qk_vec_of(col), q4 = ((col & 31) >> 3) << 2;
        float ss = 0.f;
#pragma unroll
        for (int r = 0; r < 4; ++r) ss += (a0[r] * a0[r] + a1[r] * a1[r]) + (b0[r] * b0[r] + b1[r] * b1[r]);
        ss += __shfl_xor(ss, 16); ss += __shfl_xor(ss, 32);
        const float rinv = 1.f / sqrtf(ss * (1.f / 64.f) + EPS) * (vec < 16 ? QSCALE : 1.f);
        const float* g = (vec < 16 ? qg : kg) + q4;
        a0 = a0 * rinv * *(const f32x4*)g; a1 = a1 * rinv * *(const f32x4*)(g + 16); b0 = b0 * rinv * *(const f32x4*)(g + 32); b1 = b1 * rinv * *(const f32x4*)(g + 48);
        if (t >= CTXL) { const int sq = t - CTXL; const float* c0p = rope + (sq >> 6) * 16 + q4; const float* c1p = rope + (sq & 63) * 16 + q4;
            const f32x4 c0 = *(const f32x4*)c0p, s0 = *(const f32x4*)(c0p + 1024), c1 = *(const f32x4*)c1p, s1 = *(const f32x4*)(c1p + 1024);
            const f32x4 x0 = a0 * c0 - a1 * s0, x1 = a1 * c0 + a0 * s0, y0 = b0 * c1 - b1 * s1, y1 = b1 * c1 + b0 * s1; a0 = x0; a1 = x1; b0 = y0; b1 = y1; }
        bf16* base = (vec < 16 ? Q : K) + ((size_t)(((b * NH) * 2 + (vec & 15)) * TK + t) * 64 + q4);
        v2u w; w.x = cvt_pk_bf16(a0[0], a0[1]); w.y = cvt_pk_bf16(a0[2], a0[3]); *(v2u*)base = w;
        w.x = cvt_pk_bf16(a1[0], a1[1]); w.y = cvt_pk_bf16(a1[2], a1[3]); *(v2u*)(base + 16) = w;
        w.x = cvt_pk_bf16(b0[0], b0[1]); w.y = cvt_pk_bf16(b0[2], b0[3]); *(v2u*)(base + 32) = w;
        w.x = cvt_pk_bf16(b1[0], b1[1]); w.y = cvt_pk_bf16(b1[2], b1[3]); *(v2u*)(base + 48) = w;
    }
};
struct EpiMerge {
    static constexpr bool ROW16 = false;
    const bf16* GT; bf16* TF; bf16* M1;
    __device__ __forceinline__ void store8(const Unit& u, int row, int col, f32x4 v0, f32x4 v1) const {
        f32x4 g0, g1; unpack8(*(const v4u*)(GT + (size_t)row * 2048 + u.aux * 1024 + col), g0, g1);
        if (u.aux == 0) { *(v4u*)(TF + (size_t)row * 1024 + col) = pack8(g0 * v0, g1 * v1); }
        else { f32x4 t0, t1; unpack8(*(const v4u*)(TF + (size_t)row * 1024 + col), t0, t1); *(v4u*)(M1 + (size_t)row * 1024 + col) = pack8(t0 + g0 * v0, t1 + g1 * v1); }
    }
};
struct EpiResid {
    static constexpr bool ROW16 = false;
    const float* src_lat; const float* src_ctx; float* dst; const float* gate;
    __device__ __forceinline__ void store8(const Unit&, int row, int col, f32x4 v0, f32x4 v1) const {
        const float* s = (row < RL ? src_lat + (size_t)row * 1024 : src_ctx + (size_t)(row - RL) * 1024) + col; const float* g = gate + row_mi(row) * 6144 + col;
        const f32x4 s0 = *(const f32x4*)s, s1 = *(const f32x4*)(s + 4), g0 = *(const f32x4*)g, g1 = *(const f32x4*)(g + 4);
        float* d = dst + (size_t)row * 1024 + col; *(f32x4*)d = s0 + g0 * v0; *(f32x4*)(d + 4) = s1 + g1 * v1;
    }
};
struct EpiSwiglu {
    static constexpr bool ROW16 = false;
    bf16* ACT; int ld;
    __device__ __forceinline__ void store8(const Unit&, int row, int col, f32x4 v0, f32x4 v1) const {
        v2u w; w.x = cvt_pk_bf16(v0[0] * sigf(v0[0]) * v1[0], v0[1] * sigf(v0[1]) * v1[1]); w.y = cvt_pk_bf16(v0[2] * sigf(v0[2]) * v1[2], v0[3] * sigf(v0[3]) * v1[3]);
        *(v2u*)(ACT + (size_t)row * ld + (col >> 1)) = w;
    }
};
struct EpiBf16Plain { bf16* O; int ld;
    static constexpr bool ROW16 = false;
    __device__ __forceinline__ void store8(const Unit&, int row, int col, f32x4 v0, f32x4 v1) const { *(v4u*)(O + (size_t)row * ld + col) = pack8(v0, v1); }
};

template <class Epi, class Sched>
__device__ __forceinline__ void gemm_naive(LAS unsigned char* lds, const int K, const Sched& S, const Epi& E) {
    LAS float* As = (LAS float*)lds; LAS float* Bs = As + 32 * 132;
    const int tid = threadIdx.x, ty = tid >> 4, tx = tid & 15, lr = tid >> 2, kc = (tid & 3) * 8;
    Unit u;
    for (int i = 0; S.next(i, u); ++i) {
        for (int sub = 0; sub < 4; ++sub) {
            const int rm = (sub >> 1) * 128, cn = (sub & 1) * 128;
            const size_t arow = u.rows ? (size_t)u.rows[rm + lr] : (size_t)(rm + lr);
            const bf16* ap = (const bf16*)u.A + arow * K + kc; const bf16* bp = (const bf16*)u.B + (size_t)(cn + lr) * K + kc;
            float acc[4][8];
#pragma unroll
            for (int r = 0; r < 4; ++r)
#pragma unroll
                for (int c = 0; c < 8; ++c) acc[r][c] = 0.f;
            for (int k0 = 0; k0 < K; k0 += 32) {
                const v4u av = *(const v4u*)(ap + k0), bv = *(const v4u*)(bp + k0);
                f32x4 a0, a1, b0, b1; unpack8(av, a0, a1); unpack8(bv, b0, b1);
#pragma unroll
                for (int j = 0; j < 4; ++j) { As[(kc + j) * 132 + lr] = a0[j]; As[(kc + 4 + j) * 132 + lr] = a1[j]; Bs[(kc + j) * 132 + lr] = b0[j]; Bs[(kc + 4 + j) * 132 + lr] = b1[j]; }
                __syncthreads();
#pragma unroll 4
                for (int kk = 0; kk < 32; ++kk) {
                    const f32x4 a = *(const LAS f32x4*)(As + kk * 132 + ty * 4), p = *(const LAS f32x4*)(Bs + kk * 132 + tx * 8), q = *(const LAS f32x4*)(Bs + kk * 132 + tx * 8 + 4);
#pragma unroll
                    for (int r = 0; r < 4; ++r) {
#pragma unroll
                        for (int c = 0; c < 4; ++c) { acc[r][c] += a[r] * p[c]; acc[r][4 + c] += a[r] * q[c]; } }
                }
                __syncthreads();
            }
#pragma unroll
            for (int r = 0; r < 4; ++r) { const int row = u.row0 + rm + ty * 4 + r;
                if (row >= u.lo && row < u.hi) E.store8(u, row, u.col0 + cn + tx * 8, (f32x4){acc[r][0], acc[r][1], acc[r][2], acc[r][3]}, (f32x4){acc[r][4], acc[r][5], acc[r][6], acc[r][7]}); }
        }
    }
}

namespace pg8 {
constexpr int BM = 256, BK = 64, HALF = 128, HTB = HALF * BK * 2, STAGE_BYTES = 8 * HTB;
__device__ __forceinline__ int lds_byte(int r, int c) { const int st = (r >> 4) * 2 + (c >> 5), rr = r & 15, cc = c & 31, ob = rr * 64 + cc * 2; return st * 1024 + (ob ^ (((ob >> 9) & 1) << 5)); }
__device__ __forceinline__ void stage_rc(int b, int& R_, int& C_) { const int st = b / 1024, sb = b % 1024, swz = sb ^ (((sb >> 9) & 1) << 5); R_ = (st >> 1) * 16 + swz / 64; C_ = (st & 1) * 32 + (swz % 64) / 2; }
__device__ __forceinline__ int perm32(int rho) { const int n = rho >> 4, i = rho & 15; return 8 * (i >> 2) + 4 * n + (i & 3); }

template <class Epi, class Sched, bool GATHER>
__device__ __forceinline__ void gemm_phase(LAS unsigned char* lds, const int K, const Sched& S, const Epi& E) {
    const int tid = threadIdx.x, wid = __builtin_amdgcn_readfirstlane(tid >> 6), lane = tid & 63, wr = wid >> 2, wc = wid & 3, fr = lane & 15, fq = lane >> 4;
    const int nt = K / BK;
    int Rr[2], Cc[2]; unsigned voffB[2];
#pragma unroll
    for (int i = 0; i < 2; ++i) { stage_rc(tid * 16 + i * 8192, Rr[i], Cc[i]); const int Rb = (Rr[i] & ~31) + perm32(Rr[i] & 31); voffB[i] = (unsigned)(Rb * K + Cc[i]) * 2u; }
    const size_t kstep = (size_t)(BK * 2), hstep = (size_t)HALF * K * 2;
    const unsigned ldsw = (unsigned)wid * 1024u;
    const int aoff = lds_byte(wr * 64 + fr, fq * 8), boff = lds_byte(wc * 32 + fr, fq * 8);
#define PG8_SA(b, h) (((b) * 2 + (h)) * HTB)
#define PG8_SB(b, h) ((4 + (b) * 2 + (h)) * HTB)
#define PG8_STAGE2(bufoff, gbase, o0, o1) do { \
        __builtin_amdgcn_global_load_lds((const unsigned*)((const char*)(gbase) + (o0)), (LAS unsigned*)(lds + (bufoff) + ldsw), 16, 0, 0); \
        __builtin_amdgcn_global_load_lds((const unsigned*)((const char*)(gbase) + (o1)), (LAS unsigned*)(lds + (bufoff) + ldsw + 8192), 16, 0, 0); } while (0)
#define PG8_STAGEB(bufoff, gbase) PG8_STAGE2(bufoff, gbase, voffB[0], voffB[1])
#define PG8_LDA(dst, b, h) do { _Pragma("unroll") for (int m = 0; m < 4; ++m) _Pragma("unroll") for (int k = 0; k < 2; ++k) dst[m][k] = *(const LAS bf16x8*)(lds + PG8_SA(b, h) + aoff + m * 2048 + k * 1024); } while (0)
#define PG8_LDB(dst, b, h) do { _Pragma("unroll") for (int n = 0; n < 2; ++n) _Pragma("unroll") for (int k = 0; k < 2; ++k) dst[n][k] = *(const LAS bf16x8*)(lds + PG8_SB(b, h) + boff + n * 2048 + k * 1024); } while (0)
#define PG8_MMA(ai, bj, At, Bt) do { __builtin_amdgcn_s_setprio(1); _Pragma("unroll") for (int m = 0; m < 4; ++m) _Pragma("unroll") for (int n = 0; n < 2; ++n) _Pragma("unroll") for (int k = 0; k < 2; ++k) \
        acc[ai][bj][m][n] = __builtin_amdgcn_mfma_f32_16x16x32_bf16(Bt[n][k], At[m][k], acc[ai][bj][m][n], 0, 0, 0); __builtin_amdgcn_s_setprio(0); } while (0)
#define PG8_WAIT_V(n) asm volatile("s_waitcnt vmcnt(" #n ")" ::: "memory")
#define PG8_WAIT_L(n) asm volatile("s_waitcnt lgkmcnt(" #n ")" ::: "memory")
#define PG8_BAR __builtin_amdgcn_s_barrier()
#define PG8_SCHED __builtin_amdgcn_sched_barrier(0)
#define PG8_OFFS(u, o0, o1) do { _Pragma("unroll") for (int _i = 0; _i < 2; ++_i) { \
        if (GATHER && (u).rows) { const unsigned r0_ = (unsigned)(u).rows[Rr[_i]], r1_ = (unsigned)(u).rows[Rr[_i] + HALF]; o0[_i] = (r0_ * (unsigned)K + (unsigned)Cc[_i]) * 2u; o1[_i] = (r1_ * (unsigned)K + (unsigned)Cc[_i]) * 2u; } \
        else { o0[_i] = (unsigned)(Rr[_i] * K + Cc[_i]) * 2u; o1[_i] = o0[_i] + (unsigned)hstep; } } } while (0)
    Unit cur, nxt; int ui = 0;
    if (!S.next(0, cur)) return;
    f32x4 acc[2][2][4][2];
#pragma unroll
    for (int a = 0; a < 2; ++a)
#pragma unroll
        for (int b = 0; b < 2; ++b)
#pragma unroll
            for (int m = 0; m < 4; ++m)
#pragma unroll
                for (int n = 0; n < 2; ++n) acc[a][b][m][n] = (f32x4){0.f, 0.f, 0.f, 0.f};
    bf16x8 At[4][2], B0[2][2], B1[2][2];
    unsigned vA0[2], vA1[2], nA0[2], nA1[2];
    PG8_OFFS(cur, vA0, vA1);
    const char* cA = cur.A; const char* cB = cur.B;
    PG8_STAGEB(PG8_SB(0, 0), cB); PG8_STAGEB(PG8_SB(0, 1), cB + hstep); PG8_STAGE2(PG8_SA(0, 0), cA, vA0[0], vA0[1]); PG8_STAGE2(PG8_SA(0, 1), cA, vA1[0], vA1[1]);
    if (wr == 1) PG8_BAR;
    PG8_WAIT_V(2); PG8_BAR;
    PG8_STAGEB(PG8_SB(1, 0), cB + kstep); PG8_STAGE2(PG8_SA(1, 0), cA + kstep, vA0[0], vA0[1]); PG8_STAGEB(PG8_SB(1, 1), cB + hstep + kstep);
    PG8_WAIT_V(6); PG8_BAR;
    for (;;) {
        const bool has_next = S.next(ui + 1, nxt);
        const char* nA = has_next ? nxt.A : cA; const char* nB = has_next ? nxt.B : cB;
        if (GATHER) { if (has_next) { PG8_OFFS(nxt, nA0, nA1); } else {
#pragma unroll
            for (int i = 0; i < 2; ++i) { nA0[i] = vA0[i]; nA1[i] = vA1[i]; } } }
        for (int t = 0; t < nt; t += 2) {
            const bool last = (t == nt - 2);
            const char* a1 = cA + (size_t)(t + 1) * kstep;
            const char* a2 = last ? nA : cA + (size_t)(t + 2) * kstep; const char* b2 = last ? nB : cB + (size_t)(t + 2) * kstep;
            const char* a3 = a2 + kstep; const char* b3 = b2 + kstep;
            unsigned x00 = vA0[0], x01 = vA0[1], x10 = vA1[0], x11 = vA1[1];
            if (GATHER) { if (last) { x00 = nA0[0]; x01 = nA0[1]; x10 = nA1[0]; x11 = nA1[1]; } }
            PG8_LDB(B0, 0, 0); PG8_LDB(B1, 0, 1); PG8_SCHED; PG8_LDA(At, 0, 0); PG8_STAGE2(PG8_SA(1, 1), a1, vA1[0], vA1[1]);
            PG8_WAIT_V(8); PG8_WAIT_L(0); PG8_BAR; PG8_MMA(0, 0, At, B0); PG8_MMA(0, 1, At, B1); PG8_BAR; PG8_SCHED;
            PG8_LDA(At, 0, 1); PG8_STAGEB(PG8_SB(0, 0), b2); PG8_STAGEB(PG8_SB(0, 1), b2 + hstep); PG8_STAGE2(PG8_SA(0, 0), a2, x00, x01);
            PG8_WAIT_V(8); PG8_WAIT_L(0); PG8_BAR; PG8_MMA(1, 0, At, B0); PG8_MMA(1, 1, At, B1); PG8_BAR; PG8_SCHED;
            PG8_LDB(B0, 1, 0); PG8_LDB(B1, 1, 1); PG8_SCHED; PG8_LDA(At, 1, 0); PG8_STAGE2(PG8_SA(0, 1), a2, x10, x11);
            PG8_WAIT_V(8); PG8_WAIT_L(0); PG8_BAR; PG8_MMA(0, 0, At, B0); PG8_MMA(0, 1, At, B1); PG8_BAR; PG8_SCHED;
            PG8_LDA(At, 1, 1); PG8_STAGEB(PG8_SB(1, 0), b3); PG8_STAGEB(PG8_SB(1, 1), b3 + hstep); PG8_STAGE2(PG8_SA(1, 0), a3, x00, x01);
            PG8_WAIT_V(8); PG8_WAIT_L(0); PG8_BAR; PG8_MMA(1, 0, At, B0); PG8_MMA(1, 1, At, B1); PG8_BAR; PG8_SCHED;
        }
        if (wr == 0) PG8_BAR;
        {
            const int row0 = cur.row0 + wr * 64 + fr, colb = cur.col0 + wc * 32 + 8 * fq;
#pragma unroll
            for (int ai = 0; ai < 2; ++ai)
#pragma unroll
                for (int m = 0; m < 4; ++m) { const int row = row0 + ai * HALF + m * 16;
                    if (row >= cur.lo && row < cur.hi) {
                        if constexpr (Epi::ROW16) E.store16(cur, row, colb, acc[ai][0][m][0], acc[ai][0][m][1], acc[ai][1][m][0], acc[ai][1][m][1]);
                        else {
#pragma unroll
                            for (int bj = 0; bj < 2; ++bj) E.store8(cur, row, colb + bj * HALF, acc[ai][bj][m][0], acc[ai][bj][m][1]); } } }
        }
        if (!has_next) break;
#pragma unroll
        for (int a = 0; a < 2; ++a)
#pragma unroll
            for (int b = 0; b < 2; ++b)
#pragma unroll
                for (int m = 0; m < 4; ++m)
#pragma unroll
                    for (int n = 0; n < 2; ++n) acc[a][b][m][n] = (f32x4){0.f, 0.f, 0.f, 0.f};
        cur = nxt; cA = nA; cB = nB; ++ui;
        if (GATHER) {
#pragma unroll
            for (int i = 0; i < 2; ++i) { vA0[i] = nA0[i]; vA1[i] = nA1[i]; } }
        if (wr == 1) PG8_BAR;
    }
    PG8_WAIT_V(0);
    PG8_BAR;
#undef PG8_SA
#undef PG8_SB
#undef PG8_STAGE2
#undef PG8_STAGEB
#undef PG8_LDA
#undef PG8_LDB
#undef PG8_MMA
#undef PG8_WAIT_V
#undef PG8_WAIT_L
#undef PG8_BAR
#undef PG8_SCHED
#undef PG8_OFFS
}
}


template <bool MASK = false, class Epi>
__device__ __forceinline__ void gemm_small_tile(LAS unsigned char* lds, const bf16* A, const bf16* Bt, int K, int row_abs0, int col_abs0, const Unit& u, const Epi& E) {
    const int tid = threadIdx.x, wid = __builtin_amdgcn_readfirstlane(tid >> 6), lane = tid & 63, fr = lane & 15, fq = lane >> 4;
    const int kw = K >> 3, kbeg = wid * kw;
    f32x4 acc[4][2][2];
#pragma unroll
    for (int m = 0; m < 4; ++m)
#pragma unroll
        for (int g = 0; g < 2; ++g)
#pragma unroll
            for (int n = 0; n < 2; ++n) acc[m][g][n] = (f32x4){0.f, 0.f, 0.f, 0.f};
    const bf16* ap = A + (size_t)fr * K + kbeg + 8 * fq;
    const bf16* bp = Bt + (size_t)(8 * (fr >> 2) + (fr & 3)) * K + kbeg + 8 * fq;
#pragma unroll 4
    for (int k0 = 0; k0 < kw; k0 += 32) {
        bf16x8 af[4], bfr[2][2];
#pragma unroll
        for (int m = 0; m < 4; ++m) af[m] = *(const bf16x8*)(ap + (size_t)(16 * m) * K + k0);
#pragma unroll
        for (int g = 0; g < 2; ++g)
#pragma unroll
            for (int n = 0; n < 2; ++n) bfr[g][n] = *(const bf16x8*)(bp + (size_t)(32 * g + 4 * n) * K + k0);
#pragma unroll
        for (int m = 0; m < 4; ++m)
#pragma unroll
            for (int g = 0; g < 2; ++g)
#pragma unroll
                for (int n = 0; n < 2; ++n) acc[m][g][n] = __builtin_amdgcn_mfma_f32_16x16x32_bf16(bfr[g][n], af[m], acc[m][g][n], 0, 0, 0);
    }
    LAS float* P = (LAS float*)lds + wid * 4096;
#pragma unroll
    for (int m = 0; m < 4; ++m)
#pragma unroll
        for (int g = 0; g < 2; ++g)
#pragma unroll
            for (int n = 0; n < 2; ++n) *(LAS f32x4*)(P + (16 * m + fr) * 64 + 32 * g + 8 * fq + 4 * n) = acc[m][g][n];
    __syncthreads();
    { const int r = tid >> 3, c8 = (tid & 7) * 8; f32x4 v0 = (f32x4){0.f, 0.f, 0.f, 0.f}, v1 = v0;
#pragma unroll
      for (int w = 0; w < 8; ++w) { const LAS float* q = (const LAS float*)lds + w * 4096 + r * 64 + c8; v0 += *(const LAS f32x4*)q; v1 += *(const LAS f32x4*)(q + 4); }
      if (!MASK || (row_abs0 + r >= u.lo && row_abs0 + r < u.hi)) E.store8(u, row_abs0 + r, col_abs0 + c8, v0, v1); }
    __syncthreads();
}

template <bool GATHER, class Epi, class Sched>
__device__ __forceinline__ void run_gemm(LAS unsigned char* lds, int K, const Sched& S, const Epi& E) {
#if FAST_GEMM
    pg8::gemm_phase<Epi, Sched, GATHER>(lds, K, S, E);
#else
    gemm_naive<Epi, Sched>(lds, K, S, E);
    __syncthreads();
#endif
}

struct Args { const float* in[N_IN]; float* out; unsigned char* ws; int ph_lo, ph_hi; };
struct Frame { LAS unsigned char* lds; int tid, lane, wave, vcu, G; };

__device__ __forceinline__ void attn_naive(const Frame& F, const bf16* Q, const bf16* Kb, const bf16* Vb, bf16* ON, const float* subln, const float* lamv, bool with_ctx) {
    LAS float* Qs = (LAS float*)F.lds;
    LAS float* Ks = Qs + 16 * 128;
    LAS float* Vs = Ks + 2 * 64 * 65;
    LAS float* Ps = Vs + 64 * 128;
    const int tid = F.tid, qi = tid >> 5, sl = tid & 31;
    const float lam = lamv[0], oscale = lamv[1];
    const int n_lat = NB * NH * (SEQ / 16), n_ctx = with_ctx ? NB * NH * (CTXL / 16) : 0;
    for (int unit = F.vcu; unit < n_lat + n_ctx; unit += F.G) {
        int b, h, t0, nkeys;
        if (unit < n_lat) { b = unit / (NH * (SEQ / 16)); const int r = unit % (NH * (SEQ / 16)); h = r / (SEQ / 16); t0 = CTXL + (r % (SEQ / 16)) * 16; nkeys = TK; }
        else { const int uu = unit - n_lat; b = uu / (NH * (CTXL / 16)); const int r = uu % (NH * (CTXL / 16)); h = r / (CTXL / 16); t0 = (r % (CTXL / 16)) * 16; nkeys = CTXL; }
        __syncthreads();
        for (int idx = tid; idx < 16 * 128; idx += 512) { const int q = idx >> 7, cd = idx & 127, c = cd >> 6, d = cd & 63;
            Qs[idx] = __uint_as_float((unsigned)Q[(size_t)(((b * NH + h) * 2 + c) * TK + t0 + q) * 64 + d] << 16); }
        float o0[4] = {0, 0, 0, 0}, o1[4] = {0, 0, 0, 0}, l0 = 0.f, l1 = 0.f;
        for (int k0 = 0; k0 < nkeys; k0 += 64) {
            __syncthreads();
            for (int idx = tid; idx < 2 * 64 * 64; idx += 512) { const int c = idx >> 12, key = (idx >> 6) & 63, d = idx & 63;
                Ks[(c * 64 + key) * 65 + d] = __uint_as_float((unsigned)Kb[(size_t)(((b * NH + h) * 2 + c) * TK + k0 + key) * 64 + d] << 16); }
            for (int idx = tid; idx < 64 * 128; idx += 512) { const int key = idx >> 7, dv = idx & 127;
                Vs[idx] = __uint_as_float((unsigned)Vb[(size_t)((b * NH + h) * TK + k0 + key) * 128 + dv] << 16); }
            __syncthreads();
#pragma unroll
            for (int c = 0; c < 2; ++c)
#pragma unroll
                for (int kk = 0; kk < 2; ++kk) { const int key = sl + 32 * kk; float s = 0.f;
                    for (int d = 0; d < 64; ++d) s += Qs[qi * 128 + c * 64 + d] * Ks[(c * 64 + key) * 65 + d];
                    Ps[(c * 16 + qi) * 64 + key] = __builtin_amdgcn_exp2f(s); }
            __syncthreads();
            for (int key = 0; key < 64; ++key) { const float p0 = Ps[qi * 64 + key], p1 = Ps[(16 + qi) * 64 + key]; const f32x4 v = *(const LAS f32x4*)(Vs + key * 128 + sl * 4);
                l0 += p0; l1 += p1;
#pragma unroll
                for (int j = 0; j < 4; ++j) { o0[j] += p0 * v[j]; o1[j] += p1 * v[j]; } }
        }
        const float i0 = 1.f / l0, i1 = lam / l1; float o[4], ss = 0.f;
#pragma unroll
        for (int j = 0; j < 4; ++j) { o[j] = o0[j] * i0 - o1[j] * i1; ss += o[j] * o[j]; }
#pragma unroll
        for (int m = 1; m < 32; m <<= 1) ss += __shfl_xor(ss, m);
        const float rinv = 1.f / sqrtf(ss * (1.f / 128.f) + EPS) * oscale;
        const int t = t0 + qi, row = t >= CTXL ? b * SEQ + (t - CTXL) : RL + b * CTXL + t;
        const f32x4 g = *(const f32x4*)(subln + sl * 4);
        v2u w; w.x = cvt_pk_bf16(o[0] * rinv * g[0], o[1] * rinv * g[1]); w.y = cvt_pk_bf16(o[2] * rinv * g[2], o[3] * rinv * g[3]);
        *(v2u*)(ON + (size_t)row * 1024 + h * 128 + sl * 4) = w;
    }
    __syncthreads();
}


namespace att {
#define SBAR() __builtin_amdgcn_sched_barrier(0)
constexpr int STAGE = 32768, ST_K1 = 8192, ST_V = 16384, OFF_WS = 3 * STAGE;
__device__ __forceinline__ int crow(int r, int hi) { return (r & 3) + 8 * (r >> 2) + 4 * hi; }
__device__ __forceinline__ int v_st(int k, int c) { const int kk = (k & ~0xC) | ((k & 4) << 1) | ((k & 8) >> 1); return ((kk >> 3) * 4 + (c >> 5)) * 512 + ((kk & 7) * 32 + (c & 31)) * 2; }
__device__ __forceinline__ int v_rd_base(int lane) { return ((lane & 3) << 3) | (((lane >> 2) & 3) << 6) | (((lane >> 4) & 1) << 5) | (((lane >> 5) & 1) << 8); }
constexpr int v_rd_off(int d0, int ks, int half) { return d0 * 512 + ks * 4096 + half * 2048; }
template <int OFF> __device__ __forceinline__ s16x4 tr_read(int vb) { s16x4 r; asm volatile("ds_read_b64_tr_b16 %0, %1 offset:%2" : "=&v"(r) : "v"(vb), "i"(OFF) : "memory"); return r; }
template <int D0> __device__ __forceinline__ void pv_one(f32x16& od, int vb, bf16x8 pa0, bf16x8 pa1, bf16x8 pa2, bf16x8 pa3) {
    const s16x4 l0 = tr_read<v_rd_off(D0, 0, 0)>(vb), h0 = tr_read<v_rd_off(D0, 0, 1)>(vb), l1 = tr_read<v_rd_off(D0, 1, 0)>(vb), h1 = tr_read<v_rd_off(D0, 1, 1)>(vb);
    const s16x4 l2 = tr_read<v_rd_off(D0, 2, 0)>(vb), h2 = tr_read<v_rd_off(D0, 2, 1)>(vb), l3 = tr_read<v_rd_off(D0, 3, 0)>(vb), h3 = tr_read<v_rd_off(D0, 3, 1)>(vb);
    asm volatile("s_waitcnt lgkmcnt(0)" ::: "memory"); SBAR();
#define ATT_PK(L, H) (bf16x8){L[0], L[1], L[2], L[3], H[0], H[1], H[2], H[3]}
    od = __builtin_amdgcn_mfma_f32_32x32x16_bf16(pa0, ATT_PK(l0, h0), od, 0, 0, 0);
    od = __builtin_amdgcn_mfma_f32_32x32x16_bf16(pa1, ATT_PK(l1, h1), od, 0, 0, 0);
    od = __builtin_amdgcn_mfma_f32_32x32x16_bf16(pa2, ATT_PK(l2, h2), od, 0, 0, 0);
    od = __builtin_amdgcn_mfma_f32_32x32x16_bf16(pa3, ATT_PK(l3, h3), od, 0, 0, 0);
#undef ATT_PK
}
template <int VAR> __device__ __forceinline__ void pv_d0(f32x16 (&o)[4], int vb, bf16x8 pa0, bf16x8 pa1, bf16x8 pa2, bf16x8 pa3) {
    if (VAR == 2) { asm volatile("" :: "v"(pa0), "v"(pa1), "v"(pa2), "v"(pa3)); return; }
    pv_one<0>(o[0], vb, pa0, pa1, pa2, pa3); pv_one<1>(o[1], vb, pa0, pa1, pa2, pa3); pv_one<2>(o[2], vb, pa0, pa1, pa2, pa3); pv_one<3>(o[3], vb, pa0, pa1, pa2, pa3);
}
#define ATT_PK4(P, BASE, OUT) do { unsigned a0 = cvt_pk_bf16(P[BASE + 0], P[BASE + 1]), a1 = cvt_pk_bf16(P[BASE + 2], P[BASE + 3]); \
    unsigned b0 = cvt_pk_bf16(P[BASE + 4], P[BASE + 5]), b1 = cvt_pk_bf16(P[BASE + 6], P[BASE + 7]); \
    auto r0 = __builtin_amdgcn_permlane32_swap(a0, b0, false, false); auto r1 = __builtin_amdgcn_permlane32_swap(a1, b1, false, false); \
    v4u w = {r0[0], r1[0], r0[1], r1[1]}; OUT = *reinterpret_cast<bf16x8*>(&w); } while (0)
template <int VAR> __device__ __forceinline__ void half_a(f32x16& p, float& ps, bf16x8& pa0, bf16x8& pa1) {
    if (VAR != 1) {
#pragma unroll
    for (int r = 0; r < 16; ++r) p[r] = __builtin_amdgcn_exp2f(p[r]); }
    float s = 0.f;
#pragma unroll
    for (int r = 0; r < 16; ++r) s += p[r];
    ps = s;
    ATT_PK4(p, 0, pa0); ATT_PK4(p, 8, pa1);
}
template <int VAR> __device__ __forceinline__ void half_b(f32x16& p, float ps, float& l_reg, bf16x8& pa2, bf16x8& pa3) {
    if (VAR != 1) {
#pragma unroll
    for (int r = 0; r < 16; ++r) p[r] = __builtin_amdgcn_exp2f(p[r]); }
#pragma unroll
    for (int r = 0; r < 16; ++r) ps += p[r];
    { auto rr = __builtin_amdgcn_permlane32_swap(__float_as_uint(ps), __float_as_uint(ps), false, false); ps = __uint_as_float(rr[0]) + __uint_as_float(rr[1]); }
    l_reg += ps;
    ATT_PK4(p, 0, pa2); ATT_PK4(p, 8, pa3);
}
__device__ __forceinline__ void qkt(f32x16& p0, f32x16& p1, const LAS unsigned char* Ks, const bf16x8 (&qr)[4], int r32, int hi) {
    p0 = f32x16{}; p1 = f32x16{};
    const int swz = (r32 >> 1) & 7;
#pragma unroll
    for (int d0 = 0; d0 < 4; ++d0) { const int off = r32 * 128 + (((d0 * 2 + hi) ^ swz) << 4);
        const bf16x8 b0 = *(const LAS bf16x8*)(Ks + off), b1 = *(const LAS bf16x8*)(Ks + 4096 + off);
        p0 = __builtin_amdgcn_mfma_f32_32x32x16_bf16(b0, qr[d0], p0, 0, 0, 0);
        p1 = __builtin_amdgcn_mfma_f32_32x32x16_bf16(b1, qr[d0], p1, 0, 0, 0); }
}
}

template <int VAR>
__device__ __forceinline__ void attn_fast(const Frame& F, const bf16* Q, const bf16* Kb, const bf16* Vb, bf16* ON, const float* subln, const float* lamv, bool with_ctx) {
    using namespace att;
    LAS unsigned char* lds = F.lds;
    const int tid = F.tid, wid = F.wave, lane = F.lane, r32 = lane & 31, hi = lane >> 5, comp = wid >> 2, wq = wid & 3;
    LAS float* li_l = (LAS float*)(lds + OFF_WS) + wid * 64;
    const int sr = tid >> 4, sc = (tid & 15) * 8, vst0 = v_st(sr, sc);
    const int krow = tid >> 3, kst = krow * 128 + (((tid & 7) ^ ((krow >> 1) & 7)) << 4);
    const int vb0 = (int)(uintptr_t)(lds + ST_V) + v_rd_base(lane);
    const unsigned koffb = (unsigned)tid * 16u, voffb = (unsigned)(sr * 128 + sc) * 2u;
    const LAS unsigned char* Kl = lds + comp * ST_K1;
    const float lam = __builtin_bit_cast(float, __builtin_amdgcn_readfirstlane(__builtin_bit_cast(int, lamv[0]))), oscale = __builtin_bit_cast(float, __builtin_amdgcn_readfirstlane(__builtin_bit_cast(int, lamv[1])));
    const int n_lat = NB * NH * (SEQ / 128), n_ctx = with_ctx ? NB * NH * (CTXL / 128) : 0;
    for (int unit = F.vcu; unit < n_lat + n_ctx; unit += F.G) {
        int b, h, t0, NT;
        if (unit < n_lat) { const int bh = unit >> 5; b = bh >> 3; h = bh & 7; t0 = CTXL + (unit & 31) * 128; NT = TK / 64; }
        else { const int uu = unit - n_lat, bh = uu >> 1; b = bh >> 3; h = bh & 7; t0 = (uu & 1) * 128; NT = CTXL / 64; }
        const char* K0u = (const char*)(Kb + (size_t)((b * NH + h) * 2) * TK * 64); const char* K1u = K0u + (size_t)TK * 128;
        const char* V0u = (const char*)(Vb + (size_t)(b * NH + h) * TK * 128); const char* V1u = V0u + 32 * 256;
        bf16x8 qr[4];
        { const bf16* Qw = Q + ((size_t)((b * NH + h) * 2 + comp) * TK + t0 + wq * 32 + r32) * 64 + hi * 8;
#pragma unroll
          for (int d0 = 0; d0 < 4; ++d0) qr[d0] = *(const bf16x8*)(Qw + d0 * 16); }
        float l_reg = 0.f; f32x16 o[4] = {};
        struct { bf16x8 vs0, vs1, ks0, ks1; } st_[2];
#define ATT_SLOAD(i, k0) do { st_[i].vs0 = *(const bf16x8*)(V0u + (size_t)(k0) * 256 + voffb); st_[i].vs1 = *(const bf16x8*)(V1u + (size_t)(k0) * 256 + voffb); \
        st_[i].ks0 = *(const bf16x8*)(K0u + (size_t)(k0) * 128 + koffb); st_[i].ks1 = *(const bf16x8*)(K1u + (size_t)(k0) * 128 + koffb); } while (0)
#define ATT_SWRITE(so, i) do { *(LAS bf16x8*)(lds + (so) + ST_V + vst0) = st_[i].vs0; *(LAS bf16x8*)(lds + (so) + ST_V + 8192 + vst0) = st_[i].vs1; \
        *(LAS bf16x8*)(lds + (so) + kst) = st_[i].ks0; *(LAS bf16x8*)(lds + (so) + ST_K1 + kst) = st_[i].ks1; } while (0)
        f32x16 pA0, pA1, pB0, pB1; bf16x8 pa0, pa1, pa2, pa3; float ps;
#define ATT_ITER(c0, c1, n0, n1, WS, LS) do { \
        SBAR(); qkt(n0, n1, Kl + sN, qr, r32, hi); half_b<VAR>(c1, ps, l_reg, pa2, pa3); SBAR(); \
        if (j + 3 < NT) ATT_SLOAD(LS, (j + 3) * 64); SBAR(); \
        pv_d0<VAR>(o, vb0 + sC, pa0, pa1, pa2, pa3); half_a<VAR>(n0, ps, pa0, pa1); \
        if (j + 2 < NT) { if (j + 3 < NT) asm volatile("s_waitcnt vmcnt(4)" ::: "memory"); else asm volatile("s_waitcnt vmcnt(0)" ::: "memory"); ATT_SWRITE(sW, WS); } \
        __syncthreads(); { const int t_ = sC; sC = sN; sN = sW; sW = t_; } ++j; } while (0)
        int sC = 0, sN = STAGE, sW = 2 * STAGE, j = 0;
        ATT_SLOAD(0, 0); ATT_SLOAD(1, 64); asm volatile("s_waitcnt vmcnt(0)" ::: "memory"); ATT_SWRITE(0, 0); ATT_SWRITE(STAGE, 1);
        ATT_SLOAD(0, 128); __syncthreads();
        qkt(pA0, pA1, Kl, qr, r32, hi); half_a<VAR>(pA0, ps, pa0, pa1);
        while (j + 2 < NT) {
            ATT_ITER(pA0, pA1, pB0, pB1, 0, 1);
            ATT_ITER(pB0, pB1, pA0, pA1, 1, 0);
        }
        ATT_ITER(pA0, pA1, pB0, pB1, 0, 1);
        half_b<VAR>(pB1, ps, l_reg, pa2, pa3); SBAR();
        pv_d0<VAR>(o, vb0 + sC, pa0, pa1, pa2, pa3);
#undef ATT_ITER
#undef ATT_SLOAD
#undef ATT_SWRITE
        if (hi == 0) li_l[r32] = l_reg;
        __syncthreads();
        float rli[16];
#pragma unroll
        for (int r = 0; r < 16; ++r) rli[r] = __builtin_amdgcn_rcpf(li_l[crow(r, hi)]);
        LAS float* X = (LAS float*)lds;
        if (comp == 1) {
#pragma unroll
            for (int r = 0; r < 16; ++r) { const int row = wq * 32 + crow(r, hi); const float sc1 = rli[r] * lam;
#pragma unroll
                for (int d0 = 0; d0 < 4; ++d0) X[row * 128 + d0 * 32 + r32] = o[d0][r] * sc1; }
        }
        __syncthreads();
        if (comp == 0) {
            float ss[16];
#pragma unroll
            for (int r = 0; r < 16; ++r) { const int row = wq * 32 + crow(r, hi); float s = 0.f;
#pragma unroll
                for (int d0 = 0; d0 < 4; ++d0) { const float v = o[d0][r] * rli[r] - X[row * 128 + d0 * 32 + r32]; o[d0][r] = v; s += v * v; }
                ss[r] = s; }
#pragma unroll
            for (int r = 0; r < 16; ++r) {
#pragma unroll
                for (int m = 1; m < 32; m <<= 1) ss[r] += __shfl_xor(ss[r], m); }
            float g[4];
#pragma unroll
            for (int d0 = 0; d0 < 4; ++d0) g[d0] = subln[d0 * 32 + r32] * oscale;
#pragma unroll
            for (int r = 0; r < 16; ++r) { const float rinv = 1.f / sqrtf(ss[r] * (1.f / 128.f) + EPS);
                const int t = t0 + wq * 32 + crow(r, hi), row = t >= CTXL ? b * SEQ + (t - CTXL) : RL + b * CTXL + t;
                bf16* op = ON + (size_t)row * 1024 + h * 128 + r32;
#pragma unroll
                for (int d0 = 0; d0 < 4; ++d0) if (VAR == 0 || lam == 12345.f) op[d0 * 32] = (bf16)(cvt_pk_bf16(o[d0][r] * rinv * g[d0], 0.f) & 0xffffu); }
        }
        __syncthreads();
    }
}


namespace a16 {
__device__ __forceinline__ int off_a(int row, int ch) { return 2048 * (row >> 3) + 512 * (ch >> 2) + 64 * (row & 7) + 16 * ((ch & 3) ^ ((row >> 2) & 3)); }
__device__ __forceinline__ int fK(int key) { return ((key >> 1) & 1) | (((key >> 3) & 1) << 1) | (((key >> 4) & 1) << 2); }
__device__ __forceinline__ void qkt16(f32x4 (&S)[2][2][2], const LAS unsigned char* Kt, int kb0, int kb1, const bf16x8 (&qf)[2][2]) {
#pragma unroll
    for (int ks2 = 0; ks2 < 2; ++ks2) {
        if (ks2) SBAR();
#pragma unroll
        for (int u = 0; u < 2; ++u) {
            const bf16x8 k0 = *(const LAS bf16x8*)(Kt + kb0 + 4096 * ks2 + 512 * u), k1 = *(const LAS bf16x8*)(Kt + kb1 + 4096 * ks2 + 512 * u);
#pragma unroll
            for (int qb = 0; qb < 2; ++qb) { f32x4 acc = (f32x4){0.f, 0.f, 0.f, 0.f};
                acc = __builtin_amdgcn_mfma_f32_16x16x32_bf16(k0, qf[qb][0], acc, 0, 0, 0); S[ks2][u][qb] = __builtin_amdgcn_mfma_f32_16x16x32_bf16(k1, qf[qb][1], acc, 0, 0, 0); }
        }
    }
}
__device__ __forceinline__ void half16(f32x4 (&Sh)[2][2], float (&ls)[2], bf16x8 (&pf)[2]) {
#pragma unroll
    for (int qb = 0; qb < 2; ++qb) {
#pragma unroll
        for (int u = 0; u < 2; ++u)
#pragma unroll
            for (int r = 0; r < 4; ++r) Sh[u][qb][r] = __builtin_amdgcn_exp2f(Sh[u][qb][r]);
        ls[qb] += ((Sh[0][qb][0] + Sh[0][qb][1]) + (Sh[0][qb][2] + Sh[0][qb][3])) + ((Sh[1][qb][0] + Sh[1][qb][1]) + (Sh[1][qb][2] + Sh[1][qb][3]));
        v4u w; w.x = cvt_pk_bf16_pin(Sh[0][qb][0], Sh[0][qb][1]); w.y = cvt_pk_bf16_pin(Sh[0][qb][2], Sh[0][qb][3]); w.z = cvt_pk_bf16_pin(Sh[1][qb][0], Sh[1][qb][1]); w.w = cvt_pk_bf16_pin(Sh[1][qb][2], Sh[1][qb][3]);
        pf[qb] = *reinterpret_cast<bf16x8*>(&w); }
}
template <int CP, bool PVSYNC = false> __device__ __forceinline__ void pv16(f32x4 (&O)[8][2], int vb00, int vb01, int vb10, int vb11, const bf16x8 (&pf)[2][2]) {
#define tr_read16(OFF, vb) __builtin_amdgcn_ds_read_tr16_b64_v4i16((LAS s16x4*)((LAS unsigned char*)(uintptr_t)(unsigned)(vb) + (OFF)))
    const s16x4 a0 = tr_read16(512 * CP, vb00), a1 = tr_read16(512 * CP, vb01), a2 = tr_read16(8192 + 512 * CP, vb00), a3 = tr_read16(8192 + 512 * CP, vb01);
    const s16x4 b0 = tr_read16(512 * CP, vb10), b1 = tr_read16(512 * CP, vb11), b2 = tr_read16(8192 + 512 * CP, vb10), b3 = tr_read16(8192 + 512 * CP, vb11);
    if (PVSYNC) { asm volatile("s_waitcnt lgkmcnt(0)" ::: "memory"); SBAR(); }
#define A16_PK(L, H) (bf16x8){L[0], L[1], L[2], L[3], H[0], H[1], H[2], H[3]}
    const bf16x8 ve0 = A16_PK(a0, a1), ve1 = A16_PK(a2, a3), vo0 = A16_PK(b0, b1), vo1 = A16_PK(b2, b3);
#pragma unroll
    for (int qb = 0; qb < 2; ++qb) {
        O[2 * CP][qb] = __builtin_amdgcn_mfma_f32_16x16x32_bf16(ve0, pf[0][qb], O[2 * CP][qb], 0, 0, 0);
        O[2 * CP + 1][qb] = __builtin_amdgcn_mfma_f32_16x16x32_bf16(vo0, pf[0][qb], O[2 * CP + 1][qb], 0, 0, 0);
        O[2 * CP][qb] = __builtin_amdgcn_mfma_f32_16x16x32_bf16(ve1, pf[1][qb], O[2 * CP][qb], 0, 0, 0);
        O[2 * CP + 1][qb] = __builtin_amdgcn_mfma_f32_16x16x32_bf16(vo1, pf[1][qb], O[2 * CP + 1][qb], 0, 0, 0); }
#undef A16_PK
#undef tr_read16
}
}

__device__ __forceinline__ void attn16(const Frame& F, const bf16* Q, const bf16* Kb, const bf16* Vb, bf16* ON, const float* subln, const float* lamv, bool with_ctx) {
    using namespace att; using namespace a16;
    LAS unsigned char* lds = F.lds;
    const int tid = F.tid, wid = F.wave, lane = F.lane, l15 = lane & 15, g = lane >> 4, comp = wid >> 2, wq = wid & 3;
    const int vrl = 8 * (tid >> 7) + ((tid >> 2) & 7);
    const unsigned ksrc = (unsigned)((tid >> 3) * 128 + (((tid & 7) ^ fK(tid >> 3)) << 4));
    const unsigned vsrc = (unsigned)(vrl * 256 + (((((tid >> 5) & 3) << 2) | ((tid & 3) ^ ((vrl >> 2) & 3))) << 4));
    const unsigned ldsw = (unsigned)__builtin_amdgcn_readfirstlane(wid) * 1024u;
    const int ki = 8 * (l15 >> 2) + (l15 & 3), kf = fK(ki);
    const int kb0 = ki * 128 + (((0 + g) ^ kf) << 4), kb1 = ki * 128 + (((4 + g) ^ kf) << 4);
    const int tq = l15 >> 2, tp = lane & 3;
    const int vr0 = (int)(uintptr_t)(lds + ST_V);
    int v00 = vr0 + off_a(8 * g + tq, 0 + (tp >> 1)) + 8 * (tp & 1), v01 = vr0 + off_a(8 * g + 4 + tq, 0 + (tp >> 1)) + 8 * (tp & 1);
    int v10 = vr0 + off_a(8 * g + tq, 2 + (tp >> 1)) + 8 * (tp & 1), v11 = vr0 + off_a(8 * g + 4 + tq, 2 + (tp >> 1)) + 8 * (tp & 1);
    const LAS unsigned char* Kl = lds + comp * ST_K1;
    const float lam = __builtin_bit_cast(float, __builtin_amdgcn_readfirstlane(__builtin_bit_cast(int, lamv[0]))), oscale = __builtin_bit_cast(float, __builtin_amdgcn_readfirstlane(__builtin_bit_cast(int, lamv[1])));
    const int n_lat = NB * NH * (SEQ / 128), n_ctx = with_ctx ? NB * NH * (CTXL / 128) : 0;
    for (int unit = F.vcu; unit < n_lat + n_ctx; unit += F.G) {
        int b, h, t0, NT;
        if (unit < n_lat) { const int bh = unit >> 5; b = bh >> 3; h = bh & 7; t0 = CTXL + (unit & 31) * 128; NT = TK / 64; }
        else { const int uu = unit - n_lat, bh = uu >> 1; b = bh >> 3; h = bh & 7; t0 = (uu & 1) * 128; NT = CTXL / 64; }
        const char* K0u = (const char*)(Kb + (size_t)((b * NH + h) * 2) * TK * 64); const char* K1u = K0u + (size_t)TK * 128;
        const char* V0u = (const char*)(Vb + (size_t)(b * NH + h) * TK * 128); const char* V1u = V0u + 32 * 256;
        bf16x8 qf[2][2];
        { const bf16* Qw = Q + ((size_t)((b * NH + h) * 2 + comp) * TK + t0 + wq * 32 + l15) * 64 + 8 * g;
#pragma unroll
          for (int qb = 0; qb < 2; ++qb)
#pragma unroll
              for (int sdim = 0; sdim < 2; ++sdim) qf[qb][sdim] = *(const bf16x8*)(Qw + (size_t)qb * 16 * 64 + 32 * sdim); }
        f32x4 O[8][2];
#pragma unroll
        for (int c = 0; c < 8; ++c) { O[c][0] = (f32x4){0.f, 0.f, 0.f, 0.f}; O[c][1] = (f32x4){0.f, 0.f, 0.f, 0.f}; }
        float ls[2] = {0.f, 0.f};
#define A16_DMA1(gp, voff, ldsa) asm volatile("s_mov_b32 m0, %2\n\ts_nop 0\n\tglobal_load_lds_dwordx4 %0, %1" :: "v"(voff), "s"(gp), "s"(ldsa) : "memory", "m0")
#define A16_DMA(so, k0) do { const unsigned la_ = (unsigned)(uintptr_t)(lds + (so)) + ldsw; \
        A16_DMA1(K0u + (size_t)(k0) * 128, ksrc, la_); A16_DMA1(K1u + (size_t)(k0) * 128, ksrc, la_ + ST_K1); \
        A16_DMA1(V0u + (size_t)(k0) * 256, vsrc, la_ + ST_V); A16_DMA1(V1u + (size_t)(k0) * 256, vsrc, la_ + ST_V + 8192); } while (0)
        f32x4 SA[2][2][2], SB[2][2][2]; bf16x8 pf[2][2], pf2[2];
#define A16_ITER(SC, SNX) do { \
        if (j + 2 < NT) A16_DMA(sW, (j + 2) * 64); \
        SBAR(); qkt16(SNX, Kl + sN, kb0, kb1, qf); half16(SC[1], ls, pf[1]); SBAR(); \
        asm volatile("" : "+v"(SNX[0][0][0]), "+v"(SNX[0][0][1]), "+v"(SNX[0][1][0]), "+v"(SNX[0][1][1]));     \
        pv16<0>(O, v00, v01, v10, v11, pf); pv16<1>(O, v00, v01, v10, v11, pf); \
        pv16<2>(O, v00, v01, v10, v11, pf); pv16<3>(O, v00, v01, v10, v11, pf); \
        half16(SNX[0], ls, pf2); pf[0][0] = pf2[0]; pf[0][1] = pf2[1]; \
        asm volatile("s_waitcnt vmcnt(0)" ::: "memory"); \
        __syncthreads(); { const int d_ = sN - sC; v00 += d_; v01 += d_; v10 += d_; v11 += d_; const int t_ = sC; sC = sN; sN = sW; sW = t_; } ++j; } while (0)
        int sC = 0, sN = STAGE, sW = 2 * STAGE, j = 0;
        A16_DMA(0, 0); A16_DMA(STAGE, 64);
        asm volatile("s_waitcnt vmcnt(0)" ::: "memory"); __syncthreads();
        qkt16(SA, Kl, kb0, kb1, qf); half16(SA[0], ls, pf[0]);
        while (j + 2 < NT) { A16_ITER(SA, SB); A16_ITER(SB, SA); }
        A16_ITER(SA, SB);
        half16(SB[1], ls, pf[1]); SBAR();
        pv16<0>(O, v00, v01, v10, v11, pf); pv16<1>(O, v00, v01, v10, v11, pf);
        pv16<2>(O, v00, v01, v10, v11, pf); pv16<3>(O, v00, v01, v10, v11, pf);
        v00 -= sC; v01 -= sC; v10 -= sC; v11 -= sC;
#undef A16_ITER
#undef A16_DMA
#undef A16_DMA1
#pragma unroll
        for (int qb = 0; qb < 2; ++qb) { ls[qb] += __shfl_xor(ls[qb], 16); ls[qb] += __shfl_xor(ls[qb], 32); }
        __syncthreads();
        LAS float* X = (LAS float*)lds; constexpr int XLD = 132;
        if (comp == 1) {
#pragma unroll
            for (int qb = 0; qb < 2; ++qb) { const float sc1 = lam * __builtin_amdgcn_rcpf(ls[qb]); LAS float* xr = X + (wq * 32 + qb * 16 + l15) * XLD + 4 * g;
#pragma unroll
                for (int c = 0; c < 8; ++c) *(LAS f32x4*)(xr + 16 * c) = O[c][qb] * sc1; }
        }
        __syncthreads();
        if (comp == 0) {
#pragma unroll
            for (int qb = 0; qb < 2; ++qb) { const float i0 = __builtin_amdgcn_rcpf(ls[qb]); const LAS float* xr = X + (wq * 32 + qb * 16 + l15) * XLD + 4 * g; float sq = 0.f;
#pragma unroll
                for (int c = 0; c < 8; ++c) { const f32x4 v = O[c][qb] * i0 - *(const LAS f32x4*)(xr + 16 * c); O[c][qb] = v; sq += (v[0] * v[0] + v[1] * v[1]) + (v[2] * v[2] + v[3] * v[3]); }
                sq += __shfl_xor(sq, 16); sq += __shfl_xor(sq, 32);
                const float rinv = 1.f / sqrtf(sq * (1.f / 128.f) + EPS) * oscale;
                const int t = t0 + wq * 32 + qb * 16 + l15, row = t >= CTXL ? b * SEQ + (t - CTXL) : RL + b * CTXL + t;
                bf16* op = ON + (size_t)row * 1024 + h * 128 + 4 * g;
#pragma unroll
                for (int c = 0; c < 8; ++c) { const f32x4 gg = *(const f32x4*)(subln + 16 * c + 4 * g); const f32x4 y = O[c][qb] * rinv * gg;
                    v2u w; w.x = cvt_pk_bf16(y[0], y[1]); w.y = cvt_pk_bf16(y[2], y[3]); *(v2u*)(op + 16 * c) = w; } }
        }
        __syncthreads();
    }
}

__device__ __forceinline__ void cvt_item(const float* s0, const float* s1, int srcN, int mode, int K, int N, bf16* dst, int item, LAS float* scr, int lane) {
    const int nblk = N / 64, kb = item / nblk, nb = item % nblk, k0 = 64 * kb, n0 = 64 * nb;
    const int v = n0 + lane; const float* sp = s0; int c = v;
    if (mode == 1) { const int kind = (v >> 2) & 1, ch = ((v >> 3) << 2) | (v & 3); sp = kind ? s1 : s0; c = ch; }
    else if (mode == 2) { if (v >= 3072 && v < 5120) { const int vv = v - 3072, kind = (vv >> 2) & 1, ch = ((vv >> 3) << 2) | (vv & 3); c = 3072 + kind * 1024 + ch; }
        else if (v < 2048) c = qk_src_col(v); }
    sp += (size_t)k0 * srcN + c;
#pragma unroll 16
    for (int kk = 0; kk < 64; ++kk) scr[kk * 64 + (lane ^ (((kk >> 3) & 7) << 2))] = sp[(size_t)kk * srcN];
    LDS_WAIT(); asm volatile("" ::: "memory");
    const int c8 = lane & 7, sw = c8 << 2;
#pragma unroll
    for (int j = 0; j < 8; ++j) { const int n = (lane >> 3) + 8 * j; const LAS float* q = scr + (8 * c8) * 64 + (n ^ sw);
        v4u o; o.x = cvt_pk_bf16(q[0 * 64], q[1 * 64]); o.y = cvt_pk_bf16(q[2 * 64], q[3 * 64]); o.z = cvt_pk_bf16(q[4 * 64], q[5 * 64]); o.w = cvt_pk_bf16(q[6 * 64], q[7 * 64]);
        *(v4u*)(dst + (size_t)(n0 + n) * K + k0 + 8 * c8) = o; }
    LDS_WAIT(); asm volatile("" ::: "memory");
}

__device__ __forceinline__ void phase_prologue(const Frame& F, const Args& a) {
    unsigned char* ws = a.ws;
    {
        LAS float* sv = (LAS float*)F.lds; LAS float* part = sv + 5 * 1024;
        for (int idx = F.tid; idx < 5 * 1024; idx += 512) { const int v = idx >> 10, k = idx & 1023; const float x = v < 4 ? a.in[I_C][v * 1024 + k] : a.in[I_CCTX][k]; sv[idx] = x * sigm(x); }
        __syncthreads();
        float* MOD = (float*)(ws + WS_MOD);
        for (int unit = F.vcu; unit < 192; unit += F.G) {
            const int l = unit / 96, n0 = (unit % 96) * 64; const float* W = a.in[I_WMOD] + (size_t)l * 1024 * 6144 + n0 + F.lane;
            float acc[5] = {0, 0, 0, 0, 0};
#pragma unroll 16
            for (int k = F.wave * 128; k < F.wave * 128 + 128; ++k) { const float wv = W[(size_t)k * 6144];
#pragma unroll
                for (int v = 0; v < 5; ++v) acc[v] += sv[v * 1024 + k] * wv; }
#pragma unroll
            for (int v = 0; v < 5; ++v) part[(F.wave * 5 + v) * 64 + F.lane] = acc[v];
            __syncthreads();
            if (F.tid < 320) { const int v = F.tid >> 6, ln = F.tid & 63; float s = a.in[I_BMOD][l * 6144 + n0 + ln];
#pragma unroll
                for (int w = 0; w < 8; ++w) s += part[(w * 5 + v) * 64 + ln];
                MOD[(size_t)(l * 5 + v) * 6144 + n0 + ln] = s; }
            __syncthreads();
        }
    }
    if (F.vcu == F.G - 1) {
        float* ROPE = (float*)(ws + WS_ROPE); float* LAMV = (float*)(ws + WS_LAM);
        for (int idx = F.tid; idx < 1024; idx += 512) { const int pos = idx >> 4, i = idx & 15; const float inv = __builtin_amdgcn_exp2f(-(float)(2 * i) * (13.287712379549449f / 32.f)), ang = (float)pos * inv; const float kq = rintf(ang * 0.15915494309189535f); float rr = fmaf(-kq, 6.2831854820251465f, ang); rr = fmaf(-kq, -1.7484555e-7f, rr); ROPE[idx] = __cosf(rr); ROPE[1024 + idx] = __sinf(rr); }
        if (F.tid < 2) { const int l = F.tid; float s1 = 0.f, s2 = 0.f;
            for (int d = 0; d < 64; ++d) { s1 += a.in[I_LQ1][l * 64 + d] * a.in[I_LK1][l * 64 + d]; s2 += a.in[I_LQ2][l * 64 + d] * a.in[I_LK2][l * 64 + d]; }
            const float lam_init = l == 0 ? 0.2f : 0.35550906759f; LAMV[l * 2 + 0] = __expf(s1) - __expf(s2) + lam_init; LAMV[l * 2 + 1] = 1.f - lam_init; }
    }
    {
        LAS float* scr = (LAS float*)(F.lds + F.wave * 16384);
        const int gw = F.vcu * 8 + F.wave, NGW = F.G * 8;
        constexpr int I_IN = 16 * 112, I_SQ = 16 * 16, I_GU0 = 16 * 88, I_D0 = 44 * 16, I_EGU = 16 * 112, I_ED = 56 * 16;
        constexpr int NITEMS = 2 * I_IN + 6 * I_SQ + I_GU0 + I_D0 + 8 * I_EGU + 8 * I_ED;
        for (int it = gw; it < NITEMS; it += NGW) {
            int r = it;
            if (r < 2 * I_IN) { const int l = r / I_IN; cvt_item(a.in[I_WIN] + (size_t)l * 1024 * INW, nullptr, INW, 2, 1024, INW, (bf16*)(ws + WS_WIN) + (size_t)l * INW * 1024, r % I_IN, scr, F.lane); continue; } r -= 2 * I_IN;
            if (r < 6 * I_SQ) { const int m = r / I_SQ, l = m / 3, w = m % 3; const float* src = a.in[w == 0 ? I_WATTNO : (w == 1 ? I_WCONVO : I_WOUT)] + (size_t)l * 1024 * 1024;
                bf16* dst = (bf16*)(ws + (w == 0 ? WS_WA : (w == 1 ? WS_WC : WS_WO)) + (size_t)l * 6 * MiB); cvt_item(src, nullptr, 1024, 0, 1024, 1024, dst, r % I_SQ, scr, F.lane); continue; } r -= 6 * I_SQ;
            if (r < I_GU0) { cvt_item(a.in[I_WFFG], a.in[I_WFFU], DFF, 1, 1024, 2 * DFF, (bf16*)(ws + WS_WGU0), r, scr, F.lane); continue; } r -= I_GU0;
            if (r < I_D0) { cvt_item(a.in[I_WFFD], nullptr, 1024, 0, DFF, 1024, (bf16*)(ws + WS_WD0), r, scr, F.lane); continue; } r -= I_D0;
            if (r < 8 * I_EGU) { const int e = r / I_EGU; cvt_item(a.in[I_WEG] + (size_t)e * 1024 * DFE, a.in[I_WEU] + (size_t)e * 1024 * DFE, DFE, 1, 1024, 2 * DFE, (bf16*)(ws + WS_WEGU) + (size_t)e * 2 * DFE * 1024, r % I_EGU, scr, F.lane); continue; } r -= 8 * I_EGU;
            { const int e = r / I_ED; cvt_item(a.in[I_WED] + (size_t)e * DFE * 1024, nullptr, 1024, 0, DFE, 1024, (bf16*)(ws + WS_WED) + (size_t)e * 1024 * DFE, r % I_ED, scr, F.lane); }
        }
    }
}

__device__ __forceinline__ void phase_rmsmod(const Frame& F, const float* src_lat, const float* src_ctx, int nrows, const float* g, const float* modl, int shift_idx, bf16* H) {
    const int gw = F.vcu * 8 + F.wave, NGW = F.G * 8;
    for (int row = gw; row < nrows; row += 2 * NGW) {
        const int row2 = row + NGW; const bool has2 = row2 < nrows;
        const float* srcA = row < RL ? src_lat + (size_t)row * 1024 : src_ctx + (size_t)(row - RL) * 1024;
        const float* srcB = has2 ? (row2 < RL ? src_lat + (size_t)row2 * 1024 : src_ctx + (size_t)(row2 - RL) * 1024) : srcA;
        f32x4 va[4], vb[4]; float sa = 0.f, sb = 0.f;
#pragma unroll
        for (int j = 0; j < 4; ++j) { va[j] = *(const f32x4*)(srcA + 4 * (F.lane + 64 * j)); vb[j] = *(const f32x4*)(srcB + 4 * (F.lane + 64 * j)); }
#pragma unroll
        for (int j = 0; j < 4; ++j) { sa += (va[j][0] * va[j][0] + va[j][1] * va[j][1]) + (va[j][2] * va[j][2] + va[j][3] * va[j][3]); sb += (vb[j][0] * vb[j][0] + vb[j][1] * vb[j][1]) + (vb[j][2] * vb[j][2] + vb[j][3] * vb[j][3]); }
        const float ra = 1.f / sqrtf(wave_sum(sa) * (1.f / 1024.f) + EPS), rb = 1.f / sqrtf(wave_sum(sb) * (1.f / 1024.f) + EPS);
        const float* shA = modl + row_mi(row) * 6144 + shift_idx * 1024; const float* shB = modl + row_mi(has2 ? row2 : row) * 6144 + shift_idx * 1024;
#pragma unroll
        for (int j = 0; j < 4; ++j) { const int col = 4 * (F.lane + 64 * j); const f32x4 gg = *(const f32x4*)(g + col);
            { const f32x4 s4 = *(const f32x4*)(shA + 1024 + col), h4 = *(const f32x4*)(shA + col); const f32x4 y = va[j] * ra * gg * (1.f + s4) + h4;
              v2u w; w.x = cvt_pk_bf16(y[0], y[1]); w.y = cvt_pk_bf16(y[2], y[3]); *(v2u*)(H + (size_t)row * 1024 + col) = w; }
            if (has2) { const f32x4 s4 = *(const f32x4*)(shB + 1024 + col), h4 = *(const f32x4*)(shB + col); const f32x4 y = vb[j] * rb * gg * (1.f + s4) + h4;
              v2u w; w.x = cvt_pk_bf16(y[0], y[1]); w.y = cvt_pk_bf16(y[2], y[3]); *(v2u*)(H + (size_t)row2 * 1024 + col) = w; } }
    }
}

__device__ __forceinline__ void phase_qknorm(const Frame& F, bf16* Q, bf16* Kb, const float* qg, const float* kg, const float* rope, int mode) {
    constexpr int HALFV = NB * NH * 2 * TK;
    const int total = mode ? NB * NH * 2 * CTXL : 2 * HALFV;
    const int j8 = F.tid & 7;
    for (int vec = (F.vcu * 512 + F.tid) >> 3; vec < total; vec += F.G * 64) {
        const bool isK = mode ? true : (vec >= HALFV); const int vv = mode ? (vec >> 8) * TK + (vec & 255) : (isK ? vec - HALFV : vec), t = vv % TK;
        bf16* p = (isK ? Kb : Q) + (size_t)vv * 64 + j8 * 8;
        f32x4 x0, x1; unpack8(*(const v4u*)p, x0, x1);
        float ss = (x0[0] * x0[0] + x0[1] * x0[1]) + (x0[2] * x0[2] + x0[3] * x0[3]) + (x1[0] * x1[0] + x1[1] * x1[1]) + (x1[2] * x1[2] + x1[3] * x1[3]);
        ss += __shfl_xor(ss, 1); ss += __shfl_xor(ss, 2); ss += __shfl_xor(ss, 4);
        const float rinv = 1.f / sqrtf(ss * (1.f / 64.f) + EPS);
        const float* gp = (isK ? kg : qg) + j8 * 8; const f32x4 g0 = *(const f32x4*)gp, g1 = *(const f32x4*)(gp + 4);
        f32x4 y0 = x0 * rinv * g0, y1 = x1 * rinv * g1;
        f32x4 p0, p1;
#pragma unroll
        for (int e = 0; e < 4; ++e) { p0[e] = __shfl_xor(y0[e], 2); p1[e] = __shfl_xor(y1[e], 2); }
        if (t >= CTXL) {
            const int s = t - CTXL, pos = (j8 >> 2) ? (s & 63) : (s >> 6), i0 = (j8 & 1) * 8; const float sgn = ((j8 >> 1) & 1) ? 1.f : -1.f;
            const float* cp = rope + pos * 16 + i0; const float* sp = cp + 1024;
            const f32x4 c0 = *(const f32x4*)cp, c1 = *(const f32x4*)(cp + 4), s0 = *(const f32x4*)sp, s1 = *(const f32x4*)(sp + 4);
            y0 = y0 * c0 + p0 * s0 * sgn; y1 = y1 * c1 + p1 * s1 * sgn;
        }
        if (!isK) { y0 = y0 * QSCALE; y1 = y1 * QSCALE; }
        *(v4u*)p = pack8(y0, y1);
    }
}

__device__ __forceinline__ void phase_conv(const Frame& F, const bf16* U0, bf16* U1, const float* dww, const float* dwb, const float* lng, const float* lnb, int nrows) {
    constexpr int RPU = 8, NIN = RPU + CK - 1;
    LAS float* red = (LAS float*)F.lds;
    const int half = F.tid >> 8, t8 = F.tid & 255, ch = 4 * t8, wv = F.wave & 3;
    const f32x4 bias = *(const f32x4*)(dwb + ch), g4 = *(const f32x4*)(lng + ch), b4 = *(const f32x4*)(lnb + ch);
    const int nunits = nrows / RPU;
    for (int u0 = F.vcu * 2; u0 < nunits; u0 += F.G * 2) {
        asm volatile("" ::: "memory");
        const int r0 = (u0 + half) * RPU;
        int seg_lo, seg_hi; if (r0 < RL) { seg_lo = r0 & ~4095; seg_hi = seg_lo + 4096; } else { seg_lo = RL + ((r0 - RL) & ~255); seg_hi = seg_lo + 256; }
        v2u xp[NIN];
#pragma unroll
        for (int i = 0; i < NIN; ++i) { const int rr = r0 - 15 + i; xp[i] = (rr >= seg_lo && rr < seg_hi) ? *(const v2u*)(U0 + (size_t)rr * 1024 + ch) : (v2u){0u, 0u}; }
        f32x4 acc[RPU];
#pragma unroll
        for (int r = 0; r < RPU; ++r) acc[r] = bias;
#pragma unroll
        for (int j = 0; j < CK; ++j) { const f32x4 wj = *(const f32x4*)(dww + j * 1024 + ch);
#pragma unroll
            for (int r = 0; r < RPU; ++r) { const v2u x = xp[r + j]; acc[r] += wj * (f32x4){bflo(x.x), bfhi(x.x), bflo(x.y), bfhi(x.y)}; } }
        float sv[RPU];
#pragma unroll
        for (int r = 0; r < RPU; ++r) sv[r] = wave_sum((acc[r][0] + acc[r][1]) + (acc[r][2] + acc[r][3]));
        __syncthreads();
        if (F.lane < RPU) { float v = sv[0];
#pragma unroll
            for (int r = 1; r < RPU; ++r) v = (F.lane == r) ? sv[r] : v;
            red[(half * 4 + wv) * RPU + F.lane] = v; }
        __syncthreads();
        float mean[RPU];
#pragma unroll
        for (int r = 0; r < RPU; ++r) mean[r] = ((red[(half * 4 + 0) * RPU + r] + red[(half * 4 + 1) * RPU + r]) + (red[(half * 4 + 2) * RPU + r] + red[(half * 4 + 3) * RPU + r])) * (1.f / 1024.f);
#pragma unroll
        for (int r = 0; r < RPU; ++r) { acc[r] = acc[r] - mean[r]; sv[r] = wave_sum((acc[r][0] * acc[r][0] + acc[r][1] * acc[r][1]) + (acc[r][2] * acc[r][2] + acc[r][3] * acc[r][3])); }
        if (F.lane < RPU) { float v = sv[0];
#pragma unroll
            for (int r = 1; r < RPU; ++r) v = (F.lane == r) ? sv[r] : v;
            red[128 + (half * 4 + wv) * RPU + F.lane] = v; }
        __syncthreads();
#pragma unroll
        for (int r = 0; r < RPU; ++r) { const float q = (red[128 + (half * 4 + 0) * RPU + r] + red[128 + (half * 4 + 1) * RPU + r]) + (red[128 + (half * 4 + 2) * RPU + r] + red[128 + (half * 4 + 3) * RPU + r]);
            const float rstd = 1.f / sqrtf(q * (1.f / 1024.f) + EPS);
            const f32x4 y = acc[r] * rstd * g4 + b4; v2u w; w.x = cvt_pk_bf16(y[0] * sigf(y[0]), y[1] * sigf(y[1])); w.y = cvt_pk_bf16(y[2] * sigf(y[2]), y[3] * sigf(y[3]));
            *(v2u*)(U1 + (size_t)(r0 + r) * 1024 + ch) = w; }
    }
    __syncthreads();
}

__device__ __forceinline__ void phase_router(const Frame& F, const float* x1, const float* g, const float* modl, const float* wr, bf16* H2, unsigned* BC, unsigned* TOK) {
    const int TPB = (RL + F.G - 1) / F.G, tbase = F.vcu * TPB;
    LAS int* le = (LAS int*)F.lds;
    for (int tl = F.wave; tl < TPB; tl += 8) {
        const int row = tbase + tl;
        if (row >= RL) { if (F.lane == 0) { le[tl * 2] = -1; le[tl * 2 + 1] = -1; } continue; }
        const float* src = x1 + (size_t)row * 1024;
        f32x4 v[4]; float ss = 0.f;
#pragma unroll
        for (int j = 0; j < 4; ++j) { v[j] = *(const f32x4*)(src + 4 * (F.lane + 64 * j)); ss += (v[j][0] * v[j][0] + v[j][1] * v[j][1]) + (v[j][2] * v[j][2] + v[j][3] * v[j][3]); }
        const float rinv = 1.f / sqrtf(wave_sum(ss) * (1.f / 1024.f) + EPS);
        const float* sh = modl + (row >> 12) * 6144 + 3 * 1024; const float* sc = sh + 1024;
        float lg[8] = {0, 0, 0, 0, 0, 0, 0, 0};
#pragma unroll
        for (int j = 0; j < 4; ++j) { const int col = 4 * (F.lane + 64 * j); const f32x4 gg = *(const f32x4*)(g + col), s4 = *(const f32x4*)(sc + col), h4 = *(const f32x4*)(sh + col);
            const f32x4 y = v[j] * rinv * gg * (1.f + s4) + h4; v2u w; w.x = cvt_pk_bf16(y[0], y[1]); w.y = cvt_pk_bf16(y[2], y[3]); *(v2u*)(H2 + (size_t)row * 1024 + col) = w;
#pragma unroll
            for (int e4 = 0; e4 < 4; ++e4) { const f32x4 wa = *(const f32x4*)(wr + (size_t)(col + e4) * 8), wb = *(const f32x4*)(wr + (size_t)(col + e4) * 8 + 4);
#pragma unroll
                for (int e = 0; e < 4; ++e) { lg[e] += y[e4] * wa[e]; lg[4 + e] += y[e4] * wb[e]; } } }
#pragma unroll
        for (int e = 0; e < 8; ++e) lg[e] = wave_sum(lg[e]);
        if (F.lane == 0) {
            int e0 = 0; float v0 = lg[0];
#pragma unroll
            for (int e = 1; e < 8; ++e) if (lg[e] > v0) { v0 = lg[e]; e0 = e; }
            int e1 = e0 == 0 ? 1 : 0; float v1 = lg[e1];
#pragma unroll
            for (int e = 0; e < 8; ++e) if (e != e0 && lg[e] > v1) { v1 = lg[e]; e1 = e; }
            const float w0 = 1.f / (1.f + __expf(v1 - v0)), w1 = 1.f - w0;
            unsigned* tk = TOK + (size_t)row * 8; tk[0] = (unsigned)e0; tk[1] = (unsigned)e1; tk[4] = __float_as_uint(w0); tk[5] = __float_as_uint(w1);
            le[tl * 2] = e0; le[tl * 2 + 1] = e1;
        }
    }
    __syncthreads();
    if (F.tid < 8) { unsigned c = 0; for (int tl = 0; tl < TPB; ++tl) c += (le[tl * 2] == F.tid) + (le[tl * 2 + 1] == F.tid); BC[F.vcu * 8 + F.tid] = c; }
    __syncthreads();
}
__device__ __forceinline__ void phase_moe_lists(const Frame& F, const unsigned* BC, unsigned* cnt, unsigned* TOK, int* slist) {
    const int TPB = (RL + F.G - 1) / F.G, tbase = F.vcu * TPB;
    LAS int* le = (LAS int*)F.lds; LAS unsigned* tot = (LAS unsigned*)(F.lds + 4096); LAS unsigned* pre = tot + 8;
    for (int i = F.tid; i < TPB * 2; i += 512) { const int row = tbase + (i >> 1); le[i] = row < RL ? (int)TOK[(size_t)row * 8 + (i & 1)] : -1; }
    LAS unsigned* bcl = pre + 8;
    for (int i = F.tid; i < F.G * 8; i += 512) bcl[i] = BC[i];
    __syncthreads();
    if (F.tid < 8) { unsigned t = 0, p = 0; for (int b = 0; b < F.G; ++b) { const unsigned c = bcl[b * 8 + F.tid]; t += c; p += (b < F.vcu) ? c : 0u; } tot[F.tid] = t; pre[F.tid] = p; }
    __syncthreads();
    if (F.tid < 8) {
        unsigned run = pre[F.tid]; for (int e = 0; e < F.tid; ++e) run += tot[e];
        if (F.vcu == 0) cnt[64 * F.tid] = tot[F.tid];
        for (int tl = 0; tl < TPB; ++tl) { const int row = tbase + tl;
            if (le[tl * 2] == F.tid) { TOK[(size_t)row * 8 + 6] = run; slist[run] = row; ++run; }
            if (le[tl * 2 + 1] == F.tid) { TOK[(size_t)row * 8 + 7] = run; slist[run] = row; ++run; } }
    }
    __syncthreads();
}
__device__ __forceinline__ int moe_build_table(const Frame& F, const unsigned* cnt, LAS int* tab) {
    LAS int* scan = tab + 4 * 160; LAS int* offl = scan + 132;
    if (F.tid == 0) { int o = 0; for (int e = 0; e < 8; ++e) { offl[e] = o; o += (int)__hip_atomic_load(cnt + 64 * e, __ATOMIC_RELAXED, __HIP_MEMORY_SCOPE_AGENT); } offl[8] = o; }
    __syncthreads();
    int nmine = 0;
    if (F.tid < 128) { const int base = F.tid * 256;
        for (int e = 0; e < 8; ++e) { const int lo = max(base, offl[e]), hi = min(base + 256, offl[e + 1]); if (lo < hi) ++nmine; }
        scan[F.tid] = nmine; }
    __syncthreads();
    if (F.tid == 0) { int o = 0; for (int t = 0; t < 128; ++t) { const int n = scan[t]; scan[t] = o; o += n; } scan[128] = o; }
    __syncthreads();
    if (F.tid < 128) { const int base = F.tid * 256; int o = scan[F.tid];
        for (int e = 0; e < 8; ++e) { const int lo = max(base, offl[e]), hi = min(base + 256, offl[e + 1]); if (lo < hi) { tab[o * 4 + 0] = F.tid; tab[o * 4 + 1] = e; tab[o * 4 + 2] = lo; tab[o * 4 + 3] = hi; ++o; } } }
    __syncthreads();
    return scan[128];
}
__device__ __forceinline__ void phase_moe_final(const Frame& F, float* out, const bf16* Ys, const unsigned* TOK, const float* gate5) {
    const int gw = F.vcu * 8 + F.wave, NGW = F.G * 8;
    for (int row = gw; row < RL; row += 2 * NGW) {
        const int row2 = (row + NGW < RL) ? row + NGW : row;
        const unsigned* tka = TOK + (size_t)row * 8; const unsigned* tkb = TOK + (size_t)row2 * 8;
        const float wa0 = __uint_as_float(tka[4]), wa1 = __uint_as_float(tka[5]), wb0 = __uint_as_float(tkb[4]), wb1 = __uint_as_float(tkb[5]);
        const size_t pa0 = tka[6], pa1 = tka[7], pb0 = tkb[6], pb1 = tkb[7];
        const float* ga = gate5 + (row >> 12) * 6144; const float* gb = gate5 + (row2 >> 12) * 6144;
        v2u ya0[4], ya1[4], yb0[4], yb1[4]; f32x4 xa[4], xb[4];
#pragma unroll
        for (int j = 0; j < 4; ++j) { const int col = 4 * (F.lane + 64 * j);
            ya0[j] = *(const v2u*)(Ys + pa0 * 1024 + col); ya1[j] = *(const v2u*)(Ys + pa1 * 1024 + col); yb0[j] = *(const v2u*)(Ys + pb0 * 1024 + col); yb1[j] = *(const v2u*)(Ys + pb1 * 1024 + col);
            xa[j] = *(const f32x4*)(out + (size_t)row * 1024 + col); xb[j] = *(const f32x4*)(out + (size_t)row2 * 1024 + col); }
#pragma unroll
        for (int j = 0; j < 4; ++j) { const int col = 4 * (F.lane + 64 * j); const f32x4 gga = *(const f32x4*)(ga + col), ggb = *(const f32x4*)(gb + col);
            f32x4 x = xa[j];
            x[0] += gga[0] * (wa0 * bflo(ya0[j].x) + wa1 * bflo(ya1[j].x)); x[1] += gga[1] * (wa0 * bfhi(ya0[j].x) + wa1 * bfhi(ya1[j].x)); x[2] += gga[2] * (wa0 * bflo(ya0[j].y) + wa1 * bflo(ya1[j].y)); x[3] += gga[3] * (wa0 * bfhi(ya0[j].y) + wa1 * bfhi(ya1[j].y));
            *(f32x4*)(out + (size_t)row * 1024 + col) = x;
            if (row2 != row) { f32x4 y = xb[j];
                y[0] += ggb[0] * (wb0 * bflo(yb0[j].x) + wb1 * bflo(yb1[j].x)); y[1] += ggb[1] * (wb0 * bfhi(yb0[j].x) + wb1 * bfhi(yb1[j].x)); y[2] += ggb[2] * (wb0 * bflo(yb0[j].y) + wb1 * bflo(yb1[j].y)); y[3] += ggb[3] * (wb0 * bfhi(yb0[j].y) + wb1 * bfhi(yb1[j].y));
                *(f32x4*)(out + (size_t)row2 * 1024 + col) = y; } }
    }
}

#ifndef REP_MASK
#define REP_MASK 0u
#endif
#define REP(j) (1 + ((REP_MASK >> (j)) & 1u))
#ifndef PH_MASK
#define PH_MASK 0xffffffffu
#endif
#define IN(k) (lo <= (k) && (k) < hi)
#define ON(j) ((PH_MASK >> (j)) & 1u)
#define SEAM(k) do { if (IN(k) && IN((k) + 1)) xcd_barrier(bar); } while (0)
template <int l>
__device__ __forceinline__ void layer_body(const Frame& F, const Args& a, const XcdBarrier& bar, unsigned char* ws, unsigned* ctl, const int lo, const int hi) {
    const int G = F.G, cb = (int)blockIdx.x;
    const float* MOD = (const float*)(ws + WS_MOD);
    bf16* A0 = (bf16*)(ws + WS_A0); bf16* A1 = (bf16*)(ws + WS_A1); bf16* A2 = (bf16*)(ws + WS_A2); bf16* A3 = (bf16*)(ws + WS_A3); bf16* A4 = (bf16*)(ws + WS_A4); bf16* A5 = (bf16*)(ws + WS_A5);
    float* XB = (float*)(ws + WS_XB);
    {
        const int pb = 1 + l * 9;
        const float* modl = MOD + (size_t)l * 5 * 6144;
        const float* xs_lat = l == 0 ? a.in[I_X] : XB; const float* xs_ctx = l == 0 ? a.in[I_CTX] : XB + (size_t)RL * 1024;
        if (ON(1) && IN(pb + 0)) for (int rep_ = 0; rep_ < (int)REP(1); ++rep_) phase_rmsmod(F, xs_lat, xs_ctx, R, a.in[I_GMIX] + l * 1024, modl, 0, A0);
        SEAM(pb + 0);
        if (ON(2) && IN(pb + 1)) {
            SchedPlain S{(const char*)A0, (const char*)(ws + WS_WIN + (size_t)l * 14 * MiB), (l == 0 ? R : RL) / 256, INW / 256, 1024, G, cb};
            EpiInProj E{A1, A2, A3, A4, A5, a.in[I_QG] + l * 64, a.in[I_KG] + l * 64, (const float*)(ws + WS_ROPE)};
            for (int rep_ = 0; rep_ < (int)REP(2); ++rep_) run_gemm<false>(F.lds, 1024, S, E);
            if (l == 1) {
                for (int t = F.vcu; t < 512; t += G) { const int tm = t >> 5, tn = t & 31; Unit u{};
                    gemm_small_tile(F.lds, A0 + (size_t)(RL + 64 * tm) * 1024, (const bf16*)(ws + WS_WIN + (size_t)14 * MiB) + (size_t)(1024 + 64 * tn) * 1024, 1024, RL + 64 * tm, 1024 + 64 * tn, u, E); }
            }
        }
        SEAM(pb + 1);
        if (ON(3) && IN(pb + 2)) {
#if FAST_GEMM
            if (l == 1) phase_qknorm(F, A1, A2, a.in[I_QG] + l * 64, a.in[I_KG] + l * 64, (const float*)(ws + WS_ROPE), 1);
#else
            phase_qknorm(F, A1, A2, a.in[I_QG] + l * 64, a.in[I_KG] + l * 64, (const float*)(ws + WS_ROPE), 0);
#endif
#ifndef SKIP_CONV
            for (int rep_ = 0; rep_ < (int)REP(3); ++rep_) phase_conv(F, A4, A0, a.in[I_DWW] + (size_t)l * CK * 1024, a.in[I_DWB] + l * 1024, a.in[I_CLNG] + l * 1024, a.in[I_CLNB] + l * 1024, l == 0 ? R : RL);
#endif
        }
        SEAM(pb + 2);
        if (ON(4) && IN(pb + 3)) {
#ifndef SKIP_ATTN
#if FAST_ATTN
#ifdef ATT_XVAR
            attn_fast<ATT_XVAR>(F, A1, A2, A3, A4, a.in[I_SUBLN] + l * 128, (const float*)(ws + WS_LAM) + l * 2, l == 0);
#endif
            attn16(F, A1, A2, A3, A4, a.in[I_SUBLN] + l * 128, (const float*)(ws + WS_LAM) + l * 2, l == 0);
#else
            attn_naive(F, A1, A2, A3, A4, a.in[I_SUBLN] + l * 128, (const float*)(ws + WS_LAM) + l * 2, l == 0);
#endif
#endif
        }
        SEAM(pb + 3);
        if (ON(5) && IN(pb + 4)) {
            SchedMerge S{(const char*)A4, (const char*)(ws + WS_WA + (size_t)l * 6 * MiB), (const char*)A0, (const char*)(ws + WS_WC + (size_t)l * 6 * MiB), RL / 256, 4, 1024, G, cb};
            EpiMerge E{A5, A2, A1};
            for (int rep_ = 0; rep_ < (int)REP(5); ++rep_) run_gemm<false>(F.lds, 1024, S, E);
            if (l == 0) {
                for (int t = F.vcu; t < 256; t += G) { const int tm = t >> 4, tn = t & 15; Unit u{};
                    u.aux = 0; gemm_small_tile(F.lds, A4 + (size_t)(RL + 64 * tm) * 1024, (const bf16*)(ws + WS_WA) + (size_t)(64 * tn) * 1024, 1024, RL + 64 * tm, 64 * tn, u, E);
                    u.aux = 1; gemm_small_tile(F.lds, A0 + (size_t)(RL + 64 * tm) * 1024, (const bf16*)(ws + WS_WC) + (size_t)(64 * tn) * 1024, 1024, RL + 64 * tm, 64 * tn, u, E); }
            }
        }
        SEAM(pb + 4);
        if (ON(6) && IN(pb + 5)) {
            SchedPlain S{(const char*)A1, (const char*)(ws + WS_WO + (size_t)l * 6 * MiB), RL / 256, 4, 1024, G, cb};
            EpiResid E{xs_lat, xs_ctx, l == 0 ? XB : a.out, modl + 2 * 1024};
            for (int rep_ = 0; rep_ < (int)REP(6); ++rep_) run_gemm<false>(F.lds, 1024, S, E);
            if (l == 0) { for (int t = F.vcu; t < 256; t += G) { const int tm = t >> 4, tn = t & 15; Unit u{};
                    gemm_small_tile(F.lds, A1 + (size_t)(RL + 64 * tm) * 1024, (const bf16*)(ws + WS_WO) + (size_t)(64 * tn) * 1024, 1024, RL + 64 * tm, 64 * tn, u, E); } }
        }
        SEAM(pb + 5);
        if (l == 0) {
            if (ON(7) && IN(pb + 6)) for (int rep_ = 0; rep_ < (int)REP(7); ++rep_) phase_rmsmod(F, XB, XB + (size_t)RL * 1024, R, a.in[I_GFFN], modl, 3, A0);
            SEAM(pb + 6);
            if (ON(8) && IN(pb + 7)) {
                SchedPlain S{(const char*)A0, (const char*)(ws + WS_WGU0), R / 256, 2 * DFF / 256, 1024, G, cb};
                EpiSwiglu E{A1, DFF};
                for (int rep_ = 0; rep_ < (int)REP(8); ++rep_) run_gemm<false>(F.lds, 1024, S, E);
            }
            SEAM(pb + 7);
            if (ON(9) && IN(pb + 8)) {
                SchedPlain S{(const char*)A1, (const char*)(ws + WS_WD0), RL / 256, 4, DFF, G, cb};
                EpiResid E{XB, XB + (size_t)RL * 1024, XB, modl + 5 * 1024};
                run_gemm<false>(F.lds, DFF, S, E);
                for (int t = F.vcu; t < 256; t += G) { const int tm = t >> 4, tn = t & 15; Unit u{};
                    gemm_small_tile(F.lds, A1 + (size_t)(RL + 64 * tm) * DFF, (const bf16*)(ws + WS_WD0) + (size_t)(64 * tn) * DFF, DFF, RL + 64 * tm, 64 * tn, u, E); }
            }
            SEAM(pb + 8);
        } else {
            unsigned* cnt = ctl + CW_CNT; unsigned* TOK = (unsigned*)(ws + WS_TOK); int* slist = (int*)(ws + WS_SLIST);
            LAS int* tab = (LAS int*)(F.lds + MOETAB_OFF);
#ifndef SKIP_ROUTER
            if (ON(16) && IN(16)) phase_router(F, a.out, a.in[I_GFFN] + 1024, modl, a.in[I_WR], A0, (unsigned*)(ws + WS_BC), TOK);
#endif
            SEAM(16);
            if (ON(17) && IN(17)) phase_moe_lists(F, (const unsigned*)(ws + WS_BC), cnt, TOK, slist);
            SEAM(17);
            if (ON(18) && IN(18)) {
                const int NU = moe_build_table(F, cnt, tab);
                SchedMoe S{(const char*)A0, (const char*)(ws + WS_WEGU), slist, tab, NU, 2 * DFE / 256, 1024, G, cb, (size_t)2 * DFE * 1024 * 2, 1, NU * (2 * DFE / 256)};
                EpiSwiglu E{A1, DFE};
                for (int rep_ = 0; rep_ < (int)REP(18); ++rep_) run_gemm<true>(F.lds, 1024, S, E);
            }
            SEAM(18);
            if (ON(19) && IN(19)) {
                const int NU = moe_build_table(F, cnt, tab);
                const int total = NU * 4; int whole = (total / G) * G, left = total - whole;
                if (left > 0) { whole = total; left = 0; }
                SchedMoe S{(const char*)A1, (const char*)(ws + WS_WED), slist, tab, NU, 4, DFE, G, cb, (size_t)1024 * DFE * 2, 0, whole};
                EpiBf16Plain E{(bf16*)XB, 1024};
                for (int rep_ = 0; rep_ < (int)REP(19); ++rep_) run_gemm<false>(F.lds, DFE, S, E);
                for (int sidx = F.vcu; sidx < left * 16; sidx += G) {
                    const int L = whole + (sidx >> 4), sm = (sidx >> 2) & 3, sn = sidx & 3; int pm, pn; tile_of(L, NU, 4, pm, pn);
                    Unit u{}; const int tile = tab[pm * 4 + 0], e = tab[pm * 4 + 1]; u.lo = tab[pm * 4 + 2]; u.hi = tab[pm * 4 + 3];
                    const int r0 = tile * 256 + 64 * sm;
                    if (r0 + 64 > u.lo && r0 < u.hi)
                        gemm_small_tile<true>(F.lds, A1 + (size_t)r0 * DFE, (const bf16*)(ws + WS_WED) + ((size_t)e * 1024 + pn * 256 + 64 * sn) * DFE, DFE, r0, pn * 256 + 64 * sn, u, E);
                }
            }
            SEAM(19);
            if (ON(20) && IN(20)) phase_moe_final(F, a.out, (const bf16*)XB, TOK, modl + 5 * 1024);
        }
        }
}

constexpr int N_PHASES = 21;
__global__ void __launch_bounds__(512, 2) fwd_kernel(Args a) {
    extern __shared__ __attribute__((aligned(16))) unsigned char lds_raw[];
    Frame F; F.lds = (LAS unsigned char*)lds_raw; F.tid = threadIdx.x; F.lane = F.tid & 63; F.wave = __builtin_amdgcn_readfirstlane(F.tid >> 6);
    F.G = gridDim.x; { const int bx = blockIdx.x; F.vcu = (F.G % 8 == 0) ? (bx % 8) * (F.G / 8) + bx / 8 : bx; }
    unsigned char* ws = a.ws;
    unsigned* ctl = (unsigned*)(ws + WS_CTL);
    for (int u = F.tid; u < (LDS_BYTES - LDSCTL_OFF) / 4; u += 512) ((LAS unsigned*)(F.lds + LDSCTL_OFF))[u] = 0u;
    __syncthreads();
    volatile LAS unsigned* MISC = (volatile LAS unsigned*)(F.lds + MISC_OFF);
    XcdBarrier bar = xcd_barrier_post(ctl + CW_BAR, MISC + 8);
    const int lo = a.ph_lo, hi = a.ph_hi;

    const int G = F.G, cb = (int)blockIdx.x;
    const float* MOD = (const float*)(ws + WS_MOD);
    bf16* A0 = (bf16*)(ws + WS_A0); bf16* A1 = (bf16*)(ws + WS_A1); bf16* A2 = (bf16*)(ws + WS_A2); bf16* A3 = (bf16*)(ws + WS_A3); bf16* A4 = (bf16*)(ws + WS_A4); bf16* A5 = (bf16*)(ws + WS_A5);
    float* XB = (float*)(ws + WS_XB);

    #ifndef SKIP_PRO
    if (ON(0) && IN(0)) { for (int rep_ = 0; rep_ < (int)REP(0); ++rep_) phase_prologue(F, a); }
#endif
    SEAM(0);

    layer_body<0>(F, a, bar, ws, ctl, lo, hi);
    layer_body<1>(F, a, bar, ws, ctl, lo, hi);
#undef IN
#undef SEAM
}

extern "C" void kernel_launch(void* const* d_in, const int* in_sizes, int n_in, void* d_out, int out_size, void* d_ws, size_t ws_size, hipStream_t stream) {
    static int grid = 0;
    if (grid == 0) {
        if (n_in != N_IN || out_size != RL * D || ws_size < WS_END) { fprintf(stderr, "kernel_launch: unexpected shapes (n_in %d out %d ws %zu)\n", n_in, out_size, ws_size); grid = -1; return; }
        int dev = 0, cus = 0, per_cu = 0;
        if (hipGetDevice(&dev) != hipSuccess || hipDeviceGetAttribute(&cus, hipDeviceAttributeMultiprocessorCount, dev) != hipSuccess) { grid = -1; return; }
        if (hipFuncSetAttribute((const void*)fwd_kernel, hipFuncAttributeMaxDynamicSharedMemorySize, LDS_BYTES) != hipSuccess) { fprintf(stderr, "kernel_launch: hipFuncSetAttribute failed\n"); grid = -1; return; }
        if (hipOccupancyMaxActiveBlocksPerMultiprocessor(&per_cu, (const void*)fwd_kernel, 512, LDS_BYTES) != hipSuccess || per_cu < 1) fprintf(stderr, "kernel_launch: occupancy query reports %d\n", per_cu);
        (void)hipGetLastError();
        grid = cus;
    }
    if (grid < 0) return;
    (void)hipMemsetAsync((char*)d_ws + WS_CTL, 0, CTL_ZERO_BYTES, stream);
    Args a{};
    for (int i = 0; i < N_IN; ++i) a.in[i] = (const float*)d_in[i];
    a.out = (float*)d_out; a.ws = (unsigned char*)d_ws; a.ph_lo = 0; a.ph_hi = N_PHASES;
    hipLaunchKernelGGL(fwd_kernel, dim3(grid), dim3(512), LDS_BYTES, stream, a);
}
```

```cpp
#include <hip/hip_runtime.h>
#include <cstdio>
#include <cstdint>

#ifndef FAST_GEMM
#define FAST_GEMM 1
#endif
#ifndef FAST_ATTN
#define FAST_ATTN 1
#define ATT_STAGGER 0
#endif

#define GAS __attribute__((address_space(1)))
#define LAS __attribute__((address_space(3)))
typedef unsigned short bf16;
typedef unsigned v4u __attribute__((ext_vector_type(4)));
typedef unsigned v2u __attribute__((ext_vector_type(2)));
typedef float f32x4 __attribute__((ext_vector_type(4)));
typedef float f32x2 __attribute__((ext_vector_type(2)));
typedef float f32x16 __attribute__((ext_vector_type(16)));
typedef short bf16x8 __attribute__((ext_vector_type(8)));
typedef short s16x4 __attribute__((ext_vector_type(4)));

constexpr int D = 1024, NB = 4, SEQ = 4096, CTXL = 256, TK = SEQ + CTXL, RL = NB * SEQ, RC = NB * CTXL, R = RL + RC;
constexpr int NH = 8, HD = 64, VD = 128, INW = 7168, DFF = 2816, NE = 8, DFE = 3584, CK = 31;
constexpr float EPS = 1e-6f;
constexpr float QSCALE = 0.125f * 1.4426950408889634f;
enum { I_X = 0, I_C, I_CTX, I_CCTX, I_WMOD, I_BMOD, I_GMIX, I_WIN, I_QG, I_KG, I_LQ1, I_LK1, I_LQ2, I_LK2, I_SUBLN, I_WATTNO, I_DWW, I_DWB, I_CLNG, I_CLNB, I_WCONVO, I_WOUT, I_GFFN,
       I_WFFG, I_WFFU, I_WFFD, I_WR, I_WEG, I_WEU, I_WED, N_IN };

constexpr size_t MiB = 1u << 20;
constexpr size_t WS_CTL = 0, CTL_ZERO_BYTES = 1 * MiB;
constexpr size_t WS_MOD = 1 * MiB;
constexpr size_t WS_ROPE = 1 * MiB + 256 * 1024;
constexpr size_t WS_LAM = 1 * MiB + 300 * 1024;
constexpr size_t WS_BC = 1 * MiB + 320 * 1024;
constexpr size_t WS_TOK = 2 * MiB;
constexpr size_t WS_SLIST = 2 * MiB + 512 * 1024;
constexpr size_t WS_WIN = 3 * MiB;
constexpr size_t WS_WA = 31 * MiB, WS_WC = 33 * MiB, WS_WO = 35 * MiB;
constexpr size_t WS_WGU0 = 43 * MiB, WS_WD0 = 54 * MiB;
constexpr size_t WS_WEGU = 60 * MiB, WS_WED = 172 * MiB;
constexpr size_t WS_XB = 228 * MiB;
constexpr size_t WS_A0 = 296 * MiB;
constexpr size_t WS_A1 = 330 * MiB;
constexpr size_t WS_A2 = 364 * MiB;
constexpr size_t WS_A3 = 398 * MiB;
constexpr size_t WS_A4 = 432 * MiB;
constexpr size_t WS_A5 = 466 * MiB;
constexpr size_t WS_END = 554 * MiB;
constexpr int CW_BAR = 4096;
constexpr int CW_CNT = 16384;

constexpr int RING_BYTES = 131072, LDSCTL_OFF = RING_BYTES, MISC_OFF = LDSCTL_OFF + 320, MOETAB_OFF = LDSCTL_OFF + 1024, LDS_BYTES = 147456;

#define LDS_WAIT() asm volatile("s_waitcnt lgkmcnt(0)" ::: "memory")
#define VM_WAIT() asm volatile("s_waitcnt vmcnt(0)" ::: "memory")
typedef float f32x2_t __attribute__((ext_vector_type(2)));
typedef __bf16 bf16x2_t __attribute__((ext_vector_type(2)));
__device__ __forceinline__ unsigned cvt_pk_bf16_pin(float lo, float hi) { unsigned r; asm volatile("v_cvt_pk_bf16_f32 %0, %1, %2" : "=v"(r) : "v"(lo), "v"(hi)); return r; }
__device__ __forceinline__ unsigned cvt_pk_bf16(float lo, float hi) { const f32x2_t v = {lo, hi}; const bf16x2_t b = __builtin_convertvector(v, bf16x2_t); return __builtin_bit_cast(unsigned, b); }
__device__ __forceinline__ float bflo(unsigned w) { return __uint_as_float(w << 16); }
__device__ __forceinline__ float bfhi(unsigned w) { return __uint_as_float(w & 0xffff0000u); }
__device__ __forceinline__ float sigm(float x) { return 1.f / (1.f + __expf(-x)); }
__device__ __forceinline__ float sigf(float x) { return __builtin_amdgcn_rcpf(1.f + __builtin_amdgcn_exp2f(x * -1.4426950408889634f)); }
__device__ __forceinline__ float wave_sum(float v) {
#pragma unroll
    for (int o = 1; o < 64; o <<= 1) v += __shfl_xor(v, o);
    return v;
}
__device__ __forceinline__ int row_mi(int row) { return row < RL ? (row >> 12) : 4; }
__device__ __forceinline__ int row_b(int row) { return row < RL ? (row >> 12) : ((row - RL) >> 8); }
__device__ __forceinline__ int row_t(int row) { return row < RL ? (CTXL + (row & 4095)) : ((row - RL) & 255); }

#define XB_TMO      128
#define XB_XCNT(j)  (256  + 64 * (j))
#define XB_XSUB(j)  (1280 + 64 * (j))
#define XB_XGEN(j)  (2304 + 64 * (j))
#define XB_TOP      3328
#define XB_TOPGEN   3392
#define XCD_BAR_WORDS 3456
#define XB_SPIN_CAP (1u << 22)
__device__ __forceinline__ unsigned xb_ld(unsigned* p)              { return __hip_atomic_load(p, __ATOMIC_RELAXED, __HIP_MEMORY_SCOPE_AGENT); }
__device__ __forceinline__ unsigned xb_add(unsigned* p, unsigned v) { return __hip_atomic_fetch_add(p, v, __ATOMIC_RELAXED, __HIP_MEMORY_SCOPE_AGENT); }
__device__ __forceinline__ unsigned xb_xcc_id() { return (unsigned)__builtin_amdgcn_s_getreg((3 << 11) | 20) & 0xFu; }
#define XB_SPIN(cond, bar) do { unsigned _sp = 0; while (cond) { __builtin_amdgcn_s_sleep(1); \
    if ((++_sp & 255u) == 0u) { if (xb_ld(&(bar)[XB_TMO])) break; if (_sp > XB_SPIN_CAP) { atomicAdd(&(bar)[XB_TMO], 1u); break; } } } } while (0)
struct XcdBarrier { unsigned* bar; unsigned x; volatile LAS unsigned* st; };
__device__ __forceinline__ XcdBarrier xcd_barrier_post(unsigned* bar, volatile LAS unsigned* st) {
    XcdBarrier b; b.bar = bar; b.x = xb_xcc_id(); b.st = st;
    if (threadIdx.x == 0) (void)xb_add(&bar[XB_XCNT(b.x)], 1u);
    return b;
}
__device__ __forceinline__ void xcd_barrier_complete(unsigned* bar, unsigned x, unsigned& nloc, unsigned& nx) {
    const unsigned G = gridDim.x * gridDim.y * gridDim.z;
    unsigned sum, cnt, mine, sp = 0u;
    for (;;) {
        sum = 0u; cnt = 0u; mine = 0u;
#pragma unroll
        for (unsigned j = 0; j < 16; ++j) { const unsigned c = xb_ld(&bar[XB_XCNT(j)]); sum += c; cnt += (c > 0u) ? 1u : 0u; mine = (j == x) ? c : mine; }
        if (sum == G) break;
        __builtin_amdgcn_s_sleep(1);
        if ((++sp & 255u) == 0u) { if (xb_ld(&bar[XB_TMO])) break; if (sp > XB_SPIN_CAP) { atomicAdd(&bar[XB_TMO], 1u); break; } }
    }
    nloc = mine > 0u ? mine : 1u; nx = cnt > 0u ? cnt : 1u;
}
__device__ __forceinline__ void xcd_barrier(const XcdBarrier& b) {
    asm volatile("s_waitcnt vmcnt(0)" ::: "memory");
    __syncthreads();
    if (threadIdx.x == 0) {
        unsigned* bar = b.bar;
        __builtin_amdgcn_s_waitcnt(0);
        unsigned nloc = b.st[0], nx = b.st[1];
        if (nloc == 0u) { xcd_barrier_complete(bar, b.x, nloc, nx); b.st[0] = nloc; b.st[1] = nx; }
        const unsigned old = xb_add(&bar[XB_XSUB(b.x)], 1u);
        const unsigned gen = old / nloc;
        if (old + 1u == (gen + 1u) * nloc) {
            __builtin_amdgcn_fence(__ATOMIC_RELEASE, "agent");
            asm volatile("s_waitcnt vmcnt(0)" ::: "memory");
            const unsigned og = xb_add(&bar[XB_TOP], 1u);
            const unsigned tg = og / nx;
            if (og + 1u == (tg + 1u) * nx) xb_add(&bar[XB_TOPGEN], 1u);
            else XB_SPIN(xb_ld(&bar[XB_TOPGEN]) == tg, bar);
            __builtin_amdgcn_fence(__ATOMIC_ACQUIRE, "agent");
            xb_add(&bar[XB_XGEN(b.x)], 1u);
            asm volatile("s_waitcnt vmcnt(0)" ::: "memory");
        } else {
            XB_SPIN(xb_ld(&bar[XB_XGEN(b.x)]) == gen, bar);
            __builtin_amdgcn_fence(__ATOMIC_ACQUIRE, "agent");
            asm volatile("s_waitcnt vmcnt(0)" ::: "memory");
        }
    }
    __syncthreads();
}

struct Unit { const char* A; const char* B; const int* rows; int row0, col0, lo, hi, aux, kt; };

__device__ __forceinline__ void tile_of(int wgid, int nM, int nN, int& pm, int& pn) {
    const int nwg = nM * nN;
    { const int q = nwg / 8, r = nwg % 8, xcd = wgid % 8, off = wgid / 8; wgid = (xcd < r ? xcd * (q + 1) : r * (q + 1) + (xcd - r) * q) + off; }
    const int nig = 8 * nN, gid = wgid / nig, fm = gid * 8, gsz = (nM - fm) < 8 ? (nM - fm) : 8;
    pm = fm + ((wgid % nig) % gsz); pn = (wgid % nig) / gsz;
}
struct SchedPlain {
    const char* A; const char* Bt; int nM, nN, K, G, c;
    __device__ __forceinline__ bool next(int i, Unit& u) const {
        const int L = i * G + c; if (L >= nM * nN) return false;
        int pm, pn; tile_of(L, nM, nN, pm, pn);
        u.A = A + (size_t)pm * 256 * K * 2; u.B = Bt + (size_t)pn * 256 * K * 2; u.rows = nullptr; u.row0 = pm * 256; u.col0 = pn * 256; u.lo = 0; u.hi = 0x7fffffff; u.aux = 0; return true;
    }
};
struct SchedMerge {
    const char* A0; const char* B0; const char* A1; const char* B1; int nM, nN, K, G, c;
    __device__ __forceinline__ bool next(int i, Unit& u) const {
        const int L = (i >> 1) * G + c; if (L >= nM * nN) return false;
        int pm, pn; tile_of(L, nM, nN, pm, pn); const int pass = i & 1;
        u.A = (pass ? A1 : A0) + (size_t)pm * 256 * K * 2; u.B = (pass ? B1 : B0) + (size_t)pn * 256 * K * 2; u.rows = nullptr; u.row0 = pm * 256; u.col0 = pn * 256; u.lo = 0; u.hi = 0x7fffffff; u.aux = pass; return true;
    }
};
struct SchedMoe {
    const char* A; const char* Bt; const int* slist; const LAS int* tab; int NU, nN, K, G, c; size_t bstride; int gather; int Lmax;
    __device__ __forceinline__ bool next(int i, Unit& u) const {
        const int L = i * G + c; if (L >= Lmax) return false;
        int pm, pn; tile_of(L, NU, nN, pm, pn);
        const int tile = __builtin_amdgcn_readfirstlane(tab[pm * 4 + 0]), e = __builtin_amdgcn_readfirstlane(tab[pm * 4 + 1]);
        u.lo = __builtin_amdgcn_readfirstlane(tab[pm * 4 + 2]); u.hi = __builtin_amdgcn_readfirstlane(tab[pm * 4 + 3]);
        u.A = gather ? A : A + (size_t)tile * 256 * K * 2; u.rows = gather ? slist + tile * 256 : nullptr;
        u.B = Bt + (size_t)e * bstride + (size_t)pn * 256 * K * 2; u.row0 = tile * 256; u.col0 = pn * 256; u.aux = e; return true;
    }
};

__device__ __forceinline__ int qk_vec_of(int v) { return ((v >> 8) << 2) | ((v >> 5) & 3); }
__device__ __forceinline__ int qk_dim_of(int v) { const int j = v & 31; return (((v >> 7) & 1) << 5) | (((j >> 2) & 1) << 4) | ((j >> 3) << 2) | (j & 3); }
__device__ __forceinline__ int qk_pos(int d) { return (d & 32) | ((d & 12) << 1) | ((d & 16) >> 2) | (d & 3); }
__device__ __forceinline__ int qk_src_col(int v) { return qk_vec_of(v) * 64 + qk_dim_of(v); }
__device__ __forceinline__ v4u pack8(f32x4 a, f32x4 b) { v4u w; w.x = cvt_pk_bf16(a[0], a[1]); w.y = cvt_pk_bf16(a[2], a[3]); w.z = cvt_pk_bf16(b[0], b[1]); w.w = cvt_pk_bf16(b[2], b[3]); return w; }
__device__ __forceinline__ void unpack8(v4u w, f32x4& a, f32x4& b) { a = (f32x4){bflo(w.x), bfhi(w.x), bflo(w.y), bfhi(w.y)}; b = (f32x4){bflo(w.z), bfhi(w.z), bflo(w.w), bfhi(w.w)}; }
struct EpiInProj {
    static constexpr bool ROW16 = true;
    bf16 *Q, *K, *V, *U0, *GT; const float *qg, *kg, *rope;
    __device__ __forceinline__ void store8(const Unit&, int row, int col, f32x4 v0, f32x4 v1) const {
        if (col < 3072) {
            const int b = row_b(row), t = row_t(row);
            if (col < 2048) {
                const int vec = qk_vec_of(col), d0 = qk_dim_of(col); bf16* base = (vec < 16 ? Q : K) + ((size_t)(((b * NH) * 2 + (vec & 15)) * TK + t) * 64 + qk_pos(d0));
                *(v4u*)base = pack8(v0, v1); }
            else { const v4u w = pack8(v0, v1); const int cc = col - 2048, h = cc >> 7, dv = cc & 127; *(v4u*)(V + ((size_t)((b * NH + h) * TK + t) * 128 + dv)) = w; }
        } else if (col < 5120) {
            const int cc = col - 3072, rem = cc & 255, ch = (cc >> 8) * 128 + (rem & 127) + (rem >> 7) * 4; v2u w; w.x = cvt_pk_bf16(v0[0] * sigf(v1[0]), v0[1] * sigf(v1[1])); w.y = cvt_pk_bf16(v0[2] * sigf(v1[2]), v0[3] * sigf(v1[3]));
            *(v2u*)(U0 + (size_t)row * 1024 + ch) = w;
        } else {
            f32x4 a, b;
#pragma unroll
            for (int j = 0; j < 4; ++j) { a[j] = sigf(v0[j]); b[j] = sigf(v1[j]); }
            *(v4u*)(GT + (size_t)row * 2048 + (col - 5120)) = pack8(a, b);
        }
    }
    __device__ __forceinline__ void store16(const Unit& u, int row, int col, f32x4 a0, f32x4 a1, f32x4 b0, f32x4 b1) const {
        if (col >= 3072 && col < 5120) {
            const int cc = col - 3072; v4u w; w.x = cvt_pk_bf16(a0[0] * sigf(a1[0]), a0[1] * sigf(a1[1])); w.y = cvt_pk_bf16(a0[2] * sigf(a1[2]), a0[3] * sigf(a1[3]));
            w.z = cvt_pk_bf16(b0[0] * sigf(b1[0]), b0[1] * sigf(b1[1])); w.w = cvt_pk_bf16(b0[2] * sigf(b1[2]), b0[3] * sigf(b1[3]));
            *(v4u*)(U0 + (size_t)row * 1024 + ((cc >> 8) * 128 + (cc & 255))) = w; return; }
        if (col >= 2048) { store8(u, row, col, a0, a1); store8(u, row, col + 128, b0, b1); return; }
        const int b = row_b(row), t = row_t(row), vec = qk_vec_of(col), q4 = ((col & 31) >> 3) << 2;
        float ss = 0.f;
#pragma unroll
        for (int r = 0; r < 4; ++r) ss += (a0[r] * a0[r] + a1[r] * a1[r]) + (b0[r] * b0[r] + b1[r] * b1[r]);
        ss += __shfl_xor(ss, 16); ss += __shfl_xor(ss, 32);
        const float rinv = 1.f / sqrtf(ss * (1.f / 64.f) + EPS) * (vec < 16 ? QSCALE : 1.f);
        const float* g = (vec < 16 ? qg : kg) + q4;
        a0 = a0 * rinv * *(const f32x4*)g; a1 = a1 * rinv * *(const f32x4*)(g + 16); b0 = b0 * rinv * *(const f32x4*)(g + 32); b1 = b1 * rinv * *(const f32x4*)(g + 48);
        if (t >= CTXL) { const int sq = t - CTXL; const float* c0p = rope + (sq >> 6) * 16 + q4; const float* c1p = rope + (sq & 63) * 16 + q4;
            const f32x4 c0 = *(const f32x4*)c0p, s0 = *(const f32x4*)(c0p + 1024), c1 = *(const f32x4*)c1p, s1 = *(const f32x4*)(c1p + 1024);
            const f32x4 x0 = a0 * c0 - a1 * s0, x1 = a1 * c0 + a0 * s0, y0 = b0 * c1 - b1 * s1, y1 = b1 * c1 + b0 * s1; a0 = x0; a1 = x1; b0 = y0; b1 = y1; }
        bf16* base = (vec < 16 ? Q : K) + ((size_t)(((b * NH) * 2 + (vec & 15)) * TK + t) * 64 + 2 * q4);
        *(v4u*)base = pack8(a0, a1); *(v4u*)(base + 32) = pack8(b0, b1);
    }
};
struct EpiMerge {
    static constexpr bool ROW16 = false;
    const bf16* GT; bf16* TF; bf16* M1;
    __device__ __forceinline__ void store8(const Unit& u, int row, int col, f32x4 v0, f32x4 v1) const {
        f32x4 g0, g1; unpack8(*(const v4u*)(GT + (size_t)row * 2048 + u.aux * 1024 + col), g0, g1);
        if (u.aux == 0) { *(v4u*)(TF + (size_t)row * 1024 + col) = pack8(g0 * v0, g1 * v1); }
        else { f32x4 t0, t1; unpack8(*(const v4u*)(TF + (size_t)row * 1024 + col), t0, t1); *(v4u*)(M1 + (size_t)row * 1024 + col) = pack8(t0 + g0 * v0, t1 + g1 * v1); }
    }
};
template <bool SB, bool DB>
struct EpiResidT {
    static constexpr bool ROW16 = false;
    const void* src_lat; const void* src_ctx; void* dst; const float* gate;
    __device__ __forceinline__ void store8(const Unit&, int row, int col, f32x4 v0, f32x4 v1) const {
        const float* g = gate + row_mi(row) * 6144 + col; const f32x4 g0 = *(const f32x4*)g, g1 = *(const f32x4*)(g + 4);
        f32x4 s0, s1;
        if constexpr (SB) { const bf16* s = (row < RL ? (const bf16*)src_lat + (size_t)row * 1024 : (const bf16*)src_ctx + (size_t)(row - RL) * 1024) + col; unpack8(*(const v4u*)s, s0, s1); }
        else { const float* s = (row < RL ? (const float*)src_lat + (size_t)row * 1024 : (const float*)src_ctx + (size_t)(row - RL) * 1024) + col; s0 = *(const f32x4*)s; s1 = *(const f32x4*)(s + 4); }
        if constexpr (DB) { *(v4u*)((bf16*)dst + (size_t)row * 1024 + col) = pack8(s0 + g0 * v0, s1 + g1 * v1); }
        else { float* d = (float*)dst + (size_t)row * 1024 + col; *(f32x4*)d = s0 + g0 * v0; *(f32x4*)(d + 4) = s1 + g1 * v1; }
    }
};
struct EpiSwiglu {
    static constexpr bool ROW16 = true;
    bf16* ACT; int ld;
    __device__ __forceinline__ void store8(const Unit&, int row, int col, f32x4 v0, f32x4 v1) const {
        v2u w; w.x = cvt_pk_bf16(v0[0] * sigf(v0[0]) * v1[0], v0[1] * sigf(v0[1]) * v1[1]); w.y = cvt_pk_bf16(v0[2] * sigf(v0[2]) * v1[2], v0[3] * sigf(v0[3]) * v1[3]);
        const int rem = col & 255; *(v2u*)(ACT + (size_t)row * ld + ((col >> 8) * 128 + (rem & 127) + (rem >> 7) * 4)) = w;
    }
    __device__ __forceinline__ void store16(const Unit&, int row, int col, f32x4 a0, f32x4 a1, f32x4 b0, f32x4 b1) const {
        v4u w; w.x = cvt_pk_bf16(a0[0] * sigf(a0[0]) * a1[0], a0[1] * sigf(a0[1]) * a1[1]); w.y = cvt_pk_bf16(a0[2] * sigf(a0[2]) * a1[2], a0[3] * sigf(a0[3]) * a1[3]);
        w.z = cvt_pk_bf16(b0[0] * sigf(b0[0]) * b1[0], b0[1] * sigf(b0[1]) * b1[1]); w.w = cvt_pk_bf16(b0[2] * sigf(b0[2]) * b1[2], b0[3] * sigf(b0[3]) * b1[3]);
        *(v4u*)(ACT + (size_t)row * ld + ((col >> 8) * 128 + (col & 255))) = w;
    }
};
struct SchedMoeDown {
    const char* A; const char* Bt; const LAS int* tab; int NU, whole, left, G, c; size_t bstride;
    __device__ __forceinline__ bool next(int i, Unit& u) const {
        const int Li = i * G + c; int L = Li, kh = 0, split = 0;
        if (Li >= whole) { const int sidx = Li - whole; if (sidx >= 2 * left) return false; L = whole + (sidx >> 1); kh = sidx & 1; split = 1; }
        int pm, pn; tile_of(L, NU, 4, pm, pn);
        const int tile = __builtin_amdgcn_readfirstlane(tab[pm * 4 + 0]), e = __builtin_amdgcn_readfirstlane(tab[pm * 4 + 1]);
        u.lo = __builtin_amdgcn_readfirstlane(tab[pm * 4 + 2]); u.hi = __builtin_amdgcn_readfirstlane(tab[pm * 4 + 3]);
        u.A = A + ((size_t)tile * 256 * DFE + (size_t)kh * (DFE / 2)) * 2; u.rows = nullptr;
        u.B = Bt + (size_t)e * bstride + ((size_t)pn * 256 * DFE + (size_t)kh * (DFE / 2)) * 2; u.row0 = tile * 256; u.col0 = pn * 256; u.aux = split; u.kt = split ? DFE / 128 : DFE / 64; return true;
    }
};
struct EpiMoeDown { bf16* O; int ld;
    static constexpr bool ROW16 = false;
    __device__ __forceinline__ void store8(const Unit& u, int row, int col, f32x4 v0, f32x4 v1) const {
        const v4u w = pack8(v0, v1); bf16* d = O + (size_t)row * ld + col;
        if (u.aux) {
            asm volatile("global_atomic_pk_add_bf16 %0, %1, off sc1\n\tglobal_atomic_pk_add_bf16 %0, %2, off offset:4 sc1\n\tglobal_atomic_pk_add_bf16 %0, %3, off offset:8 sc1\n\tglobal_atomic_pk_add_bf16 %0, %4, off offset:12 sc1"
                         :: "v"(d), "v"(w.x), "v"(w.y), "v"(w.z), "v"(w.w) : "memory"); }
        else *(v4u*)d = w;
    }
};
struct EpiBf16Plain { bf16* O; int ld;
    static constexpr bool ROW16 = false;
    __device__ __forceinline__ void store8(const Unit&, int row, int col, f32x4 v0, f32x4 v1) const { *(v4u*)(O + (size_t)row * ld + col) = pack8(v0, v1); }
};

template <class Epi, class Sched>
__device__ __forceinline__ void gemm_naive(LAS unsigned char* lds, const int K, const Sched& S, const Epi& E) {
    LAS float* As = (LAS float*)lds; LAS float* Bs = As + 32 * 132;
    const int tid = threadIdx.x, ty = tid >> 4, tx = tid & 15, lr = tid >> 2, kc = (tid & 3) * 8;
    Unit u;
    for (int i = 0; S.next(i, u); ++i) {
        for (int sub = 0; sub < 4; ++sub) {
            const int rm = (sub >> 1) * 128, cn = (sub & 1) * 128;
            const size_t arow = u.rows ? (size_t)u.rows[rm + lr] : (size_t)(rm + lr);
            const bf16* ap = (const bf16*)u.A + arow * K + kc; const bf16* bp = (const bf16*)u.B + (size_t)(cn + lr) * K + kc;
            float acc[4][8];
#pragma unroll
            for (int r = 0; r < 4; ++r)
#pragma unroll
                for (int c = 0; c < 8; ++c) acc[r][c] = 0.f;
            for (int k0 = 0; k0 < K; k0 += 32) {
                const v4u av = *(const v4u*)(ap + k0), bv = *(const v4u*)(bp + k0);
                f32x4 a0, a1, b0, b1; unpack8(av, a0, a1); unpack8(bv, b0, b1);
#pragma unroll
                for (int j = 0; j < 4; ++j) { As[(kc + j) * 132 + lr] = a0[j]; As[(kc + 4 + j) * 132 + lr] = a1[j]; Bs[(kc + j) * 132 + lr] = b0[j]; Bs[(kc + 4 + j) * 132 + lr] = b1[j]; }
                __syncthreads();
#pragma unroll 4
                for (int kk = 0; kk < 32; ++kk) {
                    const f32x4 a = *(const LAS f32x4*)(As + kk * 132 + ty * 4), p = *(const LAS f32x4*)(Bs + kk * 132 + tx * 8), q = *(const LAS f32x4*)(Bs + kk * 132 + tx * 8 + 4);
#pragma unroll
                    for (int r = 0; r < 4; ++r) {
#pragma unroll
                        for (int c = 0; c < 4; ++c) { acc[r][c] += a[r] * p[c]; acc[r][4 + c] += a[r] * q[c]; } }
                }
                __syncthreads();
            }
#pragma unroll
            for (int r = 0; r < 4; ++r) { const int row = u.row0 + rm + ty * 4 + r;
                if (row >= u.lo && row < u.hi) E.store8(u, row, u.col0 + cn + tx * 8, (f32x4){acc[r][0], acc[r][1], acc[r][2], acc[r][3]}, (f32x4){acc[r][4], acc[r][5], acc[r][6], acc[r][7]}); }
        }
    }
}

namespace pg8 {
constexpr int BM = 256, BK = 64, HALF = 128, HTB = HALF * BK * 2, STAGE_BYTES = 8 * HTB;
__device__ __forceinline__ int lds_byte(int r, int c) { const int st = (r >> 4) * 2 + (c >> 5), rr = r & 15, cc = c & 31, ob = rr * 64 + cc * 2; return st * 1024 + (ob ^ (((ob >> 9) & 1) << 5)); }
__device__ __forceinline__ void stage_rc(int b, int& R_, int& C_) { const int st = b / 1024, sb = b % 1024, swz = sb ^ (((sb >> 9) & 1) << 5); R_ = (st >> 1) * 16 + swz / 64; C_ = (st & 1) * 32 + (swz % 64) / 2; }
__device__ __forceinline__ int perm32(int rho) { const int n = rho >> 4, i = rho & 15; return 8 * (i >> 2) + 4 * n + (i & 3); }

template <class Epi, class Sched, bool GATHER, int KPITCH = 0, bool VARK = false>
__device__ __forceinline__ void gemm_phase(LAS unsigned char* lds, const int K, const Sched& S, const Epi& E) {
    const int Kp = KPITCH ? KPITCH : K;
    const int tid = threadIdx.x, wid = __builtin_amdgcn_readfirstlane(tid >> 6), lane = tid & 63, wr = wid >> 2, wc = wid & 3, fr = lane & 15, fq = lane >> 4;
    const int nt = K / BK;
    int Rr[2], Cc[2]; unsigned voffB[2];
#pragma unroll
    for (int i = 0; i < 2; ++i) { stage_rc(tid * 16 + i * 8192, Rr[i], Cc[i]); const int Rb = (Rr[i] & ~31) + perm32(Rr[i] & 31); voffB[i] = (unsigned)(Rb * Kp + Cc[i]) * 2u; }
    const size_t kstep = (size_t)(BK * 2), hstep = (size_t)HALF * Kp * 2;
    const unsigned ldsw = (unsigned)wid * 1024u;
    const int aoff = lds_byte(wr * 64 + fr, fq * 8), boff = lds_byte(wc * 32 + fr, fq * 8);
#define PG8_SA(b, h) (((b) * 2 + (h)) * HTB)
#define PG8_SB(b, h) ((4 + (b) * 2 + (h)) * HTB)
#define PG8_STAGE2(bufoff, gbase, o0, o1) do { \
        __builtin_amdgcn_global_load_lds((const unsigned*)((const char*)(gbase) + (o0)), (LAS unsigned*)(lds + (bufoff) + ldsw), 16, 0, 0); \
        __builtin_amdgcn_global_load_lds((const unsigned*)((const char*)(gbase) + (o1)), (LAS unsigned*)(lds + (bufoff) + ldsw + 8192), 16, 0, 0); } while (0)
#define PG8_STAGEB(bufoff, gbase) PG8_STAGE2(bufoff, gbase, voffB[0], voffB[1])
#define PG8_LDA(dst, b, h) do { _Pragma("unroll") for (int m = 0; m < 4; ++m) _Pragma("unroll") for (int k = 0; k < 2; ++k) dst[m][k] = *(const LAS bf16x8*)(lds + PG8_SA(b, h) + aoff + m * 2048 + k * 1024); } while (0)
#define PG8_LDB(dst, b, h) do { _Pragma("unroll") for (int n = 0; n < 2; ++n) _Pragma("unroll") for (int k = 0; k < 2; ++k) dst[n][k] = *(const LAS bf16x8*)(lds + PG8_SB(b, h) + boff + n * 2048 + k * 1024); } while (0)
#define PG8_MMA(ai, bj, At, Bt) do { __builtin_amdgcn_s_setprio(1); _Pragma("unroll") for (int m = 0; m < 4; ++m) _Pragma("unroll") for (int n = 0; n < 2; ++n) _Pragma("unroll") for (int k = 0; k < 2; ++k) \
        acc[ai][bj][m][n] = __builtin_amdgcn_mfma_f32_16x16x32_bf16(Bt[n][k], At[m][k], acc[ai][bj][m][n], 0, 0, 0); __builtin_amdgcn_s_setprio(0); } while (0)
#define PG8_WAIT_V(n) asm volatile("s_waitcnt vmcnt(" #n ")" ::: "memory")
#define PG8_WAIT_L(n) asm volatile("s_waitcnt lgkmcnt(" #n ")" ::: "memory")
#define PG8_BAR __builtin_amdgcn_s_barrier()
#define PG8_SCHED __builtin_amdgcn_sched_barrier(0)
#define PG8_OFFS(u, o0, o1) do { _Pragma("unroll") for (int _i = 0; _i < 2; ++_i) { \
        if (GATHER && (u).rows) { const unsigned r0_ = (unsigned)(u).rows[Rr[_i]], r1_ = (unsigned)(u).rows[Rr[_i] + HALF]; o0[_i] = (r0_ * (unsigned)Kp + (unsigned)Cc[_i]) * 2u; o1[_i] = (r1_ * (unsigned)Kp + (unsigned)Cc[_i]) * 2u; } \
        else { o0[_i] = (unsigned)(Rr[_i] * Kp + Cc[_i]) * 2u; o1[_i] = o0[_i] + (unsigned)hstep; } } } while (0)
    Unit cur, nxt; int ui = 0;
    if (!S.next(0, cur)) return;
    f32x4 acc[2][2][4][2];
#pragma unroll
    for (int a = 0; a < 2; ++a)
#pragma unroll
        for (int b = 0; b < 2; ++b)
#pragma unroll
            for (int m = 0; m < 4; ++m)
#pragma unroll
                for (int n = 0; n < 2; ++n) acc[a][b][m][n] = (f32x4){0.f, 0.f, 0.f, 0.f};
    bf16x8 At[4][2], B0[2][2], B1[2][2];
    unsigned vA0[2], vA1[2], nA0[2], nA1[2];
    PG8_OFFS(cur, vA0, vA1);
    const char* cA = cur.A; const char* cB = cur.B;
    PG8_STAGEB(PG8_SB(0, 0), cB); PG8_STAGEB(PG8_SB(0, 1), cB + hstep); PG8_STAGE2(PG8_SA(0, 0), cA, vA0[0], vA0[1]); PG8_STAGE2(PG8_SA(0, 1), cA, vA1[0], vA1[1]);
    if (wr == 1) PG8_BAR;
    PG8_WAIT_V(2); PG8_BAR;
    PG8_STAGEB(PG8_SB(1, 0), cB + kstep); PG8_STAGE2(PG8_SA(1, 0), cA + kstep, vA0[0], vA0[1]); PG8_STAGEB(PG8_SB(1, 1), cB + hstep + kstep);
    PG8_WAIT_V(6); PG8_BAR;
    for (;;) {
        const bool has_next = S.next(ui + 1, nxt);
        const char* nA = has_next ? nxt.A : cA; const char* nB = has_next ? nxt.B : cB;
        if (GATHER) { if (has_next) { PG8_OFFS(nxt, nA0, nA1); } else {
#pragma unroll
            for (int i = 0; i < 2; ++i) { nA0[i] = vA0[i]; nA1[i] = vA1[i]; } } }
        const int ntu = VARK ? cur.kt : nt;
        for (int t = 0; t < ntu; t += 2) {
            const bool last = (t == ntu - 2);
            const char* a1 = cA + (size_t)(t + 1) * kstep;
            const char* a2 = last ? nA : cA + (size_t)(t + 2) * kstep; const char* b2 = last ? nB : cB + (size_t)(t + 2) * kstep;
            const char* a3 = a2 + kstep; const char* b3 = b2 + kstep;
            unsigned x00 = vA0[0], x01 = vA0[1], x10 = vA1[0], x11 = vA1[1];
            if (GATHER) { if (last) { x00 = nA0[0]; x01 = nA0[1]; x10 = nA1[0]; x11 = nA1[1]; } }
            PG8_LDB(B0, 0, 0); PG8_LDB(B1, 0, 1); PG8_SCHED; PG8_LDA(At, 0, 0); PG8_STAGE2(PG8_SA(1, 1), a1, vA1[0], vA1[1]);
            PG8_WAIT_V(8); PG8_WAIT_L(0); PG8_BAR; PG8_MMA(0, 0, At, B0); PG8_MMA(0, 1, At, B1); PG8_BAR; PG8_SCHED;
            PG8_LDA(At, 0, 1); PG8_STAGEB(PG8_SB(0, 0), b2); PG8_STAGEB(PG8_SB(0, 1), b2 + hstep); PG8_STAGE2(PG8_SA(0, 0), a2, x00, x01);
            PG8_WAIT_V(8); PG8_WAIT_L(0); PG8_BAR; PG8_MMA(1, 0, At, B0); PG8_MMA(1, 1, At, B1); PG8_BAR; PG8_SCHED;
            PG8_LDB(B0, 1, 0); PG8_LDB(B1, 1, 1); PG8_SCHED; PG8_LDA(At, 1, 0); PG8_STAGE2(PG8_SA(0, 1), a2, x10, x11);
            PG8_WAIT_V(8); PG8_WAIT_L(0); PG8_BAR; PG8_MMA(0, 0, At, B0); PG8_MMA(0, 1, At, B1); PG8_BAR; PG8_SCHED;
            PG8_LDA(At, 1, 1); PG8_STAGEB(PG8_SB(1, 0), b3); PG8_STAGEB(PG8_SB(1, 1), b3 + hstep); PG8_STAGE2(PG8_SA(1, 0), a3, x00, x01);
            PG8_WAIT_V(8); PG8_WAIT_L(0); PG8_BAR; PG8_MMA(1, 0, At, B0); PG8_MMA(1, 1, At, B1); PG8_BAR; PG8_SCHED;
        }
        if (wr == 0) PG8_BAR;
        {
            const int row0 = cur.row0 + wr * 64 + fr, colb = cur.col0 + wc * 32 + 8 * fq;
#pragma unroll
            for (int ai = 0; ai < 2; ++ai)
#pragma unroll
                for (int m = 0; m < 4; ++m) { const int row = row0 + ai * HALF + m * 16;
                    if (row >= cur.lo && row < cur.hi) {
                        if constexpr (Epi::ROW16) E.store16(cur, row, colb, acc[ai][0][m][0], acc[ai][0][m][1], acc[ai][1][m][0], acc[ai][1][m][1]);
                        else {
#pragma unroll
                            for (int bj = 0; bj < 2; ++bj) E.store8(cur, row, colb + bj * HALF, acc[ai][bj][m][0], acc[ai][bj][m][1]); } } }
        }
        if (!has_next) break;
#pragma unroll
        for (int a = 0; a < 2; ++a)
#pragma unroll
            for (int b = 0; b < 2; ++b)
#pragma unroll
                for (int m = 0; m < 4; ++m)
#pragma unroll
                    for (int n = 0; n < 2; ++n) acc[a][b][m][n] = (f32x4){0.f, 0.f, 0.f, 0.f};
        cur = nxt; cA = nA; cB = nB; ++ui;
        if (GATHER) {
#pragma unroll
            for (int i = 0; i < 2; ++i) { vA0[i] = nA0[i]; vA1[i] = nA1[i]; } }
        if (wr == 1) PG8_BAR;
    }
    PG8_WAIT_V(0);
    PG8_BAR;
#undef PG8_SA
#undef PG8_SB
#undef PG8_STAGE2
#undef PG8_STAGEB
#undef PG8_LDA
#undef PG8_LDB
#undef PG8_MMA
#undef PG8_WAIT_V
#undef PG8_WAIT_L
#undef PG8_BAR
#undef PG8_SCHED
#undef PG8_OFFS
}
}


template <bool MASK = false, class Epi>
__device__ __forceinline__ void gemm_small_tile(LAS unsigned char* lds, const bf16* A, const bf16* Bt, int K, int row_abs0, int col_abs0, const Unit& u, const Epi& E) {
    const int tid = threadIdx.x, wid = __builtin_amdgcn_readfirstlane(tid >> 6), lane = tid & 63, fr = lane & 15, fq = lane >> 4;
    const int kw = K >> 3, kbeg = wid * kw;
    f32x4 acc[4][2][2];
#pragma unroll
    for (int m = 0; m < 4; ++m)
#pragma unroll
        for (int g = 0; g < 2; ++g)
#pragma unroll
            for (int n = 0; n < 2; ++n) acc[m][g][n] = (f32x4){0.f, 0.f, 0.f, 0.f};
    const bf16* ap = A + (size_t)fr * K + kbeg + 8 * fq;
    const bf16* bp = Bt + (size_t)(8 * (fr >> 2) + (fr & 3)) * K + kbeg + 8 * fq;
#pragma unroll 4
    for (int k0 = 0; k0 < kw; k0 += 32) {
        bf16x8 af[4], bfr[2][2];
#pragma unroll
        for (int m = 0; m < 4; ++m) af[m] = *(const bf16x8*)(ap + (size_t)(16 * m) * K + k0);
#pragma unroll
        for (int g = 0; g < 2; ++g)
#pragma unroll
            for (int n = 0; n < 2; ++n) bfr[g][n] = *(const bf16x8*)(bp + (size_t)(32 * g + 4 * n) * K + k0);
#pragma unroll
        for (int m = 0; m < 4; ++m)
#pragma unroll
            for (int g = 0; g < 2; ++g)
#pragma unroll
                for (int n = 0; n < 2; ++n) acc[m][g][n] = __builtin_amdgcn_mfma_f32_16x16x32_bf16(bfr[g][n], af[m], acc[m][g][n], 0, 0, 0);
    }
    LAS float* P = (LAS float*)lds + wid * 4096;
#pragma unroll
    for (int m = 0; m < 4; ++m)
#pragma unroll
        for (int g = 0; g < 2; ++g)
#pragma unroll
            for (int n = 0; n < 2; ++n) *(LAS f32x4*)(P + (16 * m + fr) * 64 + (((8 * g + 2 * fq + n) ^ fr) << 2)) = acc[m][g][n];
    __syncthreads();
    { const int r = tid >> 3, c8 = (tid & 7) * 8; f32x4 v0 = (f32x4){0.f, 0.f, 0.f, 0.f}, v1 = v0;
#pragma unroll
      for (int w = 0; w < 8; ++w) { const LAS float* q = (const LAS float*)lds + w * 4096 + r * 64; v0 += *(const LAS f32x4*)(q + ((((c8 >> 2)) ^ (r & 15)) << 2)); v1 += *(const LAS f32x4*)(q + ((((c8 >> 2) + 1) ^ (r & 15)) << 2)); }
      if (!MASK || (row_abs0 + r >= u.lo && row_abs0 + r < u.hi)) E.store8(u, row_abs0 + r, col_abs0 + c8, v0, v1); }
    __syncthreads();
}

template <bool GATHER, int KPITCH = 0, bool VARK = false, class Epi, class Sched>
__device__ __forceinline__ void run_gemm(LAS unsigned char* lds, int K, const Sched& S, const Epi& E) {
#if FAST_GEMM
    pg8::gemm_phase<Epi, Sched, GATHER, KPITCH, VARK>(lds, K, S, E);
#else
    gemm_naive<Epi, Sched>(lds, K, S, E);
    __syncthreads();
#endif
}

struct Args { const float* in[N_IN]; float* out; unsigned char* ws; int ph_lo, ph_hi; };
struct Frame { LAS unsigned char* lds; int tid, lane, wave, vcu, G; };

__device__ __forceinline__ void attn_naive(const Frame& F, const bf16* Q, const bf16* Kb, const bf16* Vb, bf16* ON, const float* subln, const float* lamv, bool with_ctx) {
    LAS float* Qs = (LAS float*)F.lds;
    LAS float* Ks = Qs + 16 * 128;
    LAS float* Vs = Ks + 2 * 64 * 65;
    LAS float* Ps = Vs + 64 * 128;
    const int tid = F.tid, qi = tid >> 5, sl = tid & 31;
    const float lam = lamv[0], oscale = lamv[1];
    const int n_lat = NB * NH * (SEQ / 16), n_ctx = with_ctx ? NB * NH * (CTXL / 16) : 0;
    for (int unit = F.vcu; unit < n_lat + n_ctx; unit += F.G) {
        int b, h, t0, nkeys;
        if (unit < n_lat) { b = unit / (NH * (SEQ / 16)); const int r = unit % (NH * (SEQ / 16)); h = r / (SEQ / 16); t0 = CTXL + (r % (SEQ / 16)) * 16; nkeys = TK; }
        else { const int uu = unit - n_lat; b = uu / (NH * (CTXL / 16)); const int r = uu % (NH * (CTXL / 16)); h = r / (CTXL / 16); t0 = (r % (CTXL / 16)) * 16; nkeys = CTXL; }
        __syncthreads();
        for (int idx = tid; idx < 16 * 128; idx += 512) { const int q = idx >> 7, cd = idx & 127, c = cd >> 6, d = cd & 63;
            Qs[idx] = __uint_as_float((unsigned)Q[(size_t)(((b * NH + h) * 2 + c) * TK + t0 + q) * 64 + d] << 16); }
        float o0[4] = {0, 0, 0, 0}, o1[4] = {0, 0, 0, 0}, l0 = 0.f, l1 = 0.f;
        for (int k0 = 0; k0 < nkeys; k0 += 64) {
            __syncthreads();
            for (int idx = tid; idx < 2 * 64 * 64; idx += 512) { const int c = idx >> 12, key = (idx >> 6) & 63, d = idx & 63;
                Ks[(c * 64 + key) * 65 + d] = __uint_as_float((unsigned)Kb[(size_t)(((b * NH + h) * 2 + c) * TK + k0 + key) * 64 + d] << 16); }
            for (int idx = tid; idx < 64 * 128; idx += 512) { const int key = idx >> 7, dv = idx & 127;
                Vs[idx] = __uint_as_float((unsigned)Vb[(size_t)((b * NH + h) * TK + k0 + key) * 128 + dv] << 16); }
            __syncthreads();
#pragma unroll
            for (int c = 0; c < 2; ++c)
#pragma unroll
                for (int kk = 0; kk < 2; ++kk) { const int key = sl + 32 * kk; float s = 0.f;
                    for (int d = 0; d < 64; ++d) s += Qs[qi * 128 + c * 64 + d] * Ks[(c * 64 + key) * 65 + d];
                    Ps[(c * 16 + qi) * 64 + key] = __builtin_amdgcn_exp2f(s); }
            __syncthreads();
            for (int key = 0; key < 64; ++key) { const float p0 = Ps[qi * 64 + key], p1 = Ps[(16 + qi) * 64 + key]; const f32x4 v = *(const LAS f32x4*)(Vs + key * 128 + sl * 4);
                l0 += p0; l1 += p1;
#pragma unroll
                for (int j = 0; j < 4; ++j) { o0[j] += p0 * v[j]; o1[j] += p1 * v[j]; } }
        }
        const float i0 = 1.f / l0, i1 = lam / l1; float o[4], ss = 0.f;
#pragma unroll
        for (int j = 0; j < 4; ++j) { o[j] = o0[j] * i0 - o1[j] * i1; ss += o[j] * o[j]; }
#pragma unroll
        for (int m = 1; m < 32; m <<= 1) ss += __shfl_xor(ss, m);
        const float rinv = 1.f / sqrtf(ss * (1.f / 128.f) + EPS) * oscale;
        const int t = t0 + qi, row = t >= CTXL ? b * SEQ + (t - CTXL) : RL + b * CTXL + t;
        const f32x4 g = *(const f32x4*)(subln + sl * 4);
        v2u w; w.x = cvt_pk_bf16(o[0] * rinv * g[0], o[1] * rinv * g[1]); w.y = cvt_pk_bf16(o[2] * rinv * g[2], o[3] * rinv * g[3]);
        *(v2u*)(ON + (size_t)row * 1024 + h * 128 + sl * 4) = w;
    }
    __syncthreads();
}


namespace att {
#define SBAR() __builtin_amdgcn_sched_barrier(0)
constexpr int STAGE = 32768, ST_K1 = 8192, ST_V = 16384, OFF_WS = 3 * STAGE;
__device__ __forceinline__ int crow(int r, int hi) { return (r & 3) + 8 * (r >> 2) + 4 * hi; }
__device__ __forceinline__ int v_st(int k, int c) { const int kk = (k & ~0xC) | ((k & 4) << 1) | ((k & 8) >> 1); return ((kk >> 3) * 4 + (c >> 5)) * 512 + ((kk & 7) * 32 + (c & 31)) * 2; }
__device__ __forceinline__ int v_rd_base(int lane) { return ((lane & 3) << 3) | (((lane >> 2) & 3) << 6) | (((lane >> 4) & 1) << 5) | (((lane >> 5) & 1) << 8); }
constexpr int v_rd_off(int d0, int ks, int half) { return d0 * 512 + ks * 4096 + half * 2048; }
template <int OFF> __device__ __forceinline__ s16x4 tr_read(int vb) { s16x4 r; asm volatile("ds_read_b64_tr_b16 %0, %1 offset:%2" : "=&v"(r) : "v"(vb), "i"(OFF) : "memory"); return r; }
template <int D0> __device__ __forceinline__ void pv_one(f32x16& od, int vb, bf16x8 pa0, bf16x8 pa1, bf16x8 pa2, bf16x8 pa3) {
    const s16x4 l0 = tr_read<v_rd_off(D0, 0, 0)>(vb), h0 = tr_read<v_rd_off(D0, 0, 1)>(vb), l1 = tr_read<v_rd_off(D0, 1, 0)>(vb), h1 = tr_read<v_rd_off(D0, 1, 1)>(vb);
    const s16x4 l2 = tr_read<v_rd_off(D0, 2, 0)>(vb), h2 = tr_read<v_rd_off(D0, 2, 1)>(vb), l3 = tr_read<v_rd_off(D0, 3, 0)>(vb), h3 = tr_read<v_rd_off(D0, 3, 1)>(vb);
    asm volatile("s_waitcnt lgkmcnt(0)" ::: "memory"); SBAR();
#define ATT_PK(L, H) (bf16x8){L[0], L[1], L[2], L[3], H[0], H[1], H[2], H[3]}
    od = __builtin_amdgcn_mfma_f32_32x32x16_bf16(pa0, ATT_PK(l0, h0), od, 0, 0, 0);
    od = __builtin_amdgcn_mfma_f32_32x32x16_bf16(pa1, ATT_PK(l1, h1), od, 0, 0, 0);
    od = __builtin_amdgcn_mfma_f32_32x32x16_bf16(pa2, ATT_PK(l2, h2), od, 0, 0, 0);
    od = __builtin_amdgcn_mfma_f32_32x32x16_bf16(pa3, ATT_PK(l3, h3), od, 0, 0, 0);
#undef ATT_PK
}
template <int VAR> __device__ __forceinline__ void pv_d0(f32x16 (&o)[4], int vb, bf16x8 pa0, bf16x8 pa1, bf16x8 pa2, bf16x8 pa3) {
    if (VAR == 2) { asm volatile("" :: "v"(pa0), "v"(pa1), "v"(pa2), "v"(pa3)); return; }
    pv_one<0>(o[0], vb, pa0, pa1, pa2, pa3); pv_one<1>(o[1], vb, pa0, pa1, pa2, pa3); pv_one<2>(o[2], vb, pa0, pa1, pa2, pa3); pv_one<3>(o[3], vb, pa0, pa1, pa2, pa3);
}
#define ATT_PK4(P, BASE, OUT) do { unsigned a0 = cvt_pk_bf16(P[BASE + 0], P[BASE + 1]), a1 = cvt_pk_bf16(P[BASE + 2], P[BASE + 3]); \
    unsigned b0 = cvt_pk_bf16(P[BASE + 4], P[BASE + 5]), b1 = cvt_pk_bf16(P[BASE + 6], P[BASE + 7]); \
    auto r0 = __builtin_amdgcn_permlane32_swap(a0, b0, false, false); auto r1 = __builtin_amdgcn_permlane32_swap(a1, b1, false, false); \
    v4u w = {r0[0], r1[0], r0[1], r1[1]}; OUT = *reinterpret_cast<bf16x8*>(&w); } while (0)
template <int VAR> __device__ __forceinline__ void half_a(f32x16& p, float& ps, bf16x8& pa0, bf16x8& pa1) {
    if (VAR != 1) {
#pragma unroll
    for (int r = 0; r < 16; ++r) p[r] = __builtin_amdgcn_exp2f(p[r]); }
    float s = 0.f;
#pragma unroll
    for (int r = 0; r < 16; ++r) s += p[r];
    ps = s;
    ATT_PK4(p, 0, pa0); ATT_PK4(p, 8, pa1);
}
template <int VAR> __device__ __forceinline__ void half_b(f32x16& p, float ps, float& l_reg, bf16x8& pa2, bf16x8& pa3) {
    if (VAR != 1) {
#pragma unroll
    for (int r = 0; r < 16; ++r) p[r] = __builtin_amdgcn_exp2f(p[r]); }
#pragma unroll
    for (int r = 0; r < 16; ++r) ps += p[r];
    { auto rr = __builtin_amdgcn_permlane32_swap(__float_as_uint(ps), __float_as_uint(ps), false, false); ps = __uint_as_float(rr[0]) + __uint_as_float(rr[1]); }
    l_reg += ps;
    ATT_PK4(p, 0, pa2); ATT_PK4(p, 8, pa3);
}
__device__ __forceinline__ void qkt(f32x16& p0, f32x16& p1, const LAS unsigned char* Ks, const bf16x8 (&qr)[4], int r32, int hi) {
    p0 = f32x16{}; p1 = f32x16{};
    const int swz = (r32 >> 1) & 7;
#pragma unroll
    for (int d0 = 0; d0 < 4; ++d0) { const int off = r32 * 128 + (((d0 * 2 + hi) ^ swz) << 4);
        const bf16x8 b0 = *(const LAS bf16x8*)(Ks + off), b1 = *(const LAS bf16x8*)(Ks + 4096 + off);
        p0 = __builtin_amdgcn_mfma_f32_32x32x16_bf16(b0, qr[d0], p0, 0, 0, 0);
        p1 = __builtin_amdgcn_mfma_f32_32x32x16_bf16(b1, qr[d0], p1, 0, 0, 0); }
}
}

template <int VAR>
__device__ __forceinline__ void attn_fast(const Frame& F, const bf16* Q, const bf16* Kb, const bf16* Vb, bf16* ON, const float* subln, const float* lamv, bool with_ctx) {
    using namespace att;
    LAS unsigned char* lds = F.lds;
    const int tid = F.tid, wid = F.wave, lane = F.lane, r32 = lane & 31, hi = lane >> 5, comp = wid >> 2, wq = wid & 3;
    LAS float* li_l = (LAS float*)(lds + OFF_WS) + wid * 64;
    const int sr = tid >> 4, sc = (tid & 15) * 8, vst0 = v_st(sr, sc);
    const int krow = tid >> 3, kst = krow * 128 + (((tid & 7) ^ ((krow >> 1) & 7)) << 4);
    const int vb0 = (int)(uintptr_t)(lds + ST_V) + v_rd_base(lane);
    const unsigned koffb = (unsigned)tid * 16u, voffb = (unsigned)(sr * 128 + sc) * 2u;
    const LAS unsigned char* Kl = lds + comp * ST_K1;
    const float lam = __builtin_bit_cast(float, __builtin_amdgcn_readfirstlane(__builtin_bit_cast(int, lamv[0]))), oscale = __builtin_bit_cast(float, __builtin_amdgcn_readfirstlane(__builtin_bit_cast(int, lamv[1])));
    const int n_lat = NB * NH * (SEQ / 128), n_ctx = with_ctx ? NB * NH * (CTXL / 128) : 0;
    for (int unit = F.vcu; unit < n_lat + n_ctx; unit += F.G) {
        int b, h, t0, NT;
        if (unit < n_lat) { const int bh = unit >> 5; b = bh >> 3; h = bh & 7; t0 = CTXL + (unit & 31) * 128; NT = TK / 64; }
        else { const int uu = unit - n_lat, bh = uu >> 1; b = bh >> 3; h = bh & 7; t0 = (uu & 1) * 128; NT = CTXL / 64; }
        const char* K0u = (const char*)(Kb + (size_t)((b * NH + h) * 2) * TK * 64); const char* K1u = K0u + (size_t)TK * 128;
        const char* V0u = (const char*)(Vb + (size_t)(b * NH + h) * TK * 128); const char* V1u = V0u + 32 * 256;
        bf16x8 qr[4];
        { const bf16* Qw = Q + ((size_t)((b * NH + h) * 2 + comp) * TK + t0 + wq * 32 + r32) * 64 + hi * 8;
#pragma unroll
          for (int d0 = 0; d0 < 4; ++d0) qr[d0] = *(const bf16x8*)(Qw + d0 * 16); }
        float l_reg = 0.f; f32x16 o[4] = {};
        struct { bf16x8 vs0, vs1, ks0, ks1; } st_[2];
#define ATT_SLOAD(i, k0) do { st_[i].vs0 = *(const bf16x8*)(V0u + (size_t)(k0) * 256 + voffb); st_[i].vs1 = *(const bf16x8*)(V1u + (size_t)(k0) * 256 + voffb); \
        st_[i].ks0 = *(const bf16x8*)(K0u + (size_t)(k0) * 128 + koffb); st_[i].ks1 = *(const bf16x8*)(K1u + (size_t)(k0) * 128 + koffb); } while (0)
#define ATT_SWRITE(so, i) do { *(LAS bf16x8*)(lds + (so) + ST_V + vst0) = st_[i].vs0; *(LAS bf16x8*)(lds + (so) + ST_V + 8192 + vst0) = st_[i].vs1; \
        *(LAS bf16x8*)(lds + (so) + kst) = st_[i].ks0; *(LAS bf16x8*)(lds + (so) + ST_K1 + kst) = st_[i].ks1; } while (0)
        f32x16 pA0, pA1, pB0, pB1; bf16x8 pa0, pa1, pa2, pa3; float ps;
#define ATT_ITER(c0, c1, n0, n1, WS, LS) do { \
        SBAR(); qkt(n0, n1, Kl + sN, qr, r32, hi); half_b<VAR>(c1, ps, l_reg, pa2, pa3); SBAR(); \
        if (j + 3 < NT) ATT_SLOAD(LS, (j + 3) * 64); SBAR(); \
        pv_d0<VAR>(o, vb0 + sC, pa0, pa1, pa2, pa3); half_a<VAR>(n0, ps, pa0, pa1); \
        if (j + 2 < NT) { if (j + 3 < NT) asm volatile("s_waitcnt vmcnt(4)" ::: "memory"); else asm volatile("s_waitcnt vmcnt(0)" ::: "memory"); ATT_SWRITE(sW, WS); } \
        __syncthreads(); { const int t_ = sC; sC = sN; sN = sW; sW = t_; } ++j; } while (0)
        int sC = 0, sN = STAGE, sW = 2 * STAGE, j = 0;
        ATT_SLOAD(0, 0); ATT_SLOAD(1, 64); asm volatile("s_waitcnt vmcnt(0)" ::: "memory"); ATT_SWRITE(0, 0); ATT_SWRITE(STAGE, 1);
        ATT_SLOAD(0, 128); __syncthreads();
        qkt(pA0, pA1, Kl, qr, r32, hi); half_a<VAR>(pA0, ps, pa0, pa1);
        while (j + 2 < NT) {
            ATT_ITER(pA0, pA1, pB0, pB1, 0, 1);
            ATT_ITER(pB0, pB1, pA0, pA1, 1, 0);
        }
        ATT_ITER(pA0, pA1, pB0, pB1, 0, 1);
        half_b<VAR>(pB1, ps, l_reg, pa2, pa3); SBAR();
        pv_d0<VAR>(o, vb0 + sC, pa0, pa1, pa2, pa3);
#undef ATT_ITER
#undef ATT_SLOAD
#undef ATT_SWRITE
        if (hi == 0) li_l[r32] = l_reg;
        __syncthreads();
        float rli[16];
#pragma unroll
        for (int r = 0; r < 16; ++r) rli[r] = __builtin_amdgcn_rcpf(li_l[crow(r, hi)]);
        LAS float* X = (LAS float*)lds;
        if (comp == 1) {
#pragma unroll
            for (int r = 0; r < 16; ++r) { const int row = wq * 32 + crow(r, hi); const float sc1 = rli[r] * lam;
#pragma unroll
                for (int d0 = 0; d0 < 4; ++d0) X[row * 128 + d0 * 32 + r32] = o[d0][r] * sc1; }
        }
        __syncthreads();
        if (comp == 0) {
            float ss[16];
#pragma unroll
            for (int r = 0; r < 16; ++r) { const int row = wq * 32 + crow(r, hi); float s = 0.f;
#pragma unroll
                for (int d0 = 0; d0 < 4; ++d0) { const float v = o[d0][r] * rli[r] - X[row * 128 + d0 * 32 + r32]; o[d0][r] = v; s += v * v; }
                ss[r] = s; }
#pragma unroll
            for (int r = 0; r < 16; ++r) {
#pragma unroll
                for (int m = 1; m < 32; m <<= 1) ss[r] += __shfl_xor(ss[r], m); }
            float g[4];
#pragma unroll
            for (int d0 = 0; d0 < 4; ++d0) g[d0] = subln[d0 * 32 + r32] * oscale;
#pragma unroll
            for (int r = 0; r < 16; ++r) { const float rinv = 1.f / sqrtf(ss[r] * (1.f / 128.f) + EPS);
                const int t = t0 + wq * 32 + crow(r, hi), row = t >= CTXL ? b * SEQ + (t - CTXL) : RL + b * CTXL + t;
                bf16* op = ON + (size_t)row * 1024 + h * 128 + r32;
#pragma unroll
                for (int d0 = 0; d0 < 4; ++d0) if (VAR == 0 || lam == 12345.f) op[d0 * 32] = (bf16)(cvt_pk_bf16(o[d0][r] * rinv * g[d0], 0.f) & 0xffffu); }
        }
        __syncthreads();
    }
}


namespace a16 {
__device__ __forceinline__ int off_a(int row, int ch) { return 2048 * (row >> 3) + 512 * (ch >> 2) + 64 * (row & 7) + 16 * ((ch & 3) ^ ((row >> 2) & 3)); }
__device__ __forceinline__ int fK(int key) { return ((key >> 1) & 1) | (((key >> 3) & 1) << 1) | (((key >> 4) & 1) << 2); }
__device__ __forceinline__ void qkt16(f32x4 (&S)[2][2][2], const LAS unsigned char* Kt, int kb0, int kb1, const bf16x8 (&qf)[2][2]) {
#pragma unroll
    for (int ks2 = 0; ks2 < 2; ++ks2) {
        if (ks2) SBAR();
#pragma unroll
        for (int u = 0; u < 2; ++u) {
            const bf16x8 k0 = *(const LAS bf16x8*)(Kt + kb0 + 4096 * ks2 + 512 * u), k1 = *(const LAS bf16x8*)(Kt + kb1 + 4096 * ks2 + 512 * u);
#pragma unroll
            for (int qb = 0; qb < 2; ++qb) { f32x4 acc = (f32x4){0.f, 0.f, 0.f, 0.f};
                acc = __builtin_amdgcn_mfma_f32_16x16x32_bf16(k0, qf[qb][0], acc, 0, 0, 0); S[ks2][u][qb] = __builtin_amdgcn_mfma_f32_16x16x32_bf16(k1, qf[qb][1], acc, 0, 0, 0); }
        }
    }
}
template <bool SUMS = true> __device__ __forceinline__ void half16(f32x4 (&Sh)[2][2], float (&ls)[2], bf16x8 (&pf)[2]) {
#pragma unroll
    for (int qb = 0; qb < 2; ++qb) {
#pragma unroll
        for (int u = 0; u < 2; ++u)
#pragma unroll
            for (int r = 0; r < 4; ++r) Sh[u][qb][r] = __builtin_amdgcn_exp2f(Sh[u][qb][r]);
        if (SUMS) ls[qb] += ((Sh[0][qb][0] + Sh[0][qb][1]) + (Sh[0][qb][2] + Sh[0][qb][3])) + ((Sh[1][qb][0] + Sh[1][qb][1]) + (Sh[1][qb][2] + Sh[1][qb][3]));
        v4u w; w.x = cvt_pk_bf16(Sh[0][qb][0], Sh[0][qb][1]); w.y = cvt_pk_bf16(Sh[0][qb][2], Sh[0][qb][3]); w.z = cvt_pk_bf16(Sh[1][qb][0], Sh[1][qb][1]); w.w = cvt_pk_bf16(Sh[1][qb][2], Sh[1][qb][3]);
        pf[qb] = *reinterpret_cast<bf16x8*>(&w); }
}
template <int CP, bool PVSYNC = false> __device__ __forceinline__ void pv16(f32x4 (&O)[8][2], int vb00, int vb01, int vb10, int vb11, const bf16x8 (&pf)[2][2]) {
#define tr_read16(OFF, vb) __builtin_amdgcn_ds_read_tr16_b64_v4i16((LAS s16x4*)((LAS unsigned char*)(uintptr_t)(unsigned)(vb) + (OFF)))
    const s16x4 a0 = tr_read16(512 * CP, vb00), a1 = tr_read16(512 * CP, vb01), a2 = tr_read16(8192 + 512 * CP, vb00), a3 = tr_read16(8192 + 512 * CP, vb01);
    const s16x4 b0 = tr_read16(512 * CP, vb10), b1 = tr_read16(512 * CP, vb11), b2 = tr_read16(8192 + 512 * CP, vb10), b3 = tr_read16(8192 + 512 * CP, vb11);
    if (PVSYNC) { asm volatile("s_waitcnt lgkmcnt(0)" ::: "memory"); SBAR(); }
#define A16_PK(L, H) (bf16x8){L[0], L[1], L[2], L[3], H[0], H[1], H[2], H[3]}
    const bf16x8 ve0 = A16_PK(a0, a1), ve1 = A16_PK(a2, a3), vo0 = A16_PK(b0, b1), vo1 = A16_PK(b2, b3);
#pragma unroll
    for (int qb = 0; qb < 2; ++qb) {
        O[2 * CP][qb] = __builtin_amdgcn_mfma_f32_16x16x32_bf16(ve0, pf[0][qb], O[2 * CP][qb], 0, 0, 0);
        O[2 * CP + 1][qb] = __builtin_amdgcn_mfma_f32_16x16x32_bf16(vo0, pf[0][qb], O[2 * CP + 1][qb], 0, 0, 0);
        O[2 * CP][qb] = __builtin_amdgcn_mfma_f32_16x16x32_bf16(ve1, pf[1][qb], O[2 * CP][qb], 0, 0, 0);
        O[2 * CP + 1][qb] = __builtin_amdgcn_mfma_f32_16x16x32_bf16(vo1, pf[1][qb], O[2 * CP + 1][qb], 0, 0, 0); }
#undef A16_PK
#undef tr_read16
}
}

__device__ __forceinline__ void attn16(const Frame& F, const bf16* Q, const bf16* Kb, const bf16* Vb, bf16* ON, const float* subln, const float* lamv, bool with_ctx, unsigned long long* stamp = nullptr) {
    using namespace att; using namespace a16;
    LAS unsigned char* lds = F.lds;
    const int tid = F.tid, wid = F.wave, lane = F.lane, l15 = lane & 15, g = lane >> 4, comp = wid >> 2, wq = wid & 3;
    const int vrl = 8 * (tid >> 7) + ((tid >> 2) & 7);
    const unsigned ksrc = (unsigned)((tid >> 3) * 128 + (((tid & 7) ^ fK(tid >> 3)) << 4));
    const unsigned vsrc = (unsigned)(vrl * 256 + (((((tid >> 5) & 3) << 2) | ((tid & 3) ^ ((vrl >> 2) & 3))) << 4));
    const unsigned ldsw = (unsigned)__builtin_amdgcn_readfirstlane(wid) * 1024u;
    const int ki = 8 * (l15 >> 2) + (l15 & 3), kf = fK(ki);
    const int kb0 = ki * 128 + (((0 + g) ^ kf) << 4), kb1 = ki * 128 + (((4 + g) ^ kf) << 4);
    const int tq = l15 >> 2, tp = lane & 3;
    const int vr0 = (int)(uintptr_t)(lds + ST_V);
    int v00 = vr0 + off_a(8 * g + tq, 0 + (tp >> 1)) + 8 * (tp & 1), v01 = vr0 + off_a(8 * g + 4 + tq, 0 + (tp >> 1)) + 8 * (tp & 1);
    int v10 = vr0 + off_a(8 * g + tq, 2 + (tp >> 1)) + 8 * (tp & 1), v11 = vr0 + off_a(8 * g + 4 + tq, 2 + (tp >> 1)) + 8 * (tp & 1);
    const LAS unsigned char* Kl = lds + comp * ST_K1;
    const float lam = __builtin_bit_cast(float, __builtin_amdgcn_readfirstlane(__builtin_bit_cast(int, lamv[0]))), oscale = __builtin_bit_cast(float, __builtin_amdgcn_readfirstlane(__builtin_bit_cast(int, lamv[1])));
    const int n_lat = NB * NH * (SEQ / 128), n_ctx = with_ctx ? NB * NH * (CTXL / 128) : 0;
#ifdef PROBE_STAMP
    unsigned long long st_t0 = 0, st_r0 = 0, st_it = 0;
    if (stamp) { st_t0 = __builtin_amdgcn_s_memtime(); st_r0 = __builtin_amdgcn_s_memrealtime(); }
#endif
    bf16x8 ones; { const short o1 = 0x3F80; ones = (bf16x8){o1, o1, o1, o1, o1, o1, o1, o1}; asm volatile("" : "+v"(ones)); }
    const int n_units = n_lat + n_ctx;
    int unit = F.vcu;
    if (unit >= n_units) return;
    int b, h, t0, NT; const char *K0u, *K1u, *V0u, *V1u; bf16x8 qf[2][2];
#define A16_DECODE(U) do { if ((U) < n_lat) { const int bh = (U) >> 5; b = bh >> 3; h = bh & 7; t0 = CTXL + ((U) & 31) * 128; NT = TK / 64; } \
        else { const int uu = (U) - n_lat, bh = uu >> 1; b = bh >> 3; h = bh & 7; t0 = (uu & 1) * 128; NT = CTXL / 64; } \
        K0u = (const char*)(Kb + (size_t)((b * NH + h) * 2) * TK * 64); K1u = K0u + (size_t)TK * 128; V0u = (const char*)(Vb + (size_t)(b * NH + h) * TK * 128); V1u = V0u + 32 * 256; } while (0)
#define A16_DMA1(gp, voff, ldsa) asm volatile("s_mov_b32 m0, %2\n\ts_nop 0\n\tglobal_load_lds_dwordx4 %0, %1" :: "v"(voff), "s"(gp), "s"(ldsa) : "memory", "m0")
#define A16_DMA(so, k0) do { const unsigned la_ = (unsigned)(uintptr_t)(lds + (so)) + ldsw; \
        A16_DMA1(K0u + (size_t)(k0) * 128, ksrc, la_); A16_DMA1(K1u + (size_t)(k0) * 128, ksrc, la_ + ST_K1); \
        A16_DMA1(V0u + (size_t)(k0) * 256, vsrc, la_ + ST_V); A16_DMA1(V1u + (size_t)(k0) * 256, vsrc, la_ + ST_V + 8192); } while (0)
#define A16_REQUEST() do { A16_DMA(0, 0); A16_DMA(STAGE, 64); \
        const bf16* Qw = Q + ((size_t)((b * NH + h) * 2 + comp) * TK + t0 + wq * 32 + l15) * 64 + 8 * g; \
        _Pragma("unroll") for (int qb = 0; qb < 2; ++qb) _Pragma("unroll") for (int sdim = 0; sdim < 2; ++sdim) qf[qb][sdim] = *(const bf16x8*)(Qw + (size_t)qb * 16 * 64 + 32 * sdim); } while (0)
    A16_DECODE(unit); A16_REQUEST();
    for (;;) {
#ifdef PROBE_STAMP
        st_it += NT;
#endif
        f32x4 O[8][2];
#pragma unroll
        for (int c = 0; c < 8; ++c) { O[c][0] = (f32x4){0.f, 0.f, 0.f, 0.f}; O[c][1] = (f32x4){0.f, 0.f, 0.f, 0.f}; }
        float ls[2] = {0.f, 0.f};
        f32x4 LS[2] = {(f32x4){0.f, 0.f, 0.f, 0.f}, (f32x4){0.f, 0.f, 0.f, 0.f}};
#define A16_LSUM() do { _Pragma("unroll") for (int qb_ = 0; qb_ < 2; ++qb_) { LS[qb_] = __builtin_amdgcn_mfma_f32_16x16x32_bf16(ones, pf[0][qb_], LS[qb_], 0, 0, 0); LS[qb_] = __builtin_amdgcn_mfma_f32_16x16x32_bf16(ones, pf[1][qb_], LS[qb_], 0, 0, 0); } } while (0)
        f32x4 SA[2][2][2], SB[2][2][2]; bf16x8 pf[2][2], pf2[2];
#define A16_ITER(SC, SNX) do { \
        if (j + 2 < NT) A16_DMA(sW, (j + 2) * 64); \
        SBAR(); qkt16(SNX, Kl + sN, kb0, kb1, qf); half16<false>(SC[1], ls, pf[1]); SBAR(); \
        asm volatile("" : "+v"(SNX[0][0][0]), "+v"(SNX[0][0][1]), "+v"(SNX[0][1][0]), "+v"(SNX[0][1][1]));     \
        pv16<0>(O, v00, v01, v10, v11, pf); pv16<1>(O, v00, v01, v10, v11, pf); A16_LSUM(); \
        pv16<2>(O, v00, v01, v10, v11, pf); pv16<3>(O, v00, v01, v10, v11, pf); \
        half16<false>(SNX[0], ls, pf2); pf[0][0] = pf2[0]; pf[0][1] = pf2[1]; \
        asm volatile("s_waitcnt vmcnt(0)" ::: "memory"); \
        __syncthreads(); { const int d_ = sN - sC; v00 += d_; v01 += d_; v10 += d_; v11 += d_; const int t_ = sC; sC = sN; sN = sW; sW = t_; } ++j; } while (0)
        int sC = 0, sN = STAGE, sW = 2 * STAGE, j = 0;
        asm volatile("s_waitcnt vmcnt(0)" ::: "memory"); __syncthreads();
        qkt16(SA, Kl, kb0, kb1, qf); half16<false>(SA[0], ls, pf[0]);
        while (j + 2 < NT) { A16_ITER(SA, SB); A16_ITER(SB, SA); }
        A16_ITER(SA, SB);
        half16<false>(SB[1], ls, pf[1]); SBAR();
        pv16<0>(O, v00, v01, v10, v11, pf); pv16<1>(O, v00, v01, v10, v11, pf); A16_LSUM();
        pv16<2>(O, v00, v01, v10, v11, pf); pv16<3>(O, v00, v01, v10, v11, pf);
        v00 -= sC; v01 -= sC; v10 -= sC; v11 -= sC;
#undef A16_ITER
#undef A16_LSUM
#pragma unroll
        for (int qb = 0; qb < 2; ++qb) ls[qb] = LS[qb][0];
        const int eb = b, eh = h, et0 = t0;
        const int nunit = unit + F.G; const bool has_next = nunit < n_units;
        __syncthreads();
        if (has_next) { A16_DECODE(nunit); A16_REQUEST(); }
        LAS float* XE = (LAS float*)(lds + 65536); LAS float* SQ = (LAS float*)(lds + MOETAB_OFF);
        const float scl = comp == 0 ? __builtin_amdgcn_rcpf(ls[0]) : lam * __builtin_amdgcn_rcpf(ls[0]), sch = comp == 0 ? __builtin_amdgcn_rcpf(ls[1]) : lam * __builtin_amdgcn_rcpf(ls[1]);
#pragma unroll
        for (int c = 0; c < 8; ++c) { O[c][0] *= scl; O[c][1] *= sch; }
#pragma unroll
        for (int qb = 0; qb < 2; ++qb) { LAS float* xw = XE + comp * 8192 + (wq * 32 + qb * 16 + l15) * 64;
#pragma unroll
            for (int cc = 0; cc < 4; ++cc) *(LAS f32x4*)(xw + (((4 * cc + g) ^ l15) << 2)) = O[comp == 0 ? 4 + cc : cc][qb]; }
        __syncthreads();
        float sqp[2];
#pragma unroll
        for (int qb = 0; qb < 2; ++qb) { const LAS float* xr = XE + (comp ^ 1) * 8192 + (wq * 32 + qb * 16 + l15) * 64; float sq = 0.f;
#pragma unroll
            for (int cc = 0; cc < 4; ++cc) { const f32x4 x = *(const LAS f32x4*)(xr + (((4 * cc + g) ^ l15) << 2)); const int c = comp == 0 ? cc : 4 + cc;
                const f32x4 v = comp == 0 ? O[c][qb] - x : x - O[c][qb]; O[c][qb] = v; sq += (v[0] * v[0] + v[1] * v[1]) + (v[2] * v[2] + v[3] * v[3]); }
            sq += __shfl_xor(sq, 16); sq += __shfl_xor(sq, 32); sqp[qb] = sq;
            if (g == 0) SQ[comp * 128 + wq * 32 + qb * 16 + l15] = sq; }
        __syncthreads();
#pragma unroll
        for (int qb = 0; qb < 2; ++qb) { const int rl = wq * 32 + qb * 16 + l15; const float sq = SQ[rl] + SQ[128 + rl];
            const float rinv = 1.f / sqrtf(sq * (1.f / 128.f) + EPS) * oscale;
            const int t = et0 + rl, row = t >= CTXL ? eb * SEQ + (t - CTXL) : RL + eb * CTXL + t;
            bf16* op = ON + (size_t)row * 1024 + eh * 128 + 64 * comp + 8 * g;
#pragma unroll
            for (int pp = 0; pp < 2; ++pp) { const int c = (comp == 0 ? 0 : 4) + 2 * pp; const float* gp = subln + 64 * comp + 32 * pp + 8 * g;
                const f32x4 y0 = O[c][qb] * rinv * *(const f32x4*)gp, y1 = O[c + 1][qb] * rinv * *(const f32x4*)(gp + 4);
                *(v4u*)(op + 32 * pp) = pack8(y0, y1); } }
        if (!has_next) break;
        unit = nunit;
    }
    __syncthreads();
#undef A16_DECODE
#undef A16_REQUEST
#undef A16_DMA
#undef A16_DMA1
#ifdef PROBE_STAMP
    if (stamp) { const unsigned long long t1 = __builtin_amdgcn_s_memtime(), r1 = __builtin_amdgcn_s_memrealtime(); if (tid == 0) { stamp[0] = t1 - st_t0; stamp[1] = r1 - st_r0; stamp[2] = st_it; } }
#endif
}

__device__ __forceinline__ void cvt_item(const float* s0, const float* s1, int srcN, int mode, int K, int N, bf16* dst, int item, LAS float* scr, int lane) {
    const int nblk = N / 64, kb = item / nblk, nb = item % nblk, k0 = 64 * kb, n0 = 64 * nb;
    const int v = n0 + lane; const float* sp = s0; int c = v;
    const int m1_tile = nb >> 2, m1_wc = nb & 3;
    if (mode == 1) { const int kind = (lane >> 2) & 1; sp = kind ? s1 : s0; c = m1_tile * 128 + m1_wc * 32 + ((lane >> 3) & 3) * 8 + (lane >> 5) * 4 + (lane & 3); }
    const bool glu = mode == 2 && n0 >= 3072 && n0 < 5120;
    if (glu) { const int kind = (lane >> 2) & 1; c = 3072 + kind * 1024 + (m1_tile - 12) * 128 + m1_wc * 32 + ((lane >> 3) & 3) * 8 + (lane >> 5) * 4 + (lane & 3); }
    else if (mode == 2) { if (v < 2048) c = qk_src_col(v);
        else if (v < 3072) { const int q = v & 127, cb_ = q >> 4, i = q & 15; c = (v & ~127) + 32 * (cb_ >> 1) + 8 * (i >> 2) + 4 * (cb_ & 1) + (i & 3); } }
    sp += (size_t)k0 * srcN + c;
#pragma unroll 16
    for (int kk = 0; kk < 64; ++kk) scr[kk * 64 + (lane ^ (((kk >> 3) & 7) << 2))] = sp[(size_t)kk * srcN];
    LDS_WAIT(); asm volatile("" ::: "memory");
    const int c8 = lane & 7, sw = c8 << 2;
#pragma unroll
    for (int j = 0; j < 8; ++j) { const int n = (lane >> 3) + 8 * j; const LAS float* q = scr + (8 * c8) * 64 + (n ^ sw);
        v4u o; o.x = cvt_pk_bf16(q[0 * 64], q[1 * 64]); o.y = cvt_pk_bf16(q[2 * 64], q[3 * 64]); o.z = cvt_pk_bf16(q[4 * 64], q[5 * 64]); o.w = cvt_pk_bf16(q[6 * 64], q[7 * 64]);
        const int vrow = (mode == 1 || glu) ? m1_tile * 256 + (n >> 5) * 128 + m1_wc * 32 + (n & 31) : n0 + n;
        *(v4u*)(dst + (size_t)vrow * K + k0 + 8 * c8) = o; }
    LDS_WAIT(); asm volatile("" ::: "memory");
}

__device__ __forceinline__ void phase_prologue(const Frame& F, const Args& a) {
    unsigned char* ws = a.ws;
    {
        LAS float* sv = (LAS float*)F.lds; LAS float* part = sv + 5 * 1024;
        for (int idx = F.tid; idx < 5 * 1024; idx += 512) { const int v = idx >> 10, k = idx & 1023; const float x = v < 4 ? a.in[I_C][v * 1024 + k] : a.in[I_CCTX][k]; sv[idx] = x * sigm(x); }
        __syncthreads();
        float* MOD = (float*)(ws + WS_MOD);
        for (int unit = F.vcu; unit < 192; unit += F.G) {
            const int l = unit / 96, n0 = (unit % 96) * 64; const float* W = a.in[I_WMOD] + (size_t)l * 1024 * 6144 + n0 + F.lane;
            float acc[5] = {0, 0, 0, 0, 0};
#pragma unroll 16
            for (int k = F.wave * 128; k < F.wave * 128 + 128; ++k) { const float wv = W[(size_t)k * 6144];
#pragma unroll
                for (int v = 0; v < 5; ++v) acc[v] += sv[v * 1024 + k] * wv; }
#pragma unroll
            for (int v = 0; v < 5; ++v) part[(F.wave * 5 + v) * 64 + F.lane] = acc[v];
            __syncthreads();
            if (F.tid < 320) { const int v = F.tid >> 6, ln = F.tid & 63; float s = a.in[I_BMOD][l * 6144 + n0 + ln];
#pragma unroll
                for (int w = 0; w < 8; ++w) s += part[(w * 5 + v) * 64 + ln];
                MOD[(size_t)(l * 5 + v) * 6144 + n0 + ln] = s; }
            __syncthreads();
        }
    }
    if (F.vcu == F.G - 1) {
        float* ROPE = (float*)(ws + WS_ROPE); float* LAMV = (float*)(ws + WS_LAM);
        for (int idx = F.tid; idx < 1024; idx += 512) { const int pos = idx >> 4, i = idx & 15; const float inv = __builtin_amdgcn_exp2f(-(float)(2 * i) * (13.287712379549449f / 32.f)), ang = (float)pos * inv; const float kq = rintf(ang * 0.15915494309189535f); float rr = fmaf(-kq, 6.2831854820251465f, ang); rr = fmaf(-kq, -1.7484555e-7f, rr); ROPE[idx] = __cosf(rr); ROPE[1024 + idx] = __sinf(rr); }
        if (F.tid < 2) { const int l = F.tid; float s1 = 0.f, s2 = 0.f;
            for (int d = 0; d < 64; ++d) { s1 += a.in[I_LQ1][l * 64 + d] * a.in[I_LK1][l * 64 + d]; s2 += a.in[I_LQ2][l * 64 + d] * a.in[I_LK2][l * 64 + d]; }
            const float lam_init = l == 0 ? 0.2f : 0.35550906759f; LAMV[l * 2 + 0] = __expf(s1) - __expf(s2) + lam_init; LAMV[l * 2 + 1] = 1.f - lam_init; }
    }
    {
        LAS float* scr = (LAS float*)(F.lds + F.wave * 16384);
        const int gw = F.vcu * 8 + F.wave, NGW = F.G * 8;
        constexpr int I_IN = 16 * 112, I_SQ = 16 * 16, I_GU0 = 16 * 88, I_D0 = 44 * 16, I_EGU = 16 * 112, I_ED = 56 * 16;
        constexpr int NITEMS = 2 * I_IN + 6 * I_SQ + I_GU0 + I_D0 + 8 * I_EGU + 8 * I_ED;
        for (int it = gw; it < NITEMS; it += NGW) {
            int r = it;
            if (r < 2 * I_IN) { const int l = r / I_IN; cvt_item(a.in[I_WIN] + (size_t)l * 1024 * INW, nullptr, INW, 2, 1024, INW, (bf16*)(ws + WS_WIN) + (size_t)l * INW * 1024, r % I_IN, scr, F.lane); continue; } r -= 2 * I_IN;
            if (r < 6 * I_SQ) { const int m = r / I_SQ, l = m / 3, w = m % 3; const float* src = a.in[w == 0 ? I_WATTNO : (w == 1 ? I_WCONVO : I_WOUT)] + (size_t)l * 1024 * 1024;
                bf16* dst = (bf16*)(ws + (w == 0 ? WS_WA : (w == 1 ? WS_WC : WS_WO)) + (size_t)l * 6 * MiB); cvt_item(src, nullptr, 1024, 0, 1024, 1024, dst, r % I_SQ, scr, F.lane); continue; } r -= 6 * I_SQ;
            if (r < I_GU0) { cvt_item(a.in[I_WFFG], a.in[I_WFFU], DFF, 1, 1024, 2 * DFF, (bf16*)(ws + WS_WGU0), r, scr, F.lane); continue; } r -= I_GU0;
            if (r < I_D0) { cvt_item(a.in[I_WFFD], nullptr, 1024, 0, DFF, 1024, (bf16*)(ws + WS_WD0), r, scr, F.lane); continue; } r -= I_D0;
            if (r < 8 * I_EGU) { const int e = r / I_EGU; cvt_item(a.in[I_WEG] + (size_t)e * 1024 * DFE, a.in[I_WEU] + (size_t)e * 1024 * DFE, DFE, 1, 1024, 2 * DFE, (bf16*)(ws + WS_WEGU) + (size_t)e * 2 * DFE * 1024, r % I_EGU, scr, F.lane); continue; } r -= 8 * I_EGU;
            { const int e = r / I_ED; cvt_item(a.in[I_WED] + (size_t)e * DFE * 1024, nullptr, 1024, 0, DFE, 1024, (bf16*)(ws + WS_WED) + (size_t)e * 1024 * DFE, r % I_ED, scr, F.lane); }
        }
    }
}

template <bool SB> __device__ __forceinline__ void phase_rmsmod(const Frame& F, const void* src_lat_, const void* src_ctx_, int nrows, const float* g, const float* modl, int shift_idx, bf16* H) {
    const int gw = F.vcu * 8 + F.wave, NGW = F.G * 8;
    for (int row = gw; row < nrows; row += 2 * NGW) {
        const int row2 = row + NGW; const bool has2 = row2 < nrows;
        f32x4 va[4], vb[4]; float sa = 0.f, sb = 0.f;
        if constexpr (SB) { const bf16* src_lat = (const bf16*)src_lat_; const bf16* src_ctx = (const bf16*)src_ctx_;
            const bf16* srcA = row < RL ? src_lat + (size_t)row * 1024 : src_ctx + (size_t)(row - RL) * 1024;
            const bf16* srcB = has2 ? (row2 < RL ? src_lat + (size_t)row2 * 1024 : src_ctx + (size_t)(row2 - RL) * 1024) : srcA;
#pragma unroll
            for (int j = 0; j < 4; ++j) { const v2u xa = *(const v2u*)(srcA + 4 * (F.lane + 64 * j)), xb = *(const v2u*)(srcB + 4 * (F.lane + 64 * j));
                va[j] = (f32x4){bflo(xa.x), bfhi(xa.x), bflo(xa.y), bfhi(xa.y)}; vb[j] = (f32x4){bflo(xb.x), bfhi(xb.x), bflo(xb.y), bfhi(xb.y)}; } }
        else { const float* src_lat = (const float*)src_lat_; const float* src_ctx = (const float*)src_ctx_;
            const float* srcA = row < RL ? src_lat + (size_t)row * 1024 : src_ctx + (size_t)(row - RL) * 1024;
            const float* srcB = has2 ? (row2 < RL ? src_lat + (size_t)row2 * 1024 : src_ctx + (size_t)(row2 - RL) * 1024) : srcA;
#pragma unroll
            for (int j = 0; j < 4; ++j) { va[j] = *(const f32x4*)(srcA + 4 * (F.lane + 64 * j)); vb[j] = *(const f32x4*)(srcB + 4 * (F.lane + 64 * j)); } }
#pragma unroll
        for (int j = 0; j < 4; ++j) { sa += (va[j][0] * va[j][0] + va[j][1] * va[j][1]) + (va[j][2] * va[j][2] + va[j][3] * va[j][3]); sb += (vb[j][0] * vb[j][0] + vb[j][1] * vb[j][1]) + (vb[j][2] * vb[j][2] + vb[j][3] * vb[j][3]); }
        const float ra = 1.f / sqrtf(wave_sum(sa) * (1.f / 1024.f) + EPS), rb = 1.f / sqrtf(wave_sum(sb) * (1.f / 1024.f) + EPS);
        const float* shA = modl + row_mi(row) * 6144 + shift_idx * 1024; const float* shB = modl + row_mi(has2 ? row2 : row) * 6144 + shift_idx * 1024;
#pragma unroll
        for (int j = 0; j < 4; ++j) { const int col = 4 * (F.lane + 64 * j); const f32x4 gg = *(const f32x4*)(g + col);
            { const f32x4 s4 = *(const f32x4*)(shA + 1024 + col), h4 = *(const f32x4*)(shA + col); const f32x4 y = va[j] * ra * gg * (1.f + s4) + h4;
              v2u w; w.x = cvt_pk_bf16(y[0], y[1]); w.y = cvt_pk_bf16(y[2], y[3]); *(v2u*)(H + (size_t)row * 1024 + col) = w; }
            if (has2) { const f32x4 s4 = *(const f32x4*)(shB + 1024 + col), h4 = *(const f32x4*)(shB + col); const f32x4 y = vb[j] * rb * gg * (1.f + s4) + h4;
              v2u w; w.x = cvt_pk_bf16(y[0], y[1]); w.y = cvt_pk_bf16(y[2], y[3]); *(v2u*)(H + (size_t)row2 * 1024 + col) = w; } }
    }
}

__device__ __forceinline__ void phase_qknorm(const Frame& F, bf16* Q, bf16* Kb, const float* qg, const float* kg, const float* rope, int mode) {
    constexpr int HALFV = NB * NH * 2 * TK;
    const int total = mode ? NB * NH * 2 * CTXL : 2 * HALFV;
    const int j8 = F.tid & 7;
    for (int vec = (F.vcu * 512 + F.tid) >> 3; vec < total; vec += F.G * 64) {
        const bool isK = mode ? true : (vec >= HALFV); const int vv = mode ? (vec >> 8) * TK + (vec & 255) : (isK ? vec - HALFV : vec), t = vv % TK;
        bf16* p = (isK ? Kb : Q) + (size_t)vv * 64 + j8 * 8;
        f32x4 x0, x1; unpack8(*(const v4u*)p, x0, x1);
        float ss = (x0[0] * x0[0] + x0[1] * x0[1]) + (x0[2] * x0[2] + x0[3] * x0[3]) + (x1[0] * x1[0] + x1[1] * x1[1]) + (x1[2] * x1[2] + x1[3] * x1[3]);
        ss += __shfl_xor(ss, 1); ss += __shfl_xor(ss, 2); ss += __shfl_xor(ss, 4);
        const float rinv = 1.f / sqrtf(ss * (1.f / 64.f) + EPS);
        const float* gp = (isK ? kg : qg) + 32 * (j8 >> 2) + 4 * (j8 & 3); const f32x4 g0 = *(const f32x4*)gp, g1 = *(const f32x4*)(gp + 16);
        f32x4 y0 = x0 * rinv * g0, y1 = x1 * rinv * g1;
        f32x4 p0, p1;
#pragma unroll
        for (int e = 0; e < 4; ++e) { p0[e] = __shfl_xor(y0[e], 2); p1[e] = __shfl_xor(y1[e], 2); }
        if (t >= CTXL) {
            const int s = t - CTXL, pos = (j8 >> 2) ? (s & 63) : (s >> 6), i0 = (j8 & 1) * 8; const float sgn = ((j8 >> 1) & 1) ? 1.f : -1.f;
            const float* cp = rope + pos * 16 + i0; const float* sp = cp + 1024;
            const f32x4 c0 = *(const f32x4*)cp, c1 = *(const f32x4*)(cp + 4), s0 = *(const f32x4*)sp, s1 = *(const f32x4*)(sp + 4);
            y0 = y0 * c0 + p0 * s0 * sgn; y1 = y1 * c1 + p1 * s1 * sgn;
        }
        if (!isK) { y0 = y0 * QSCALE; y1 = y1 * QSCALE; }
        *(v4u*)p = pack8(y0, y1);
    }
}

__device__ __forceinline__ void phase_conv(const Frame& F, const bf16* U0, bf16* U1, const float* dww, const float* dwb, const float* lng, const float* lnb, int nrows) {
    constexpr int RPU = 8, NIN = RPU + CK - 1;
    LAS float* red = (LAS float*)F.lds;
    const int half = F.tid >> 8, t8 = F.tid & 255, ch = 4 * t8, wv = F.wave & 3;
    const f32x4 bias = *(const f32x4*)(dwb + ch), g4 = *(const f32x4*)(lng + ch), b4 = *(const f32x4*)(lnb + ch);
    const int nunits = nrows / RPU;
    for (int u0 = F.vcu * 2; u0 < nunits; u0 += F.G * 2) {
        asm volatile("" ::: "memory");
        const int r0 = (u0 + half) * RPU;
        int seg_lo, seg_hi; if (r0 < RL) { seg_lo = r0 & ~4095; seg_hi = seg_lo + 4096; } else { seg_lo = RL + ((r0 - RL) & ~255); seg_hi = seg_lo + 256; }
        v2u xp[NIN];
#pragma unroll
        for (int i = 0; i < NIN; ++i) { const int rr = r0 - 15 + i; xp[i] = (rr >= seg_lo && rr < seg_hi) ? *(const v2u*)(U0 + (size_t)rr * 1024 + ch) : (v2u){0u, 0u}; }
        f32x4 acc[RPU];
#pragma unroll
        for (int r = 0; r < RPU; ++r) acc[r] = bias;
#pragma unroll
        for (int j = 0; j < CK; ++j) { const f32x4 wj = *(const f32x4*)(dww + j * 1024 + ch);
#pragma unroll
            for (int r = 0; r < RPU; ++r) { const v2u x = xp[r + j]; acc[r] += wj * (f32x4){bflo(x.x), bfhi(x.x), bflo(x.y), bfhi(x.y)}; } }
        float sv[RPU];
#pragma unroll
        for (int r = 0; r < RPU; ++r) sv[r] = wave_sum((acc[r][0] + acc[r][1]) + (acc[r][2] + acc[r][3]));
        __syncthreads();
        if (F.lane < RPU) { float v = sv[0];
#pragma unroll
            for (int r = 1; r < RPU; ++r) v = (F.lane == r) ? sv[r] : v;
            red[(half * 4 + wv) * RPU + F.lane] = v; }
        __syncthreads();
        float mean[RPU];
#pragma unroll
        for (int r = 0; r < RPU; ++r) mean[r] = ((red[(half * 4 + 0) * RPU + r] + red[(half * 4 + 1) * RPU + r]) + (red[(half * 4 + 2) * RPU + r] + red[(half * 4 + 3) * RPU + r])) * (1.f / 1024.f);
#pragma unroll
        for (int r = 0; r < RPU; ++r) { acc[r] = acc[r] - mean[r]; sv[r] = wave_sum((acc[r][0] * acc[r][0] + acc[r][1] * acc[r][1]) + (acc[r][2] * acc[r][2] + acc[r][3] * acc[r][3])); }
        if (F.lane < RPU) { float v = sv[0];
#pragma unroll
            for (int r = 1; r < RPU; ++r) v = (F.lane == r) ? sv[r] : v;
            red[128 + (half * 4 + wv) * RPU + F.lane] = v; }
        __syncthreads();
#pragma unroll
        for (int r = 0; r < RPU; ++r) { const float q = (red[128 + (half * 4 + 0) * RPU + r] + red[128 + (half * 4 + 1) * RPU + r]) + (red[128 + (half * 4 + 2) * RPU + r] + red[128 + (half * 4 + 3) * RPU + r]);
            const float rstd = 1.f / sqrtf(q * (1.f / 1024.f) + EPS);
            const f32x4 y = acc[r] * rstd * g4 + b4; v2u w; w.x = cvt_pk_bf16(y[0] * sigf(y[0]), y[1] * sigf(y[1])); w.y = cvt_pk_bf16(y[2] * sigf(y[2]), y[3] * sigf(y[3]));
            *(v2u*)(U1 + (size_t)(r0 + r) * 1024 + ch) = w; }
    }
    __syncthreads();
}

__device__ __forceinline__ void phase_router(const Frame& F, const float* x1, const float* g, const float* modl, const float* wr, bf16* H2, unsigned* BC, unsigned* TOK) {
    const int TPB = (RL + F.G - 1) / F.G, tbase = F.vcu * TPB;
    LAS int* le = (LAS int*)F.lds;
    f32x4 wa[4][4], wb[4][4];
#pragma unroll
    for (int j = 0; j < 4; ++j)
#pragma unroll
        for (int e4 = 0; e4 < 4; ++e4) { const float* wp = wr + (size_t)(4 * (F.lane + 64 * j) + e4) * 8; wa[j][e4] = *(const f32x4*)wp; wb[j][e4] = *(const f32x4*)(wp + 4); }
    for (int tl0 = F.wave; tl0 < TPB; tl0 += 16) {
        f32x4 v[2][4]; int rows[2]; bool ok[2];
#pragma unroll
        for (int u = 0; u < 2; ++u) { const int tl = tl0 + 8 * u; rows[u] = tbase + tl; ok[u] = tl < TPB && rows[u] < RL;
            if (ok[u]) {
#pragma unroll
                for (int j = 0; j < 4; ++j) v[u][j] = *(const f32x4*)(x1 + (size_t)rows[u] * 1024 + 4 * (F.lane + 64 * j)); }
            else {
#pragma unroll
                for (int j = 0; j < 4; ++j) v[u][j] = (f32x4){0.f, 0.f, 0.f, 0.f}; } }
#pragma unroll
        for (int u = 0; u < 2; ++u) {
            const int tl = tl0 + 8 * u, row = rows[u];
            if (tl >= TPB) continue;
            if (!ok[u]) { if (F.lane == 0) { le[tl * 2] = -1; le[tl * 2 + 1] = -1; } continue; }
            float ss = 0.f;
#pragma unroll
            for (int j = 0; j < 4; ++j) ss += (v[u][j][0] * v[u][j][0] + v[u][j][1] * v[u][j][1]) + (v[u][j][2] * v[u][j][2] + v[u][j][3] * v[u][j][3]);
            const float rinv = 1.f / sqrtf(wave_sum(ss) * (1.f / 1024.f) + EPS);
            const float* sh = modl + (row >> 12) * 6144 + 3 * 1024; const float* sc = sh + 1024;
            float lg[8] = {0, 0, 0, 0, 0, 0, 0, 0};
#pragma unroll
            for (int j = 0; j < 4; ++j) { const int col = 4 * (F.lane + 64 * j); const f32x4 gg = *(const f32x4*)(g + col), s4 = *(const f32x4*)(sc + col), h4 = *(const f32x4*)(sh + col);
                const f32x4 y = v[u][j] * rinv * gg * (1.f + s4) + h4; v2u w; w.x = cvt_pk_bf16(y[0], y[1]); w.y = cvt_pk_bf16(y[2], y[3]); *(v2u*)(H2 + (size_t)row * 1024 + col) = w;
#pragma unroll
                for (int e4 = 0; e4 < 4; ++e4)
#pragma unroll
                    for (int e = 0; e < 4; ++e) { lg[e] += y[e4] * wa[j][e4][e]; lg[4 + e] += y[e4] * wb[j][e4][e]; } }
#pragma unroll
            for (int e = 0; e < 8; ++e) lg[e] = wave_sum(lg[e]);
            if (F.lane == 0) {
                int e0 = 0; float v0 = lg[0];
#pragma unroll
                for (int e = 1; e < 8; ++e) if (lg[e] > v0) { v0 = lg[e]; e0 = e; }
                int e1 = e0 == 0 ? 1 : 0; float v1 = lg[e1];
#pragma unroll
                for (int e = 0; e < 8; ++e) if (e != e0 && lg[e] > v1) { v1 = lg[e]; e1 = e; }
                const float w0 = 1.f / (1.f + __expf(v1 - v0)), w1 = 1.f - w0;
                unsigned* tk = TOK + (size_t)row * 8; tk[0] = (unsigned)e0; tk[1] = (unsigned)e1; tk[4] = __float_as_uint(w0); tk[5] = __float_as_uint(w1);
                le[tl * 2] = e0; le[tl * 2 + 1] = e1;
            }
        }
    }
    __syncthreads();
    { const int e = F.wave; unsigned c = 0;
      for (int t0 = 0; t0 < TPB; t0 += 64) { const int tl = t0 + F.lane; const bool m = tl < TPB && (le[tl * 2] == e || le[tl * 2 + 1] == e); c += (unsigned)__popcll(__ballot(m)); }
      if (F.lane == 0) BC[F.vcu * 8 + e] = c; }
    __syncthreads();
}
__device__ __forceinline__ void phase_moe_lists(const Frame& F, const unsigned* BC, unsigned* cnt, unsigned* TOK, int* slist) {
    const int TPB = (RL + F.G - 1) / F.G, tbase = F.vcu * TPB;
    LAS int* le = (LAS int*)F.lds; LAS unsigned* tot = (LAS unsigned*)(F.lds + 4096); LAS unsigned* pre = tot + 8;
    for (int i = F.tid; i < TPB * 2; i += 512) { const int row = tbase + (i >> 1); le[i] = row < RL ? (int)TOK[(size_t)row * 8 + (i & 1)] : -1; }
    LAS unsigned* bcl = pre + 8;
    for (int i = F.tid; i < F.G * 8; i += 512) bcl[i] = BC[i];
    __syncthreads();
    const int e = F.wave;
    { unsigned t = 0, p = 0; for (int b = F.lane; b < F.G; b += 64) { const unsigned c = bcl[b * 8 + e]; t += c; p += (b < F.vcu) ? c : 0u; }
#pragma unroll
      for (int o = 32; o > 0; o >>= 1) { t += (unsigned)__shfl_xor((int)t, o); p += (unsigned)__shfl_xor((int)p, o); }
      if (F.lane == 0) { tot[e] = t; pre[e] = p; } }
    __syncthreads();
    unsigned run = pre[e]; for (int x = 0; x < e; ++x) run += tot[x];
    if (F.vcu == 0 && F.lane == 0) cnt[64 * e] = tot[e];
    for (int t0 = 0; t0 < TPB; t0 += 64) { const int tl = t0 + F.lane; bool m0 = false, m1 = false; if (tl < TPB) { m0 = le[tl * 2] == e; m1 = le[tl * 2 + 1] == e; }
        const unsigned long long bal = __ballot(m0 || m1); const unsigned pos = run + (unsigned)__popcll(bal & ((1ull << F.lane) - 1ull)); const int row = tbase + tl;
        if (m0) { TOK[(size_t)row * 8 + 6] = pos; slist[pos] = row; } else if (m1) { TOK[(size_t)row * 8 + 7] = pos; slist[pos] = row; }
        run += (unsigned)__popcll(bal); }
    __syncthreads();
}
__device__ __forceinline__ int moe_build_table(const Frame& F, const unsigned* cnt, LAS int* tab) {
    LAS int* scan = tab + 4 * 160; LAS int* offl = scan + 132;
    if (F.tid < 64) {
        const int c = F.lane < 8 ? (int)__hip_atomic_load(cnt + 64 * F.lane, __ATOMIC_RELAXED, __HIP_MEMORY_SCOPE_AGENT) : 0; int inc = c;
#pragma unroll
        for (int o = 1; o < 8; o <<= 1) { const int n = __shfl_up(inc, o); if (F.lane >= o) inc += n; }
        if (F.lane < 8) offl[F.lane + 1] = inc; if (F.lane == 0) offl[0] = 0; }
    __syncthreads();
    int nmine = 0;
    if (F.tid < 128) { const int base = F.tid * 256;
#pragma unroll
        for (int e = 0; e < 8; ++e) { const int lo = max(base, offl[e]), hi = min(base + 256, offl[e + 1]); if (lo < hi) ++nmine; }
        int inc = nmine;
#pragma unroll
        for (int o = 1; o < 64; o <<= 1) { const int n = __shfl_up(inc, o); if (F.lane >= o) inc += n; }
        scan[F.tid] = inc - nmine; if (F.tid == 63) scan[129] = inc; if (F.tid == 127) scan[130] = inc; }
    __syncthreads();
    const int w0tot = scan[129], total = w0tot + scan[130];
    if (F.tid < 128) { const int base = F.tid * 256; int o = scan[F.tid] + (F.tid >= 64 ? w0tot : 0);
#pragma unroll
        for (int e = 0; e < 8; ++e) { const int lo = max(base, offl[e]), hi = min(base + 256, offl[e + 1]); if (lo < hi) { tab[o * 4 + 0] = F.tid; tab[o * 4 + 1] = e; tab[o * 4 + 2] = lo; tab[o * 4 + 3] = hi; ++o; } } }
    __syncthreads();
    return total;
}
__device__ __forceinline__ void phase_moe_final(const Frame& F, float* out, const bf16* Ys, const unsigned* TOK, const float* gate5) {
    const int gw = F.vcu * 8 + F.wave, NGW = F.G * 8;
    for (int row = gw; row < RL; row += 2 * NGW) {
        const int row2 = (row + NGW < RL) ? row + NGW : row;
        const unsigned* tka = TOK + (size_t)row * 8; const unsigned* tkb = TOK + (size_t)row2 * 8;
        const float wa0 = __uint_as_float(tka[4]), wa1 = __uint_as_float(tka[5]), wb0 = __uint_as_float(tkb[4]), wb1 = __uint_as_float(tkb[5]);
        const size_t pa0 = tka[6], pa1 = tka[7], pb0 = tkb[6], pb1 = tkb[7];
        const float* ga = gate5 + (row >> 12) * 6144; const float* gb = gate5 + (row2 >> 12) * 6144;
        v2u ya0[4], ya1[4], yb0[4], yb1[4]; f32x4 xa[4], xb[4];
#pragma unroll
        for (int j = 0; j < 4; ++j) { const int col = 4 * (F.lane + 64 * j);
            ya0[j] = *(const v2u*)(Ys + pa0 * 1024 + col); ya1[j] = *(const v2u*)(Ys + pa1 * 1024 + col); yb0[j] = *(const v2u*)(Ys + pb0 * 1024 + col); yb1[j] = *(const v2u*)(Ys + pb1 * 1024 + col);
            xa[j] = *(const f32x4*)(out + (size_t)row * 1024 + col); xb[j] = *(const f32x4*)(out + (size_t)row2 * 1024 + col); }
#pragma unroll
        for (int j = 0; j < 4; ++j) { const int col = 4 * (F.lane + 64 * j); const f32x4 gga = *(const f32x4*)(ga + col), ggb = *(const f32x4*)(gb + col);
            f32x4 x = xa[j];
            x[0] += gga[0] * (wa0 * bflo(ya0[j].x) + wa1 * bflo(ya1[j].x)); x[1] += gga[1] * (wa0 * bfhi(ya0[j].x) + wa1 * bfhi(ya1[j].x)); x[2] += gga[2] * (wa0 * bflo(ya0[j].y) + wa1 * bflo(ya1[j].y)); x[3] += gga[3] * (wa0 * bfhi(ya0[j].y) + wa1 * bfhi(ya1[j].y));
            *(f32x4*)(out + (size_t)row * 1024 + col) = x;
            if (row2 != row) { f32x4 y = xb[j];
                y[0] += ggb[0] * (wb0 * bflo(yb0[j].x) + wb1 * bflo(yb1[j].x)); y[1] += ggb[1] * (wb0 * bfhi(yb0[j].x) + wb1 * bfhi(yb1[j].x)); y[2] += ggb[2] * (wb0 * bflo(yb0[j].y) + wb1 * bflo(yb1[j].y)); y[3] += ggb[3] * (wb0 * bfhi(yb0[j].y) + wb1 * bfhi(yb1[j].y));
                *(f32x4*)(out + (size_t)row2 * 1024 + col) = y; } }
    }
}

#ifndef REP_MASK
#define REP_MASK 0u
#endif
#define REP(j) (1 + ((REP_MASK >> (j)) & 1u))
#ifndef PH_MASK
#define PH_MASK 0xffffffffu
#endif
#define IN(k) (lo <= (k) && (k) < hi)
#define ON(j) ((PH_MASK >> (j)) & 1u)
#define SEAM(k) do { if (IN(k) && IN((k) + 1)) xcd_barrier(bar); } while (0)
template <int l>
__device__ __forceinline__ void layer_body(const Frame& F, const Args& a, const XcdBarrier& bar, unsigned char* ws, unsigned* ctl, const int lo, const int hi) {
    const int G = F.G, cb = (int)blockIdx.x;
    const float* MOD = (const float*)(ws + WS_MOD);
    bf16* A0 = (bf16*)(ws + WS_A0); bf16* A1 = (bf16*)(ws + WS_A1); bf16* A2 = (bf16*)(ws + WS_A2); bf16* A3 = (bf16*)(ws + WS_A3); bf16* A4 = (bf16*)(ws + WS_A4); bf16* A5 = (bf16*)(ws + WS_A5);
    bf16* XB = (bf16*)(ws + WS_XB);
    {
        const int pb = 1 + l * 9;
        const float* modl = MOD + (size_t)l * 5 * 6144;
        const void* xs_lat = l == 0 ? (const void*)a.in[I_X] : (const void*)XB; const void* xs_ctx = l == 0 ? (const void*)a.in[I_CTX] : (const void*)(XB + (size_t)RL * 1024);
        if (ON(1) && IN(pb + 0)) for (int rep_ = 0; rep_ < (int)REP(1); ++rep_) phase_rmsmod<(l != 0)>(F, xs_lat, xs_ctx, R, a.in[I_GMIX] + l * 1024, modl, 0, A0);
        SEAM(pb + 0);
        if (ON(2) && IN(pb + 1)) {
            SchedPlain S{(const char*)A0, (const char*)(ws + WS_WIN + (size_t)l * 14 * MiB), (l == 0 ? R : RL) / 256, INW / 256, 1024, G, cb};
            EpiInProj E{A1, A2, A3, A4, A5, a.in[I_QG] + l * 64, a.in[I_KG] + l * 64, (const float*)(ws + WS_ROPE)};
            for (int rep_ = 0; rep_ < (int)REP(2); ++rep_) run_gemm<false>(F.lds, 1024, S, E);
            if (l == 1) {
                for (int t = F.vcu; t < 512; t += G) { const int tm = t >> 5, tn = t & 31; Unit u{};
                    gemm_small_tile(F.lds, A0 + (size_t)(RL + 64 * tm) * 1024, (const bf16*)(ws + WS_WIN + (size_t)14 * MiB) + (size_t)(1024 + 64 * tn) * 1024, 1024, RL + 64 * tm, 1024 + 64 * tn, u, E); }
            }
        }
        SEAM(pb + 1);
        if (ON(3) && IN(pb + 2)) {
#if FAST_GEMM
            if (l == 1) phase_qknorm(F, A1, A2, a.in[I_QG] + l * 64, a.in[I_KG] + l * 64, (const float*)(ws + WS_ROPE), 1);
#else
            phase_qknorm(F, A1, A2, a.in[I_QG] + l * 64, a.in[I_KG] + l * 64, (const float*)(ws + WS_ROPE), 0);
#endif
#ifndef SKIP_CONV
            for (int rep_ = 0; rep_ < (int)REP(3); ++rep_) phase_conv(F, A4, A0, a.in[I_DWW] + (size_t)l * CK * 1024, a.in[I_DWB] + l * 1024, a.in[I_CLNG] + l * 1024, a.in[I_CLNB] + l * 1024, l == 0 ? R : RL);
#endif
        }
        SEAM(pb + 2);
        if (ON(4) && IN(pb + 3)) {
#ifndef SKIP_ATTN
#if FAST_ATTN
#ifdef ATT_XVAR
            attn_fast<ATT_XVAR>(F, A1, A2, A3, A4, a.in[I_SUBLN] + l * 128, (const float*)(ws + WS_LAM) + l * 2, l == 0);
#endif
            attn16(F, A1, A2, A3, A4, a.in[I_SUBLN] + l * 128, (const float*)(ws + WS_LAM) + l * 2, l == 0
#ifdef PROBE_STAMP
                   , (l == 0 && blockIdx.x == 0) ? (unsigned long long*)(ws + WS_CTL + 768 * 1024) : nullptr
#endif
                   );
#else
            attn_naive(F, A1, A2, A3, A4, a.in[I_SUBLN] + l * 128, (const float*)(ws + WS_LAM) + l * 2, l == 0);
#endif
#endif
        }
        SEAM(pb + 3);
        if (ON(5) && IN(pb + 4)) {
            SchedMerge S{(const char*)A4, (const char*)(ws + WS_WA + (size_t)l * 6 * MiB), (const char*)A0, (const char*)(ws + WS_WC + (size_t)l * 6 * MiB), RL / 256, 4, 1024, G, cb};
            EpiMerge E{A5, A2, A1};
            for (int rep_ = 0; rep_ < (int)REP(5); ++rep_) run_gemm<false>(F.lds, 1024, S, E);
            if (l == 0) {
                for (int t = F.vcu; t < 256; t += G) { const int tm = t >> 4, tn = t & 15; Unit u{};
                    u.aux = 0; gemm_small_tile(F.lds, A4 + (size_t)(RL + 64 * tm) * 1024, (const bf16*)(ws + WS_WA) + (size_t)(64 * tn) * 1024, 1024, RL + 64 * tm, 64 * tn, u, E);
                    u.aux = 1; gemm_small_tile(F.lds, A0 + (size_t)(RL + 64 * tm) * 1024, (const bf16*)(ws + WS_WC) + (size_t)(64 * tn) * 1024, 1024, RL + 64 * tm, 64 * tn, u, E); }
            }
        }
        SEAM(pb + 4);
        if (ON(6) && IN(pb + 5)) {
            SchedPlain S{(const char*)A1, (const char*)(ws + WS_WO + (size_t)l * 6 * MiB), RL / 256, 4, 1024, G, cb};
            EpiResidT<(l != 0), (l == 0)> E{xs_lat, xs_ctx, l == 0 ? (void*)XB : (void*)a.out, modl + 2 * 1024};
            for (int rep_ = 0; rep_ < (int)REP(6); ++rep_) run_gemm<false>(F.lds, 1024, S, E);
            if (l == 0) { for (int t = F.vcu; t < 256; t += G) { const int tm = t >> 4, tn = t & 15; Unit u{};
                    gemm_small_tile(F.lds, A1 + (size_t)(RL + 64 * tm) * 1024, (const bf16*)(ws + WS_WO) + (size_t)(64 * tn) * 1024, 1024, RL + 64 * tm, 64 * tn, u, E); } }
        }
        SEAM(pb + 5);
        if (l == 0) {
            if (ON(7) && IN(pb + 6)) for (int rep_ = 0; rep_ < (int)REP(7); ++rep_) phase_rmsmod<true>(F, XB, XB + (size_t)RL * 1024, R, a.in[I_GFFN], modl, 3, A0);
            SEAM(pb + 6);
            if (ON(8) && IN(pb + 7)) {
                SchedPlain S{(const char*)A0, (const char*)(ws + WS_WGU0), R / 256, 2 * DFF / 256, 1024, G, cb};
                EpiSwiglu E{A1, DFF};
                for (int rep_ = 0; rep_ < (int)REP(8); ++rep_) run_gemm<false>(F.lds, 1024, S, E);
            }
            SEAM(pb + 7);
            if (ON(9) && IN(pb + 8)) {
                SchedPlain S{(const char*)A1, (const char*)(ws + WS_WD0), RL / 256, 4, DFF, G, cb};
                EpiResidT<true, true> E{XB, XB + (size_t)RL * 1024, XB, modl + 5 * 1024};
                run_gemm<false>(F.lds, DFF, S, E);
                for (int t = F.vcu; t < 256; t += G) { const int tm = t >> 4, tn = t & 15; Unit u{};
                    gemm_small_tile(F.lds, A1 + (size_t)(RL + 64 * tm) * DFF, (const bf16*)(ws + WS_WD0) + (size_t)(64 * tn) * DFF, DFF, RL + 64 * tm, 64 * tn, u, E); }
            }
            SEAM(pb + 8);
        } else {
            unsigned* cnt = ctl + CW_CNT; unsigned* TOK = (unsigned*)(ws + WS_TOK); int* slist = (int*)(ws + WS_SLIST);
            LAS int* tab = (LAS int*)(F.lds + MOETAB_OFF);
#ifndef SKIP_ROUTER
            if (ON(16) && IN(16)) phase_router(F, a.out, a.in[I_GFFN] + 1024, modl, a.in[I_WR], A0, (unsigned*)(ws + WS_BC), TOK);
#endif
            SEAM(16);
            if (ON(17) && IN(17)) phase_moe_lists(F, (const unsigned*)(ws + WS_BC), cnt, TOK, slist);
            SEAM(17);
            if (ON(18) && IN(18)) {
                const int NU = moe_build_table(F, cnt, tab);
                SchedMoe S{(const char*)A0, (const char*)(ws + WS_WEGU), slist, tab, NU, 2 * DFE / 256, 1024, G, cb, (size_t)2 * DFE * 1024 * 2, 1, NU * (2 * DFE / 256)};
                EpiSwiglu E{A1, DFE};
                for (int rep_ = 0; rep_ < (int)REP(18); ++rep_) run_gemm<true>(F.lds, 1024, S, E);
                { const int total = NU * 4, whole = (total / G) * G, left = total - whole;
                  if (left > 0 && 2 * left <= G) for (int sidx = F.vcu; sidx < left; sidx += G) { int pm, pn; tile_of(whole + sidx, NU, 4, pm, pn); const int lo = tab[pm * 4 + 2], hi = tab[pm * 4 + 3];
                      for (int i = F.tid; i < (hi - lo) * 32; i += 512) *(v4u*)((bf16*)XB + (size_t)(lo + (i >> 5)) * 1024 + pn * 256 + (i & 31) * 8) = (v4u){0u, 0u, 0u, 0u}; } }
            }
            SEAM(18);
            if (ON(19) && IN(19)) {
                const int NU = moe_build_table(F, cnt, tab);
                const int total = NU * 4; int whole = (total / G) * G, left = total - whole;
                if (!(left > 0 && 2 * left <= G)) { whole = total; left = 0; }
                SchedMoeDown S{(const char*)A1, (const char*)(ws + WS_WED), tab, NU, whole, left, G, cb, (size_t)1024 * DFE * 2};
                EpiMoeDown E{(bf16*)XB, 1024};
                run_gemm<false, DFE, true>(F.lds, DFE, S, E);
            }
            SEAM(19);
            if (ON(20) && IN(20)) phase_moe_final(F, a.out, (const bf16*)XB, TOK, modl + 5 * 1024);
        }
        }
}

constexpr int N_PHASES = 21;
__global__ void __launch_bounds__(512, 2) fwd_kernel(Args a) {
    extern __shared__ __attribute__((aligned(16))) unsigned char lds_raw[];
    Frame F; F.lds = (LAS unsigned char*)lds_raw; F.tid = threadIdx.x; F.lane = F.tid & 63; F.wave = __builtin_amdgcn_readfirstlane(F.tid >> 6);
    F.G = gridDim.x; { const int bx = blockIdx.x; F.vcu = (F.G % 8 == 0) ? (bx % 8) * (F.G / 8) + bx / 8 : bx; }
    unsigned char* ws = a.ws;
    unsigned* ctl = (unsigned*)(ws + WS_CTL);
    for (int u = F.tid; u < (LDS_BYTES - LDSCTL_OFF) / 4; u += 512) ((LAS unsigned*)(F.lds + LDSCTL_OFF))[u] = 0u;
    __syncthreads();
    volatile LAS unsigned* MISC = (volatile LAS unsigned*)(F.lds + MISC_OFF);
    XcdBarrier bar = xcd_barrier_post(ctl + CW_BAR, MISC + 8);
    const int lo = a.ph_lo, hi = a.ph_hi;

    const int G = F.G, cb = (int)blockIdx.x;
    const float* MOD = (const float*)(ws + WS_MOD);
    bf16* A0 = (bf16*)(ws + WS_A0); bf16* A1 = (bf16*)(ws + WS_A1); bf16* A2 = (bf16*)(ws + WS_A2); bf16* A3 = (bf16*)(ws + WS_A3); bf16* A4 = (bf16*)(ws + WS_A4); bf16* A5 = (bf16*)(ws + WS_A5);
    bf16* XB = (bf16*)(ws + WS_XB);

    #ifndef SKIP_PRO
    if (ON(0) && IN(0)) { for (int rep_ = 0; rep_ < (int)REP(0); ++rep_) phase_prologue(F, a); }
#endif
    SEAM(0);

    layer_body<0>(F, a, bar, ws, ctl, lo, hi);
    layer_body<1>(F, a, bar, ws, ctl, lo, hi);
#ifdef PROBE_STAMP
    xcd_barrier(bar);
    if (blockIdx.x == 0 && F.tid == 0) { const unsigned long long* st = (const unsigned long long*)(ws + WS_CTL + 768 * 1024);
        const float ghz = (float)st[0] / (float)st[1] * 0.1f, cpi = (float)st[0] / (float)st[2];
        a.out[0] += (PROBE_STAMP == 1) ? ghz * 10.f : (cpi - 2000.f) * 0.05f; }
#endif
#undef IN
#undef SEAM
}

extern "C" void kernel_launch(void* const* d_in, const int* in_sizes, int n_in, void* d_out, int out_size, void* d_ws, size_t ws_size, hipStream_t stream) {
    static int grid = 0;
    if (grid == 0) {
        if (n_in != N_IN || out_size != RL * D || ws_size < WS_END) { fprintf(stderr, "kernel_launch: unexpected shapes (n_in %d out %d ws %zu)\n", n_in, out_size, ws_size); grid = -1; return; }
        int dev = 0, cus = 0, per_cu = 0;
        if (hipGetDevice(&dev) != hipSuccess || hipDeviceGetAttribute(&cus, hipDeviceAttributeMultiprocessorCount, dev) != hipSuccess) { grid = -1; return; }
        if (hipFuncSetAttribute((const void*)fwd_kernel, hipFuncAttributeMaxDynamicSharedMemorySize, LDS_BYTES) != hipSuccess) { fprintf(stderr, "kernel_launch: hipFuncSetAttribute failed\n"); grid = -1; return; }
        if (hipOccupancyMaxActiveBlocksPerMultiprocessor(&per_cu, (const void*)fwd_kernel, 512, LDS_BYTES) != hipSuccess || per_cu < 1) fprintf(stderr, "kernel_launch: occupancy query reports %d\n", per_cu);
        (void)hipGetLastError();
        grid = cus;
    }
    if (grid < 0) return;
    (void)hipMemsetAsync((char*)d_ws + WS_CTL, 0, CTL_ZERO_BYTES, stream);
    Args a{};
    for (int i = 0; i < N_IN; ++i) a.in[i] = (const float*)d_in[i];
    a.out = (float*)d_out; a.ws = (unsigned char*)d_ws; a.ph_lo = 0; a.ph_hi = N_PHASES;
    hipLaunchKernelGGL(fwd_kernel, dim3(grid), dim3(512), LDS_BYTES, stream, a);
}
```

```cpp
#include <hip/hip_runtime.h>
#include <cstdio>
#include <cstdint>

#ifndef FAST_GEMM
#define FAST_GEMM 1
#endif
#ifndef FAST_ATTN
#define FAST_ATTN 1
#define ATT_STAGGER 0
#endif

#define GAS __attribute__((address_space(1)))
#define LAS __attribute__((address_space(3)))
typedef unsigned short bf16;
typedef unsigned v4u __attribute__((ext_vector_type(4)));
typedef unsigned v2u __attribute__((ext_vector_type(2)));
typedef float f32x4 __attribute__((ext_vector_type(4)));
typedef float f32x2 __attribute__((ext_vector_type(2)));
typedef float f32x16 __attribute__((ext_vector_type(16)));
typedef short bf16x8 __attribute__((ext_vector_type(8)));
typedef short s16x4 __attribute__((ext_vector_type(4)));

constexpr int D = 1024, NB = 4, SEQ = 4096, CTXL = 256, TK = SEQ + CTXL, RL = NB * SEQ, RC = NB * CTXL, R = RL + RC;
constexpr int NH = 8, HD = 64, VD = 128, INW = 7168, DFF = 2816, NE = 8, DFE = 3584, CK = 31;
constexpr float EPS = 1e-6f;
constexpr float QSCALE = 0.125f * 1.4426950408889634f;
enum { I_X = 0, I_C, I_CTX, I_CCTX, I_WMOD, I_BMOD, I_GMIX, I_WIN, I_QG, I_KG, I_LQ1, I_LK1, I_LQ2, I_LK2, I_SUBLN, I_WATTNO, I_DWW, I_DWB, I_CLNG, I_CLNB, I_WCONVO, I_WOUT, I_GFFN,
       I_WFFG, I_WFFU, I_WFFD, I_WR, I_WEG, I_WEU, I_WED, N_IN };

constexpr size_t MiB = 1u << 20;
constexpr size_t WS_CTL = 0, CTL_ZERO_BYTES = 1 * MiB;
constexpr size_t WS_MOD = 1 * MiB;
constexpr size_t WS_ROPE = 1 * MiB + 256 * 1024;
constexpr size_t WS_LAM = 1 * MiB + 300 * 1024;
constexpr size_t WS_BC = 1 * MiB + 320 * 1024;
constexpr size_t WS_TOK = 2 * MiB;
constexpr size_t WS_SLIST = 2 * MiB + 512 * 1024;
constexpr size_t WS_WIN = 3 * MiB;
constexpr size_t WS_WA = 31 * MiB, WS_WC = 33 * MiB, WS_WO = 35 * MiB;
constexpr size_t WS_WGU0 = 43 * MiB, WS_WD0 = 54 * MiB;
constexpr size_t WS_WEGU = 60 * MiB, WS_WED = 172 * MiB;
constexpr size_t WS_XB = 228 * MiB;
constexpr size_t WS_A0 = 296 * MiB;
constexpr size_t WS_A1 = 330 * MiB;
constexpr size_t WS_A2 = 364 * MiB;
constexpr size_t WS_A3 = 398 * MiB;
constexpr size_t WS_A4 = 432 * MiB;
constexpr size_t WS_A5 = 466 * MiB;
constexpr size_t WS_END = 554 * MiB;
constexpr int CW_BAR = 4096;
constexpr int CW_CNT = 16384;

constexpr int RING_BYTES = 131072, LDSCTL_OFF = RING_BYTES, MISC_OFF = LDSCTL_OFF + 320, MOETAB_OFF = LDSCTL_OFF + 1024, LDS_BYTES = 147456;

#define LDS_WAIT() asm volatile("s_waitcnt lgkmcnt(0)" ::: "memory")
#define VM_WAIT() asm volatile("s_waitcnt vmcnt(0)" ::: "memory")
typedef float f32x2_t __attribute__((ext_vector_type(2)));
typedef __bf16 bf16x2_t __attribute__((ext_vector_type(2)));
__device__ __forceinline__ unsigned cvt_pk_bf16_pin(float lo, float hi) { unsigned r; asm volatile("v_cvt_pk_bf16_f32 %0, %1, %2" : "=v"(r) : "v"(lo), "v"(hi)); return r; }
__device__ __forceinline__ unsigned cvt_pk_bf16(float lo, float hi) { const f32x2_t v = {lo, hi}; const bf16x2_t b = __builtin_convertvector(v, bf16x2_t); return __builtin_bit_cast(unsigned, b); }
__device__ __forceinline__ float bflo(unsigned w) { return __uint_as_float(w << 16); }
__device__ __forceinline__ float bfhi(unsigned w) { return __uint_as_float(w & 0xffff0000u); }
__device__ __forceinline__ float sigm(float x) { return 1.f / (1.f + __expf(-x)); }
__device__ __forceinline__ float sigf(float x) { return __builtin_amdgcn_rcpf(1.f + __builtin_amdgcn_exp2f(x * -1.4426950408889634f)); }
__device__ __forceinline__ float rsq_(float x) { return __builtin_amdgcn_rsqf(x); }
__device__ __forceinline__ float wave_sum(float v) {
#pragma unroll
    for (int o = 1; o < 64; o <<= 1) v += __shfl_xor(v, o);
    return v;
}
__device__ __forceinline__ float reduce8(const float (&v)[8], int lane) {
    float w[4], u[2];
#pragma unroll
    for (int k = 0; k < 4; ++k) { const float snd = (lane & 32) ? v[k] : v[k + 4], kp = (lane & 32) ? v[k + 4] : v[k]; w[k] = kp + __shfl_xor(snd, 32); }
#pragma unroll
    for (int k = 0; k < 2; ++k) { const float snd = (lane & 16) ? w[k] : w[k + 2], kp = (lane & 16) ? w[k + 2] : w[k]; u[k] = kp + __shfl_xor(snd, 16); }
    const float snd = (lane & 8) ? u[0] : u[1], kp = (lane & 8) ? u[1] : u[0]; float t = kp + __shfl_xor(snd, 8);
    t += __shfl_xor(t, 4); t += __shfl_xor(t, 2); t += __shfl_xor(t, 1);
    return t;
}
__device__ __forceinline__ int row_mi(int row) { return row < RL ? (row >> 12) : 4; }
__device__ __forceinline__ int row_b(int row) { return row < RL ? (row >> 12) : ((row - RL) >> 8); }
__device__ __forceinline__ int row_t(int row) { return row < RL ? (CTXL + (row & 4095)) : ((row - RL) & 255); }

#define XB_TMO      128
#define XB_XCNT(j)  (256  + 64 * (j))
#define XB_XSUB(j)  (1280 + 64 * (j))
#define XB_XGEN(j)  (2304 + 64 * (j))
#define XB_TOP      3328
#define XB_TOPGEN   3392
#define XCD_BAR_WORDS 3456
#define XB_SPIN_CAP (1u << 22)
__device__ __forceinline__ unsigned xb_ld(unsigned* p)              { return __hip_atomic_load(p, __ATOMIC_RELAXED, __HIP_MEMORY_SCOPE_AGENT); }
__device__ __forceinline__ unsigned xb_add(unsigned* p, unsigned v) { return __hip_atomic_fetch_add(p, v, __ATOMIC_RELAXED, __HIP_MEMORY_SCOPE_AGENT); }
__device__ __forceinline__ unsigned xb_xcc_id() { return (unsigned)__builtin_amdgcn_s_getreg((3 << 11) | 20) & 0xFu; }
#define XB_SPIN(cond, bar) do { unsigned _sp = 0; while (cond) { __builtin_amdgcn_s_sleep(1); \
    if ((++_sp & 255u) == 0u) { if (xb_ld(&(bar)[XB_TMO])) break; if (_sp > XB_SPIN_CAP) { atomicAdd(&(bar)[XB_TMO], 1u); break; } } } } while (0)
struct XcdBarrier { unsigned* bar; unsigned x; volatile LAS unsigned* st; };
__device__ __forceinline__ XcdBarrier xcd_barrier_post(unsigned* bar, volatile LAS unsigned* st) {
    XcdBarrier b; b.bar = bar; b.x = xb_xcc_id(); b.st = st;
    if (threadIdx.x == 0) (void)xb_add(&bar[XB_XCNT(b.x)], 1u);
    return b;
}
__device__ __forceinline__ void xcd_barrier_complete(unsigned* bar, unsigned x, unsigned& nloc, unsigned& nx) {
    const unsigned G = gridDim.x * gridDim.y * gridDim.z;
    unsigned sum, cnt, mine, sp = 0u;
    for (;;) {
        sum = 0u; cnt = 0u; mine = 0u;
#pragma unroll
        for (unsigned j = 0; j < 16; ++j) { const unsigned c = xb_ld(&bar[XB_XCNT(j)]); sum += c; cnt += (c > 0u) ? 1u : 0u; mine = (j == x) ? c : mine; }
        if (sum == G) break;
        __builtin_amdgcn_s_sleep(1);
        if ((++sp & 255u) == 0u) { if (xb_ld(&bar[XB_TMO])) break; if (sp > XB_SPIN_CAP) { atomicAdd(&bar[XB_TMO], 1u); break; } }
    }
    nloc = mine > 0u ? mine : 1u; nx = cnt > 0u ? cnt : 1u;
}
__device__ __forceinline__ void xcd_barrier(const XcdBarrier& b) {
    asm volatile("s_waitcnt vmcnt(0)" ::: "memory");
    __syncthreads();
    if (threadIdx.x == 0) {
        unsigned* bar = b.bar;
        __builtin_amdgcn_s_waitcnt(0);
        unsigned nloc = b.st[0], nx = b.st[1];
        if (nloc == 0u) { xcd_barrier_complete(bar, b.x, nloc, nx); b.st[0] = nloc; b.st[1] = nx; }
        const unsigned old = xb_add(&bar[XB_XSUB(b.x)], 1u);
        const unsigned gen = old / nloc;
        if (old + 1u == (gen + 1u) * nloc) {
            __builtin_amdgcn_fence(__ATOMIC_RELEASE, "agent");
            asm volatile("s_waitcnt vmcnt(0)" ::: "memory");
            const unsigned og = xb_add(&bar[XB_TOP], 1u);
            const unsigned tg = og / nx;
            if (og + 1u == (tg + 1u) * nx) xb_add(&bar[XB_TOPGEN], 1u);
            else XB_SPIN(xb_ld(&bar[XB_TOPGEN]) == tg, bar);
            __builtin_amdgcn_fence(__ATOMIC_ACQUIRE, "agent");
            xb_add(&bar[XB_XGEN(b.x)], 1u);
            asm volatile("s_waitcnt vmcnt(0)" ::: "memory");
        } else {
            XB_SPIN(xb_ld(&bar[XB_XGEN(b.x)]) == gen, bar);
            __builtin_amdgcn_fence(__ATOMIC_ACQUIRE, "agent");
            asm volatile("s_waitcnt vmcnt(0)" ::: "memory");
        }
    }
    __syncthreads();
}

struct Unit { const char* A; const char* B; const int* rows; int row0, col0, lo, hi, aux, kt; };

__device__ __forceinline__ void tile_of(int wgid, int nM, int nN, int& pm, int& pn) {
    const int nwg = nM * nN;
    { const int q = nwg / 8, r = nwg % 8, xcd = wgid % 8, off = wgid / 8; wgid = (xcd < r ? xcd * (q + 1) : r * (q + 1) + (xcd - r) * q) + off; }
    const int nig = 8 * nN, gid = wgid / nig, fm = gid * 8, gsz = (nM - fm) < 8 ? (nM - fm) : 8;
    pm = fm + ((wgid % nig) % gsz); pn = (wgid % nig) / gsz;
}
struct SchedPlain {
    const char* A; const char* Bt; int nM, nN, K, G, c;
    __device__ __forceinline__ bool next(int i, Unit& u) const {
        const int L = i * G + c; if (L >= nM * nN) return false;
        int pm, pn; tile_of(L, nM, nN, pm, pn);
        u.A = A + (size_t)pm * 256 * K * 2; u.B = Bt + (size_t)pn * 256 * K * 2; u.rows = nullptr; u.row0 = pm * 256; u.col0 = pn * 256; u.lo = 0; u.hi = 0x7fffffff; u.aux = 0; return true;
    }
};
struct SchedMerge {
    const char* A0; const char* B0; const char* A1; const char* B1; int nM, nN, K, G, c;
    __device__ __forceinline__ bool next(int i, Unit& u) const {
        const int L = (i >> 1) * G + c; if (L >= nM * nN) return false;
        int pm, pn; tile_of(L, nM, nN, pm, pn); const int pass = i & 1;
        u.A = (pass ? A1 : A0) + (size_t)pm * 256 * K * 2; u.B = (pass ? B1 : B0) + (size_t)pn * 256 * K * 2; u.rows = nullptr; u.row0 = pm * 256; u.col0 = pn * 256; u.lo = 0; u.hi = 0x7fffffff; u.aux = pass; return true;
    }
};
struct SchedMoe {
    const char* A; const char* Bt; const int* slist; const LAS int* tab; int NU, nN, K, G, c; size_t bstride; int gather; int Lmax;
    __device__ __forceinline__ bool next(int i, Unit& u) const {
        const int L = i * G + c; if (L >= Lmax) return false;
        int pm, pn; tile_of(L, NU, nN, pm, pn);
        const int tile = __builtin_amdgcn_readfirstlane(tab[pm * 4 + 0]), e = __builtin_amdgcn_readfirstlane(tab[pm * 4 + 1]);
        u.lo = __builtin_amdgcn_readfirstlane(tab[pm * 4 + 2]); u.hi = __builtin_amdgcn_readfirstlane(tab[pm * 4 + 3]);
        u.A = gather ? A : A + (size_t)tile * 256 * K * 2; u.rows = gather ? slist + tile * 256 : nullptr;
        u.B = Bt + (size_t)e * bstride + (size_t)pn * 256 * K * 2; u.row0 = tile * 256; u.col0 = pn * 256; u.aux = e; return true;
    }
};

__device__ __forceinline__ int qk_vec_of(int v) { return ((v >> 8) << 2) | ((v >> 5) & 3); }
__device__ __forceinline__ int qk_dim_of(int v) { const int j = v & 31; return (((v >> 7) & 1) << 5) | (((j >> 2) & 1) << 4) | ((j >> 3) << 2) | (j & 3); }
__device__ __forceinline__ int qk_pos(int d) { return (d & 32) | ((d & 12) << 1) | ((d & 16) >> 2) | (d & 3); }
__device__ __forceinline__ int qk_src_col(int v) { return qk_vec_of(v) * 64 + qk_dim_of(v); }
__device__ __forceinline__ v4u pack8(f32x4 a, f32x4 b) { v4u w; w.x = cvt_pk_bf16(a[0], a[1]); w.y = cvt_pk_bf16(a[2], a[3]); w.z = cvt_pk_bf16(b[0], b[1]); w.w = cvt_pk_bf16(b[2], b[3]); return w; }
__device__ __forceinline__ void unpack8(v4u w, f32x4& a, f32x4& b) { a = (f32x4){bflo(w.x), bfhi(w.x), bflo(w.y), bfhi(w.y)}; b = (f32x4){bflo(w.z), bfhi(w.z), bflo(w.w), bfhi(w.w)}; }
struct EpiInProj {
    static constexpr bool ROW16 = true;
    bf16 *Q, *K, *V, *U0, *GT; const float *qg, *kg, *rope;
    __device__ __forceinline__ void store8(const Unit&, int row, int col, f32x4 v0, f32x4 v1) const {
        if (col < 3072) {
            const int b = row_b(row), t = row_t(row);
            if (col < 2048) {
                const int vec = qk_vec_of(col), d0 = qk_dim_of(col); bf16* base = (vec < 16 ? Q : K) + ((size_t)(((b * NH) * 2 + (vec & 15)) * TK + t) * 64 + qk_pos(d0));
                *(v4u*)base = pack8(v0, v1); }
            else { const v4u w = pack8(v0, v1); const int cc = col - 2048, h = cc >> 7, dv = cc & 127; *(v4u*)(V + ((size_t)((b * NH + h) * TK + t) * 128 + dv)) = w; }
        } else if (col < 5120) {
            const int cc = col - 3072, rem = cc & 255, ch = (cc >> 8) * 128 + (rem & 127) + (rem >> 7) * 4; v2u w; w.x = cvt_pk_bf16(v0[0] * sigf(v1[0]), v0[1] * sigf(v1[1])); w.y = cvt_pk_bf16(v0[2] * sigf(v1[2]), v0[3] * sigf(v1[3]));
            *(v2u*)(U0 + (size_t)row * 1024 + ch) = w;
        } else {
            f32x4 a, b;
#pragma unroll
            for (int j = 0; j < 4; ++j) { a[j] = sigf(v0[j]); b[j] = sigf(v1[j]); }
            *(v4u*)(GT + (size_t)row * 2048 + (col - 5120)) = pack8(a, b);
        }
    }
    __device__ __forceinline__ void store16(const Unit& u, int row, int col, f32x4 a0, f32x4 a1, f32x4 b0, f32x4 b1) const {
        if (col >= 3072 && col < 5120) {
            const int cc = col - 3072; v4u w; w.x = cvt_pk_bf16(a0[0] * sigf(a1[0]), a0[1] * sigf(a1[1])); w.y = cvt_pk_bf16(a0[2] * sigf(a1[2]), a0[3] * sigf(a1[3]));
            w.z = cvt_pk_bf16(b0[0] * sigf(b1[0]), b0[1] * sigf(b1[1])); w.w = cvt_pk_bf16(b0[2] * sigf(b1[2]), b0[3] * sigf(b1[3]));
            *(v4u*)(U0 + (size_t)row * 1024 + ((cc >> 8) * 128 + (cc & 255))) = w; return; }
        if (col >= 2048) { store8(u, row, col, a0, a1); store8(u, row, col + 128, b0, b1); return; }
        const int b = row_b(row), t = row_t(row), vec = qk_vec_of(col), q4 = ((col & 31) >> 3) << 2;
        float ss = 0.f;
#pragma unroll
        for (int r = 0; r < 4; ++r) ss += (a0[r] * a0[r] + a1[r] * a1[r]) + (b0[r] * b0[r] + b1[r] * b1[r]);
        ss += __shfl_xor(ss, 16); ss += __shfl_xor(ss, 32);
        const float rinv = rsq_((ss * (1.f / 64.f) + EPS)) * (vec < 16 ? QSCALE : 1.f);
        const float* g = (vec < 16 ? qg : kg) + q4;
        a0 = a0 * rinv * *(const f32x4*)g; a1 = a1 * rinv * *(const f32x4*)(g + 16); b0 = b0 * rinv * *(const f32x4*)(g + 32); b1 = b1 * rinv * *(const f32x4*)(g + 48);
        if (t >= CTXL) { const int sq = t - CTXL; const float* c0p = rope + (sq >> 6) * 16 + q4; const float* c1p = rope + (sq & 63) * 16 + q4;
            const f32x4 c0 = *(const f32x4*)c0p, s0 = *(const f32x4*)(c0p + 1024), c1 = *(const f32x4*)c1p, s1 = *(const f32x4*)(c1p + 1024);
            const f32x4 x0 = a0 * c0 - a1 * s0, x1 = a1 * c0 + a0 * s0, y0 = b0 * c1 - b1 * s1, y1 = b1 * c1 + b0 * s1; a0 = x0; a1 = x1; b0 = y0; b1 = y1; }
        bf16* base = (vec < 16 ? Q : K) + ((size_t)(((b * NH) * 2 + (vec & 15)) * TK + t) * 64 + 2 * q4);
        *(v4u*)base = pack8(a0, a1); *(v4u*)(base + 32) = pack8(b0, b1);
    }
};
struct EpiMerge {
    static constexpr bool ROW16 = false;
    const bf16* GT; bf16* TF; bf16* M1;
    __device__ __forceinline__ void store8(const Unit& u, int row, int col, f32x4 v0, f32x4 v1) const {
        f32x4 g0, g1; unpack8(*(const v4u*)(GT + (size_t)row * 2048 + u.aux * 1024 + col), g0, g1);
        if (u.aux == 0) { *(v4u*)(TF + (size_t)row * 1024 + col) = pack8(g0 * v0, g1 * v1); }
        else { f32x4 t0, t1; unpack8(*(const v4u*)(TF + (size_t)row * 1024 + col), t0, t1); *(v4u*)(M1 + (size_t)row * 1024 + col) = pack8(t0 + g0 * v0, t1 + g1 * v1); }
    }
};
template <bool SB, bool DB>
struct EpiResidT {
    static constexpr bool ROW16 = false;
    const void* src_lat; const void* src_ctx; void* dst; const float* gate;
    __device__ __forceinline__ void store8(const Unit&, int row, int col, f32x4 v0, f32x4 v1) const {
        const float* g = gate + row_mi(row) * 6144 + col; const f32x4 g0 = *(const f32x4*)g, g1 = *(const f32x4*)(g + 4);
        f32x4 s0, s1;
        if constexpr (SB) { const bf16* s = (row < RL ? (const bf16*)src_lat + (size_t)row * 1024 : (const bf16*)src_ctx + (size_t)(row - RL) * 1024) + col; unpack8(*(const v4u*)s, s0, s1); }
        else { const float* s = (row < RL ? (const float*)src_lat + (size_t)row * 1024 : (const float*)src_ctx + (size_t)(row - RL) * 1024) + col; s0 = *(const f32x4*)s; s1 = *(const f32x4*)(s + 4); }
        if constexpr (DB) { *(v4u*)((bf16*)dst + (size_t)row * 1024 + col) = pack8(s0 + g0 * v0, s1 + g1 * v1); }
        else { float* d = (float*)dst + (size_t)row * 1024 + col; *(f32x4*)d = s0 + g0 * v0; *(f32x4*)(d + 4) = s1 + g1 * v1; }
    }
};
struct EpiSwiglu {
    static constexpr bool ROW16 = true;
    bf16* ACT; int ld;
    __device__ __forceinline__ void store8(const Unit&, int row, int col, f32x4 v0, f32x4 v1) const {
        v2u w; w.x = cvt_pk_bf16(v0[0] * sigf(v0[0]) * v1[0], v0[1] * sigf(v0[1]) * v1[1]); w.y = cvt_pk_bf16(v0[2] * sigf(v0[2]) * v1[2], v0[3] * sigf(v0[3]) * v1[3]);
        const int rem = col & 255; *(v2u*)(ACT + (size_t)row * ld + ((col >> 8) * 128 + (rem & 127) + (rem >> 7) * 4)) = w;
    }
    __device__ __forceinline__ void store16(const Unit&, int row, int col, f32x4 a0, f32x4 a1, f32x4 b0, f32x4 b1) const {
        v4u w; w.x = cvt_pk_bf16(a0[0] * sigf(a0[0]) * a1[0], a0[1] * sigf(a0[1]) * a1[1]); w.y = cvt_pk_bf16(a0[2] * sigf(a0[2]) * a1[2], a0[3] * sigf(a0[3]) * a1[3]);
        w.z = cvt_pk_bf16(b0[0] * sigf(b0[0]) * b1[0], b0[1] * sigf(b0[1]) * b1[1]); w.w = cvt_pk_bf16(b0[2] * sigf(b0[2]) * b1[2], b0[3] * sigf(b0[3]) * b1[3]);
        *(v4u*)(ACT + (size_t)row * ld + ((col >> 8) * 128 + (col & 255))) = w;
    }
};
struct SchedMoeDown {
    const char* A; const char* Bt; const LAS int* tab; int NU, whole, left, G, c; size_t bstride;
    __device__ __forceinline__ bool next(int i, Unit& u) const {
        const int Li = i * G + c; int L = Li, kh = 0, split = 0;
        if (Li >= whole) { const int sidx = Li - whole; if (sidx >= 2 * left) return false; L = whole + (sidx >> 1); kh = sidx & 1; split = 1; }
        int pm, pn; tile_of(L, NU, 4, pm, pn);
        const int tile = __builtin_amdgcn_readfirstlane(tab[pm * 4 + 0]), e = __builtin_amdgcn_readfirstlane(tab[pm * 4 + 1]);
        u.lo = __builtin_amdgcn_readfirstlane(tab[pm * 4 + 2]); u.hi = __builtin_amdgcn_readfirstlane(tab[pm * 4 + 3]);
        u.A = A + ((size_t)tile * 256 * DFE + (size_t)kh * (DFE / 2)) * 2; u.rows = nullptr;
        u.B = Bt + (size_t)e * bstride + ((size_t)pn * 256 * DFE + (size_t)kh * (DFE / 2)) * 2; u.row0 = tile * 256; u.col0 = pn * 256; u.aux = split; u.kt = split ? DFE / 128 : DFE / 64; return true;
    }
};
struct EpiMoeDown { bf16* O; int ld;
    static constexpr bool ROW16 = false;
    __device__ __forceinline__ void store8(const Unit& u, int row, int col, f32x4 v0, f32x4 v1) const {
        const v4u w = pack8(v0, v1); bf16* d = O + (size_t)row * ld + col;
        if (u.aux) {
            asm volatile("global_atomic_pk_add_bf16 %0, %1, off sc1\n\tglobal_atomic_pk_add_bf16 %0, %2, off offset:4 sc1\n\tglobal_atomic_pk_add_bf16 %0, %3, off offset:8 sc1\n\tglobal_atomic_pk_add_bf16 %0, %4, off offset:12 sc1"
                         :: "v"(d), "v"(w.x), "v"(w.y), "v"(w.z), "v"(w.w) : "memory"); }
        else *(v4u*)d = w;
    }
};
struct EpiBf16Plain { bf16* O; int ld;
    static constexpr bool ROW16 = false;
    __device__ __forceinline__ void store8(const Unit&, int row, int col, f32x4 v0, f32x4 v1) const { *(v4u*)(O + (size_t)row * ld + col) = pack8(v0, v1); }
};

template <class Epi, class Sched>
__device__ __forceinline__ void gemm_naive(LAS unsigned char* lds, const int K, const Sched& S, const Epi& E) {
    LAS float* As = (LAS float*)lds; LAS float* Bs = As + 32 * 132;
    const int tid = threadIdx.x, ty = tid >> 4, tx = tid & 15, lr = tid >> 2, kc = (tid & 3) * 8;
    Unit u;
    for (int i = 0; S.next(i, u); ++i) {
        for (int sub = 0; sub < 4; ++sub) {
            const int rm = (sub >> 1) * 128, cn = (sub & 1) * 128;
            const size_t arow = u.rows ? (size_t)u.rows[rm + lr] : (size_t)(rm + lr);
            const bf16* ap = (const bf16*)u.A + arow * K + kc; const bf16* bp = (const bf16*)u.B + (size_t)(cn + lr) * K + kc;
            float acc[4][8];
#pragma unroll
            for (int r = 0; r < 4; ++r)
#pragma unroll
                for (int c = 0; c < 8; ++c) acc[r][c] = 0.f;
            for (int k0 = 0; k0 < K; k0 += 32) {
                const v4u av = *(const v4u*)(ap + k0), bv = *(const v4u*)(bp + k0);
                f32x4 a0, a1, b0, b1; unpack8(av, a0, a1); unpack8(bv, b0, b1);
#pragma unroll
                for (int j = 0; j < 4; ++j) { As[(kc + j) * 132 + lr] = a0[j]; As[(kc + 4 + j) * 132 + lr] = a1[j]; Bs[(kc + j) * 132 + lr] = b0[j]; Bs[(kc + 4 + j) * 132 + lr] = b1[j]; }
                __syncthreads();
#pragma unroll 4
                for (int kk = 0; kk < 32; ++kk) {
                    const f32x4 a = *(const LAS f32x4*)(As + kk * 132 + ty * 4), p = *(const LAS f32x4*)(Bs + kk * 132 + tx * 8), q = *(const LAS f32x4*)(Bs + kk * 132 + tx * 8 + 4);
#pragma unroll
                    for (int r = 0; r < 4; ++r) {
#pragma unroll
                        for (int c = 0; c < 4; ++c) { acc[r][c] += a[r] * p[c]; acc[r][4 + c] += a[r] * q[c]; } }
                }
                __syncthreads();
            }
#pragma unroll
            for (int r = 0; r < 4; ++r) { const int row = u.row0 + rm + ty * 4 + r;
                if (row >= u.lo && row < u.hi) E.store8(u, row, u.col0 + cn + tx * 8, (f32x4){acc[r][0], acc[r][1], acc[r][2], acc[r][3]}, (f32x4){acc[r][4], acc[r][5], acc[r][6], acc[r][7]}); }
        }
    }
}

namespace pg8 {
constexpr int BM = 256, BK = 64, HALF = 128, HTB = HALF * BK * 2, STAGE_BYTES = 8 * HTB;
__device__ __forceinline__ int lds_byte(int r, int c) { const int st = (r >> 4) * 2 + (c >> 5), rr = r & 15, cc = c & 31, ob = rr * 64 + cc * 2; return st * 1024 + (ob ^ (((ob >> 9) & 1) << 5)); }
__device__ __forceinline__ void stage_rc(int b, int& R_, int& C_) { const int st = b / 1024, sb = b % 1024, swz = sb ^ (((sb >> 9) & 1) << 5); R_ = (st >> 1) * 16 + swz / 64; C_ = (st & 1) * 32 + (swz % 64) / 2; }
__device__ __forceinline__ int perm32(int rho) { const int n = rho >> 4, i = rho & 15; return 8 * (i >> 2) + 4 * n + (i & 3); }

template <class Epi, class Sched, bool GATHER, int KPITCH = 0, bool VARK = false>
__device__ __forceinline__ void gemm_phase(LAS unsigned char* lds, const int K, const Sched& S, const Epi& E) {
    const int Kp = KPITCH ? KPITCH : K;
    const int tid = threadIdx.x, wid = __builtin_amdgcn_readfirstlane(tid >> 6), lane = tid & 63, wr = wid >> 2, wc = wid & 3, fr = lane & 15, fq = lane >> 4;
    const int nt = K / BK;
    int Rr[2], Cc[2]; unsigned voffB[2];
#pragma unroll
    for (int i = 0; i < 2; ++i) { stage_rc(tid * 16 + i * 8192, Rr[i], Cc[i]); const int Rb = (Rr[i] & ~31) + perm32(Rr[i] & 31); voffB[i] = (unsigned)(Rb * Kp + Cc[i]) * 2u; }
    const size_t kstep = (size_t)(BK * 2), hstep = (size_t)HALF * Kp * 2;
    const unsigned ldsw = (unsigned)wid * 1024u;
    const int aoff = lds_byte(wr * 64 + fr, fq * 8), boff = lds_byte(wc * 32 + fr, fq * 8);
#define PG8_SA(b, h) (((b) * 2 + (h)) * HTB)
#define PG8_SB(b, h) ((4 + (b) * 2 + (h)) * HTB)
#define PG8_STAGE2(bufoff, gbase, o0, o1) do { \
        __builtin_amdgcn_global_load_lds((const unsigned*)((const char*)(gbase) + (o0)), (LAS unsigned*)(lds + (bufoff) + ldsw), 16, 0, 0); \
        __builtin_amdgcn_global_load_lds((const unsigned*)((const char*)(gbase) + (o1)), (LAS unsigned*)(lds + (bufoff) + ldsw + 8192), 16, 0, 0); } while (0)
#define PG8_STAGEB(bufoff, gbase) PG8_STAGE2(bufoff, gbase, voffB[0], voffB[1])
#define PG8_LDA(dst, b, h) do { _Pragma("unroll") for (int m = 0; m < 4; ++m) _Pragma("unroll") for (int k = 0; k < 2; ++k) dst[m][k] = *(const LAS bf16x8*)(lds + PG8_SA(b, h) + aoff + m * 2048 + k * 1024); } while (0)
#define PG8_LDB(dst, b, h) do { _Pragma("unroll") for (int n = 0; n < 2; ++n) _Pragma("unroll") for (int k = 0; k < 2; ++k) dst[n][k] = *(const LAS bf16x8*)(lds + PG8_SB(b, h) + boff + n * 2048 + k * 1024); } while (0)
#define PG8_MMA(ai, bj, At, Bt) do { __builtin_amdgcn_s_setprio(1); _Pragma("unroll") for (int m = 0; m < 4; ++m) _Pragma("unroll") for (int n = 0; n < 2; ++n) _Pragma("unroll") for (int k = 0; k < 2; ++k) \
        acc[ai][bj][m][n] = __builtin_amdgcn_mfma_f32_16x16x32_bf16(Bt[n][k], At[m][k], acc[ai][bj][m][n], 0, 0, 0); __builtin_amdgcn_s_setprio(0); } while (0)
#define PG8_WAIT_V(n) asm volatile("s_waitcnt vmcnt(" #n ")" ::: "memory")
#define PG8_WAIT_L(n) asm volatile("s_waitcnt lgkmcnt(" #n ")" ::: "memory")
#define PG8_BAR __builtin_amdgcn_s_barrier()
#define PG8_SCHED __builtin_amdgcn_sched_barrier(0)
#define PG8_OFFS(u, o0, o1) do { _Pragma("unroll") for (int _i = 0; _i < 2; ++_i) { \
        if (GATHER && (u).rows) { const unsigned r0_ = (unsigned)(u).rows[Rr[_i]], r1_ = (unsigned)(u).rows[Rr[_i] + HALF]; o0[_i] = (r0_ * (unsigned)Kp + (unsigned)Cc[_i]) * 2u; o1[_i] = (r1_ * (unsigned)Kp + (unsigned)Cc[_i]) * 2u; } \
        else { o0[_i] = (unsigned)(Rr[_i] * Kp + Cc[_i]) * 2u; o1[_i] = o0[_i] + (unsigned)hstep; } } } while (0)
    Unit cur, nxt; int ui = 0;
    if (!S.next(0, cur)) return;
    f32x4 acc[2][2][4][2];
#pragma unroll
    for (int a = 0; a < 2; ++a)
#pragma unroll
        for (int b = 0; b < 2; ++b)
#pragma unroll
            for (int m = 0; m < 4; ++m)
#pragma unroll
                for (int n = 0; n < 2; ++n) acc[a][b][m][n] = (f32x4){0.f, 0.f, 0.f, 0.f};
    bf16x8 At[4][2], B0[2][2], B1[2][2];
    unsigned vA0[2], vA1[2], nA0[2], nA1[2];
    PG8_OFFS(cur, vA0, vA1);
    const char* cA = cur.A; const char* cB = cur.B;
    PG8_STAGEB(PG8_SB(0, 0), cB); PG8_STAGEB(PG8_SB(0, 1), cB + hstep); PG8_STAGE2(PG8_SA(0, 0), cA, vA0[0], vA0[1]); PG8_STAGE2(PG8_SA(0, 1), cA, vA1[0], vA1[1]);
    if (wr == 1) PG8_BAR;
    PG8_WAIT_V(2); PG8_BAR;
    PG8_STAGEB(PG8_SB(1, 0), cB + kstep); PG8_STAGE2(PG8_SA(1, 0), cA + kstep, vA0[0], vA0[1]); PG8_STAGEB(PG8_SB(1, 1), cB + hstep + kstep);
    PG8_WAIT_V(6); PG8_BAR;
    for (;;) {
        const bool has_next = S.next(ui + 1, nxt);
        const char* nA = has_next ? nxt.A : cA; const char* nB = has_next ? nxt.B : cB;
        if (GATHER) { if (has_next) { PG8_OFFS(nxt, nA0, nA1); } else {
#pragma unroll
            for (int i = 0; i < 2; ++i) { nA0[i] = vA0[i]; nA1[i] = vA1[i]; } } }
        const int ntu = VARK ? cur.kt : nt;
        for (int t = 0; t < ntu; t += 2) {
            const bool last = (t == ntu - 2);
            const char* a1 = cA + (size_t)(t + 1) * kstep;
            const char* a2 = last ? nA : cA + (size_t)(t + 2) * kstep; const char* b2 = last ? nB : cB + (size_t)(t + 2) * kstep;
            const char* a3 = a2 + kstep; const char* b3 = b2 + kstep;
            unsigned x00 = vA0[0], x01 = vA0[1], x10 = vA1[0], x11 = vA1[1];
            if (GATHER) { if (last) { x00 = nA0[0]; x01 = nA0[1]; x10 = nA1[0]; x11 = nA1[1]; } }
            PG8_LDB(B0, 0, 0); PG8_LDB(B1, 0, 1); PG8_SCHED; PG8_LDA(At, 0, 0); PG8_STAGE2(PG8_SA(1, 1), a1, vA1[0], vA1[1]);
            PG8_WAIT_V(8); PG8_WAIT_L(0); PG8_BAR; PG8_MMA(0, 0, At, B0); PG8_MMA(0, 1, At, B1); PG8_BAR; PG8_SCHED;
            PG8_LDA(At, 0, 1); PG8_STAGEB(PG8_SB(0, 0), b2); PG8_STAGEB(PG8_SB(0, 1), b2 + hstep); PG8_STAGE2(PG8_SA(0, 0), a2, x00, x01);
            PG8_WAIT_V(8); PG8_WAIT_L(0); PG8_BAR; PG8_MMA(1, 0, At, B0); PG8_MMA(1, 1, At, B1); PG8_BAR; PG8_SCHED;
            PG8_LDB(B0, 1, 0); PG8_LDB(B1, 1, 1); PG8_SCHED; PG8_LDA(At, 1, 0); PG8_STAGE2(PG8_SA(0, 1), a2, x10, x11);
            PG8_WAIT_V(8); PG8_WAIT_L(0); PG8_BAR; PG8_MMA(0, 0, At, B0); PG8_MMA(0, 1, At, B1); PG8_BAR; PG8_SCHED;
            PG8_LDA(At, 1, 1); PG8_STAGEB(PG8_SB(1, 0), b3); PG8_STAGEB(PG8_SB(1, 1), b3 + hstep); PG8_STAGE2(PG8_SA(1, 0), a3, x00, x01);
            PG8_WAIT_V(8); PG8_WAIT_L(0); PG8_BAR; PG8_MMA(1, 0, At, B0); PG8_MMA(1, 1, At, B1); PG8_BAR; PG8_SCHED;
        }
        if (wr == 0) PG8_BAR;
        {
            const int row0 = cur.row0 + wr * 64 + fr, colb = cur.col0 + wc * 32 + 8 * fq;
#pragma unroll
            for (int ai = 0; ai < 2; ++ai)
#pragma unroll
                for (int m = 0; m < 4; ++m) { const int row = row0 + ai * HALF + m * 16;
                    if (row >= cur.lo && row < cur.hi) {
                        if constexpr (Epi::ROW16) E.store16(cur, row, colb, acc[ai][0][m][0], acc[ai][0][m][1], acc[ai][1][m][0], acc[ai][1][m][1]);
                        else {
#pragma unroll
                            for (int bj = 0; bj < 2; ++bj) E.store8(cur, row, colb + bj * HALF, acc[ai][bj][m][0], acc[ai][bj][m][1]); } } }
        }
        if (!has_next) break;
#pragma unroll
        for (int a = 0; a < 2; ++a)
#pragma unroll
            for (int b = 0; b < 2; ++b)
#pragma unroll
                for (int m = 0; m < 4; ++m)
#pragma unroll
                    for (int n = 0; n < 2; ++n) acc[a][b][m][n] = (f32x4){0.f, 0.f, 0.f, 0.f};
        cur = nxt; cA = nA; cB = nB; ++ui;
        if (GATHER) {
#pragma unroll
            for (int i = 0; i < 2; ++i) { vA0[i] = nA0[i]; vA1[i] = nA1[i]; } }
        if (wr == 1) PG8_BAR;
    }
    PG8_WAIT_V(0);
    PG8_BAR;
#undef PG8_SA
#undef PG8_SB
#undef PG8_STAGE2
#undef PG8_STAGEB
#undef PG8_LDA
#undef PG8_LDB
#undef PG8_MMA
#undef PG8_WAIT_V
#undef PG8_WAIT_L
#undef PG8_BAR
#undef PG8_SCHED
#undef PG8_OFFS
}
}


template <bool MASK = false, class Epi>
__device__ __forceinline__ void gemm_small_tile(LAS unsigned char* lds, const bf16* A, const bf16* Bt, int K, int row_abs0, int col_abs0, const Unit& u, const Epi& E) {
    const int tid = threadIdx.x, wid = __builtin_amdgcn_readfirstlane(tid >> 6), lane = tid & 63, fr = lane & 15, fq = lane >> 4;
    const int kw = K >> 3, kbeg = wid * kw;
    f32x4 acc[4][2][2];
#pragma unroll
    for (int m = 0; m < 4; ++m)
#pragma unroll
        for (int g = 0; g < 2; ++g)
#pragma unroll
            for (int n = 0; n < 2; ++n) acc[m][g][n] = (f32x4){0.f, 0.f, 0.f, 0.f};
    const bf16* ap = A + (size_t)fr * K + kbeg + 8 * fq;
    const bf16* bp = Bt + (size_t)(8 * (fr >> 2) + (fr & 3)) * K + kbeg + 8 * fq;
#pragma unroll 4
    for (int k0 = 0; k0 < kw; k0 += 32) {
        bf16x8 af[4], bfr[2][2];
#pragma unroll
        for (int m = 0; m < 4; ++m) af[m] = *(const bf16x8*)(ap + (size_t)(16 * m) * K + k0);
#pragma unroll
        for (int g = 0; g < 2; ++g)
#pragma unroll
            for (int n = 0; n < 2; ++n) bfr[g][n] = *(const bf16x8*)(bp + (size_t)(32 * g + 4 * n) * K + k0);
#pragma unroll
        for (int m = 0; m < 4; ++m)
#pragma unroll
            for (int g = 0; g < 2; ++g)
#pragma unroll
                for (int n = 0; n < 2; ++n) acc[m][g][n] = __builtin_amdgcn_mfma_f32_16x16x32_bf16(bfr[g][n], af[m], acc[m][g][n], 0, 0, 0);
    }
    LAS float* P = (LAS float*)lds + wid * 4096;
#pragma unroll
    for (int m = 0; m < 4; ++m)
#pragma unroll
        for (int g = 0; g < 2; ++g)
#pragma unroll
            for (int n = 0; n < 2; ++n) *(LAS f32x4*)(P + (16 * m + fr) * 64 + (((8 * g + 2 * fq + n) ^ fr) << 2)) = acc[m][g][n];
    __syncthreads();
    { const int r = tid >> 3, c8 = (tid & 7) * 8; f32x4 v0 = (f32x4){0.f, 0.f, 0.f, 0.f}, v1 = v0;
#pragma unroll
      for (int w = 0; w < 8; ++w) { const LAS float* q = (const LAS float*)lds + w * 4096 + r * 64; v0 += *(const LAS f32x4*)(q + ((((c8 >> 2)) ^ (r & 15)) << 2)); v1 += *(const LAS f32x4*)(q + ((((c8 >> 2) + 1) ^ (r & 15)) << 2)); }
      if (!MASK || (row_abs0 + r >= u.lo && row_abs0 + r < u.hi)) E.store8(u, row_abs0 + r, col_abs0 + c8, v0, v1); }
    __syncthreads();
}

template <bool GATHER, int KPITCH = 0, bool VARK = false, class Epi, class Sched>
__device__ __forceinline__ void run_gemm(LAS unsigned char* lds, int K, const Sched& S, const Epi& E) {
#if FAST_GEMM
    pg8::gemm_phase<Epi, Sched, GATHER, KPITCH, VARK>(lds, K, S, E);
#else
    gemm_naive<Epi, Sched>(lds, K, S, E);
    __syncthreads();
#endif
}

struct Args { const float* in[N_IN]; float* out; unsigned char* ws; int ph_lo, ph_hi; };
struct Frame { LAS unsigned char* lds; int tid, lane, wave, vcu, G; };

__device__ __forceinline__ void attn_naive(const Frame& F, const bf16* Q, const bf16* Kb, const bf16* Vb, bf16* ON, const float* subln, const float* lamv, bool with_ctx) {
    LAS float* Qs = (LAS float*)F.lds;
    LAS float* Ks = Qs + 16 * 128;
    LAS float* Vs = Ks + 2 * 64 * 65;
    LAS float* Ps = Vs + 64 * 128;
    const int tid = F.tid, qi = tid >> 5, sl = tid & 31;
    const float lam = lamv[0], oscale = lamv[1];
    const int n_lat = NB * NH * (SEQ / 16), n_ctx = with_ctx ? NB * NH * (CTXL / 16) : 0;
    for (int unit = F.vcu; unit < n_lat + n_ctx; unit += F.G) {
        int b, h, t0, nkeys;
        if (unit < n_lat) { b = unit / (NH * (SEQ / 16)); const int r = unit % (NH * (SEQ / 16)); h = r / (SEQ / 16); t0 = CTXL + (r % (SEQ / 16)) * 16; nkeys = TK; }
        else { const int uu = unit - n_lat; b = uu / (NH * (CTXL / 16)); const int r = uu % (NH * (CTXL / 16)); h = r / (CTXL / 16); t0 = (r % (CTXL / 16)) * 16; nkeys = CTXL; }
        __syncthreads();
        for (int idx = tid; idx < 16 * 128; idx += 512) { const int q = idx >> 7, cd = idx & 127, c = cd >> 6, d = cd & 63;
            Qs[idx] = __uint_as_float((unsigned)Q[(size_t)(((b * NH + h) * 2 + c) * TK + t0 + q) * 64 + d] << 16); }
        float o0[4] = {0, 0, 0, 0}, o1[4] = {0, 0, 0, 0}, l0 = 0.f, l1 = 0.f;
        for (int k0 = 0; k0 < nkeys; k0 += 64) {
            __syncthreads();
            for (int idx = tid; idx < 2 * 64 * 64; idx += 512) { const int c = idx >> 12, key = (idx >> 6) & 63, d = idx & 63;
                Ks[(c * 64 + key) * 65 + d] = __uint_as_float((unsigned)Kb[(size_t)(((b * NH + h) * 2 + c) * TK + k0 + key) * 64 + d] << 16); }
            for (int idx = tid; idx < 64 * 128; idx += 512) { const int key = idx >> 7, dv = idx & 127;
                Vs[idx] = __uint_as_float((unsigned)Vb[(size_t)((b * NH + h) * TK + k0 + key) * 128 + dv] << 16); }
            __syncthreads();
#pragma unroll
            for (int c = 0; c < 2; ++c)
#pragma unroll
                for (int kk = 0; kk < 2; ++kk) { const int key = sl + 32 * kk; float s = 0.f;
                    for (int d = 0; d < 64; ++d) s += Qs[qi * 128 + c * 64 + d] * Ks[(c * 64 + key) * 65 + d];
                    Ps[(c * 16 + qi) * 64 + key] = __builtin_amdgcn_exp2f(s); }
            __syncthreads();
            for (int key = 0; key < 64; ++key) { const float p0 = Ps[qi * 64 + key], p1 = Ps[(16 + qi) * 64 + key]; const f32x4 v = *(const LAS f32x4*)(Vs + key * 128 + sl * 4);
                l0 += p0; l1 += p1;
#pragma unroll
                for (int j = 0; j < 4; ++j) { o0[j] += p0 * v[j]; o1[j] += p1 * v[j]; } }
        }
        const float i0 = 1.f / l0, i1 = lam / l1; float o[4], ss = 0.f;
#pragma unroll
        for (int j = 0; j < 4; ++j) { o[j] = o0[j] * i0 - o1[j] * i1; ss += o[j] * o[j]; }
#pragma unroll
        for (int m = 1; m < 32; m <<= 1) ss += __shfl_xor(ss, m);
        const float rinv = rsq_((ss * (1.f / 128.f) + EPS)) * oscale;
        const int t = t0 + qi, row = t >= CTXL ? b * SEQ + (t - CTXL) : RL + b * CTXL + t;
        const f32x4 g = *(const f32x4*)(subln + sl * 4);
        v2u w; w.x = cvt_pk_bf16(o[0] * rinv * g[0], o[1] * rinv * g[1]); w.y = cvt_pk_bf16(o[2] * rinv * g[2], o[3] * rinv * g[3]);
        *(v2u*)(ON + (size_t)row * 1024 + h * 128 + sl * 4) = w;
    }
    __syncthreads();
}


namespace att {
#define SBAR() __builtin_amdgcn_sched_barrier(0)
constexpr int STAGE = 32768, ST_K1 = 8192, ST_V = 16384, OFF_WS = 3 * STAGE;
__device__ __forceinline__ int crow(int r, int hi) { return (r & 3) + 8 * (r >> 2) + 4 * hi; }
__device__ __forceinline__ int v_st(int k, int c) { const int kk = (k & ~0xC) | ((k & 4) << 1) | ((k & 8) >> 1); return ((kk >> 3) * 4 + (c >> 5)) * 512 + ((kk & 7) * 32 + (c & 31)) * 2; }
__device__ __forceinline__ int v_rd_base(int lane) { return ((lane & 3) << 3) | (((lane >> 2) & 3) << 6) | (((lane >> 4) & 1) << 5) | (((lane >> 5) & 1) << 8); }
constexpr int v_rd_off(int d0, int ks, int half) { return d0 * 512 + ks * 4096 + half * 2048; }
template <int OFF> __device__ __forceinline__ s16x4 tr_read(int vb) { s16x4 r; asm volatile("ds_read_b64_tr_b16 %0, %1 offset:%2" : "=&v"(r) : "v"(vb), "i"(OFF) : "memory"); return r; }
template <int D0> __device__ __forceinline__ void pv_one(f32x16& od, int vb, bf16x8 pa0, bf16x8 pa1, bf16x8 pa2, bf16x8 pa3) {
    const s16x4 l0 = tr_read<v_rd_off(D0, 0, 0)>(vb), h0 = tr_read<v_rd_off(D0, 0, 1)>(vb), l1 = tr_read<v_rd_off(D0, 1, 0)>(vb), h1 = tr_read<v_rd_off(D0, 1, 1)>(vb);
    const s16x4 l2 = tr_read<v_rd_off(D0, 2, 0)>(vb), h2 = tr_read<v_rd_off(D0, 2, 1)>(vb), l3 = tr_read<v_rd_off(D0, 3, 0)>(vb), h3 = tr_read<v_rd_off(D0, 3, 1)>(vb);
    asm volatile("s_waitcnt lgkmcnt(0)" ::: "memory"); SBAR();
#define ATT_PK(L, H) (bf16x8){L[0], L[1], L[2], L[3], H[0], H[1], H[2], H[3]}
    od = __builtin_amdgcn_mfma_f32_32x32x16_bf16(pa0, ATT_PK(l0, h0), od, 0, 0, 0);
    od = __builtin_amdgcn_mfma_f32_32x32x16_bf16(pa1, ATT_PK(l1, h1), od, 0, 0, 0);
    od = __builtin_amdgcn_mfma_f32_32x32x16_bf16(pa2, ATT_PK(l2, h2), od, 0, 0, 0);
    od = __builtin_amdgcn_mfma_f32_32x32x16_bf16(pa3, ATT_PK(l3, h3), od, 0, 0, 0);
#undef ATT_PK
}
template <int VAR> __device__ __forceinline__ void pv_d0(f32x16 (&o)[4], int vb, bf16x8 pa0, bf16x8 pa1, bf16x8 pa2, bf16x8 pa3) {
    if (VAR == 2) { asm volatile("" :: "v"(pa0), "v"(pa1), "v"(pa2), "v"(pa3)); return; }
    pv_one<0>(o[0], vb, pa0, pa1, pa2, pa3); pv_one<1>(o[1], vb, pa0, pa1, pa2, pa3); pv_one<2>(o[2], vb, pa0, pa1, pa2, pa3); pv_one<3>(o[3], vb, pa0, pa1, pa2, pa3);
}
#define ATT_PK4(P, BASE, OUT) do { unsigned a0 = cvt_pk_bf16(P[BASE + 0], P[BASE + 1]), a1 = cvt_pk_bf16(P[BASE + 2], P[BASE + 3]); \
    unsigned b0 = cvt_pk_bf16(P[BASE + 4], P[BASE + 5]), b1 = cvt_pk_bf16(P[BASE + 6], P[BASE + 7]); \
    auto r0 = __builtin_amdgcn_permlane32_swap(a0, b0, false, false); auto r1 = __builtin_amdgcn_permlane32_swap(a1, b1, false, false); \
    v4u w = {r0[0], r1[0], r0[1], r1[1]}; OUT = *reinterpret_cast<bf16x8*>(&w); } while (0)
template <int VAR> __device__ __forceinline__ void half_a(f32x16& p, float& ps, bf16x8& pa0, bf16x8& pa1) {
    if (VAR != 1) {
#pragma unroll
    for (int r = 0; r < 16; ++r) p[r] = __builtin_amdgcn_exp2f(p[r]); }
    float s = 0.f;
#pragma unroll
    for (int r = 0; r < 16; ++r) s += p[r];
    ps = s;
    ATT_PK4(p, 0, pa0); ATT_PK4(p, 8, pa1);
}
template <int VAR> __device__ __forceinline__ void half_b(f32x16& p, float ps, float& l_reg, bf16x8& pa2, bf16x8& pa3) {
    if (VAR != 1) {
#pragma unroll
    for (int r = 0; r < 16; ++r) p[r] = __builtin_amdgcn_exp2f(p[r]); }
#pragma unroll
    for (int r = 0; r < 16; ++r) ps += p[r];
    { auto rr = __builtin_amdgcn_permlane32_swap(__float_as_uint(ps), __float_as_uint(ps), false, false); ps = __uint_as_float(rr[0]) + __uint_as_float(rr[1]); }
    l_reg += ps;
    ATT_PK4(p, 0, pa2); ATT_PK4(p, 8, pa3);
}
__device__ __forceinline__ void qkt(f32x16& p0, f32x16& p1, const LAS unsigned char* Ks, const bf16x8 (&qr)[4], int r32, int hi) {
    p0 = f32x16{}; p1 = f32x16{};
    const int swz = (r32 >> 1) & 7;
#pragma unroll
    for (int d0 = 0; d0 < 4; ++d0) { const int off = r32 * 128 + (((d0 * 2 + hi) ^ swz) << 4);
        const bf16x8 b0 = *(const LAS bf16x8*)(Ks + off), b1 = *(const LAS bf16x8*)(Ks + 4096 + off);
        p0 = __builtin_amdgcn_mfma_f32_32x32x16_bf16(b0, qr[d0], p0, 0, 0, 0);
        p1 = __builtin_amdgcn_mfma_f32_32x32x16_bf16(b1, qr[d0], p1, 0, 0, 0); }
}
}

template <int VAR>
__device__ __forceinline__ void attn_fast(const Frame& F, const bf16* Q, const bf16* Kb, const bf16* Vb, bf16* ON, const float* subln, const float* lamv, bool with_ctx) {
    using namespace att;
    LAS unsigned char* lds = F.lds;
    const int tid = F.tid, wid = F.wave, lane = F.lane, r32 = lane & 31, hi = lane >> 5, comp = wid >> 2, wq = wid & 3;
    LAS float* li_l = (LAS float*)(lds + OFF_WS) + wid * 64;
    const int sr = tid >> 4, sc = (tid & 15) * 8, vst0 = v_st(sr, sc);
    const int krow = tid >> 3, kst = krow * 128 + (((tid & 7) ^ ((krow >> 1) & 7)) << 4);
    const int vb0 = (int)(uintptr_t)(lds + ST_V) + v_rd_base(lane);
    const unsigned koffb = (unsigned)tid * 16u, voffb = (unsigned)(sr * 128 + sc) * 2u;
    const LAS unsigned char* Kl = lds + comp * ST_K1;
    const float lam = __builtin_bit_cast(float, __builtin_amdgcn_readfirstlane(__builtin_bit_cast(int, lamv[0]))), oscale = __builtin_bit_cast(float, __builtin_amdgcn_readfirstlane(__builtin_bit_cast(int, lamv[1])));
    const int n_lat = NB * NH * (SEQ / 128), n_ctx = with_ctx ? NB * NH * (CTXL / 128) : 0;
    for (int unit = F.vcu; unit < n_lat + n_ctx; unit += F.G) {
        int b, h, t0, NT;
        if (unit < n_lat) { const int bh = unit >> 5; b = bh >> 3; h = bh & 7; t0 = CTXL + (unit & 31) * 128; NT = TK / 64; }
        else { const int uu = unit - n_lat, bh = uu >> 1; b = bh >> 3; h = bh & 7; t0 = (uu & 1) * 128; NT = CTXL / 64; }
        const char* K0u = (const char*)(Kb + (size_t)((b * NH + h) * 2) * TK * 64); const char* K1u = K0u + (size_t)TK * 128;
        const char* V0u = (const char*)(Vb + (size_t)(b * NH + h) * TK * 128); const char* V1u = V0u + 32 * 256;
        bf16x8 qr[4];
        { const bf16* Qw = Q + ((size_t)((b * NH + h) * 2 + comp) * TK + t0 + wq * 32 + r32) * 64 + hi * 8;
#pragma unroll
          for (int d0 = 0; d0 < 4; ++d0) qr[d0] = *(const bf16x8*)(Qw + d0 * 16); }
        float l_reg = 0.f; f32x16 o[4] = {};
        struct { bf16x8 vs0, vs1, ks0, ks1; } st_[2];
#define ATT_SLOAD(i, k0) do { st_[i].vs0 = *(const bf16x8*)(V0u + (size_t)(k0) * 256 + voffb); st_[i].vs1 = *(const bf16x8*)(V1u + (size_t)(k0) * 256 + voffb); \
        st_[i].ks0 = *(const bf16x8*)(K0u + (size_t)(k0) * 128 + koffb); st_[i].ks1 = *(const bf16x8*)(K1u + (size_t)(k0) * 128 + koffb); } while (0)
#define ATT_SWRITE(so, i) do { *(LAS bf16x8*)(lds + (so) + ST_V + vst0) = st_[i].vs0; *(LAS bf16x8*)(lds + (so) + ST_V + 8192 + vst0) = st_[i].vs1; \
        *(LAS bf16x8*)(lds + (so) + kst) = st_[i].ks0; *(LAS bf16x8*)(lds + (so) + ST_K1 + kst) = st_[i].ks1; } while (0)
        f32x16 pA0, pA1, pB0, pB1; bf16x8 pa0, pa1, pa2, pa3; float ps;
#define ATT_ITER(c0, c1, n0, n1, WS, LS) do { \
        SBAR(); qkt(n0, n1, Kl + sN, qr, r32, hi); half_b<VAR>(c1, ps, l_reg, pa2, pa3); SBAR(); \
        if (j + 3 < NT) ATT_SLOAD(LS, (j + 3) * 64); SBAR(); \
        pv_d0<VAR>(o, vb0 + sC, pa0, pa1, pa2, pa3); half_a<VAR>(n0, ps, pa0, pa1); \
        if (j + 2 < NT) { if (j + 3 < NT) asm volatile("s_waitcnt vmcnt(4)" ::: "memory"); else asm volatile("s_waitcnt vmcnt(0)" ::: "memory"); ATT_SWRITE(sW, WS); } \
        __syncthreads(); { const int t_ = sC; sC = sN; sN = sW; sW = t_; } ++j; } while (0)
        int sC = 0, sN = STAGE, sW = 2 * STAGE, j = 0;
        ATT_SLOAD(0, 0); ATT_SLOAD(1, 64); asm volatile("s_waitcnt vmcnt(0)" ::: "memory"); ATT_SWRITE(0, 0); ATT_SWRITE(STAGE, 1);
        ATT_SLOAD(0, 128); __syncthreads();
        qkt(pA0, pA1, Kl, qr, r32, hi); half_a<VAR>(pA0, ps, pa0, pa1);
        while (j + 2 < NT) {
            ATT_ITER(pA0, pA1, pB0, pB1, 0, 1);
            ATT_ITER(pB0, pB1, pA0, pA1, 1, 0);
        }
        ATT_ITER(pA0, pA1, pB0, pB1, 0, 1);
        half_b<VAR>(pB1, ps, l_reg, pa2, pa3); SBAR();
        pv_d0<VAR>(o, vb0 + sC, pa0, pa1, pa2, pa3);
#undef ATT_ITER
#undef ATT_SLOAD
#undef ATT_SWRITE
        if (hi == 0) li_l[r32] = l_reg;
        __syncthreads();
        float rli[16];
#pragma unroll
        for (int r = 0; r < 16; ++r) rli[r] = __builtin_amdgcn_rcpf(li_l[crow(r, hi)]);
        LAS float* X = (LAS float*)lds;
        if (comp == 1) {
#pragma unroll
            for (int r = 0; r < 16; ++r) { const int row = wq * 32 + crow(r, hi); const float sc1 = rli[r] * lam;
#pragma unroll
                for (int d0 = 0; d0 < 4; ++d0) X[row * 128 + d0 * 32 + r32] = o[d0][r] * sc1; }
        }
        __syncthreads();
        if (comp == 0) {
            float ss[16];
#pragma unroll
            for (int r = 0; r < 16; ++r) { const int row = wq * 32 + crow(r, hi); float s = 0.f;
#pragma unroll
                for (int d0 = 0; d0 < 4; ++d0) { const float v = o[d0][r] * rli[r] - X[row * 128 + d0 * 32 + r32]; o[d0][r] = v; s += v * v; }
                ss[r] = s; }
#pragma unroll
            for (int r = 0; r < 16; ++r) {
#pragma unroll
                for (int m = 1; m < 32; m <<= 1) ss[r] += __shfl_xor(ss[r], m); }
            float g[4];
#pragma unroll
            for (int d0 = 0; d0 < 4; ++d0) g[d0] = subln[d0 * 32 + r32] * oscale;
#pragma unroll
            for (int r = 0; r < 16; ++r) { const float rinv = rsq_((ss[r] * (1.f / 128.f) + EPS));
                const int t = t0 + wq * 32 + crow(r, hi), row = t >= CTXL ? b * SEQ + (t - CTXL) : RL + b * CTXL + t;
                bf16* op = ON + (size_t)row * 1024 + h * 128 + r32;
#pragma unroll
                for (int d0 = 0; d0 < 4; ++d0) if (VAR == 0 || lam == 12345.f) op[d0 * 32] = (bf16)(cvt_pk_bf16(o[d0][r] * rinv * g[d0], 0.f) & 0xffffu); }
        }
        __syncthreads();
    }
}


namespace a16 {
__device__ __forceinline__ int off_a(int row, int ch) { return 2048 * (row >> 3) + 512 * (ch >> 2) + 64 * (row & 7) + 16 * ((ch & 3) ^ ((row >> 2) & 3)); }
__device__ __forceinline__ int fK(int key) { return ((key >> 1) & 1) | (((key >> 3) & 1) << 1) | (((key >> 4) & 1) << 2); }
__device__ __forceinline__ void qkt16(f32x4 (&S)[2][2][2], const LAS unsigned char* Kt, int kb0, int kb1, const bf16x8 (&qf)[2][2]) {
#pragma unroll
    for (int ks2 = 0; ks2 < 2; ++ks2) {
        if (ks2) SBAR();
#pragma unroll
        for (int u = 0; u < 2; ++u) {
            const bf16x8 k0 = *(const LAS bf16x8*)(Kt + kb0 + 4096 * ks2 + 512 * u), k1 = *(const LAS bf16x8*)(Kt + kb1 + 4096 * ks2 + 512 * u);
#pragma unroll
            for (int qb = 0; qb < 2; ++qb) { f32x4 acc = (f32x4){0.f, 0.f, 0.f, 0.f};
                acc = __builtin_amdgcn_mfma_f32_16x16x32_bf16(k0, qf[qb][0], acc, 0, 0, 0); S[ks2][u][qb] = __builtin_amdgcn_mfma_f32_16x16x32_bf16(k1, qf[qb][1], acc, 0, 0, 0); }
        }
    }
}
template <bool SUMS = true> __device__ __forceinline__ void half16(f32x4 (&Sh)[2][2], float (&ls)[2], bf16x8 (&pf)[2]) {
#pragma unroll
    for (int qb = 0; qb < 2; ++qb) {
#pragma unroll
        for (int u = 0; u < 2; ++u)
#pragma unroll
            for (int r = 0; r < 4; ++r) Sh[u][qb][r] = __builtin_amdgcn_exp2f(Sh[u][qb][r]);
        if (SUMS) ls[qb] += ((Sh[0][qb][0] + Sh[0][qb][1]) + (Sh[0][qb][2] + Sh[0][qb][3])) + ((Sh[1][qb][0] + Sh[1][qb][1]) + (Sh[1][qb][2] + Sh[1][qb][3]));
        v4u w; w.x = cvt_pk_bf16(Sh[0][qb][0], Sh[0][qb][1]); w.y = cvt_pk_bf16(Sh[0][qb][2], Sh[0][qb][3]); w.z = cvt_pk_bf16(Sh[1][qb][0], Sh[1][qb][1]); w.w = cvt_pk_bf16(Sh[1][qb][2], Sh[1][qb][3]);
        pf[qb] = *reinterpret_cast<bf16x8*>(&w); }
}
template <int CP, bool PVSYNC = false> __device__ __forceinline__ void pv16(f32x4 (&O)[8][2], int vb00, int vb01, int vb10, int vb11, const bf16x8 (&pf)[2][2]) {
#define tr_read16(OFF, vb) __builtin_amdgcn_ds_read_tr16_b64_v4i16((LAS s16x4*)((LAS unsigned char*)(uintptr_t)(unsigned)(vb) + (OFF)))
    const s16x4 a0 = tr_read16(512 * CP, vb00), a1 = tr_read16(512 * CP, vb01), a2 = tr_read16(8192 + 512 * CP, vb00), a3 = tr_read16(8192 + 512 * CP, vb01);
    const s16x4 b0 = tr_read16(512 * CP, vb10), b1 = tr_read16(512 * CP, vb11), b2 = tr_read16(8192 + 512 * CP, vb10), b3 = tr_read16(8192 + 512 * CP, vb11);
    if (PVSYNC) { asm volatile("s_waitcnt lgkmcnt(0)" ::: "memory"); SBAR(); }
#define A16_PK(L, H) (bf16x8){L[0], L[1], L[2], L[3], H[0], H[1], H[2], H[3]}
    const bf16x8 ve0 = A16_PK(a0, a1), ve1 = A16_PK(a2, a3), vo0 = A16_PK(b0, b1), vo1 = A16_PK(b2, b3);
#pragma unroll
    for (int qb = 0; qb < 2; ++qb) {
        O[2 * CP][qb] = __builtin_amdgcn_mfma_f32_16x16x32_bf16(ve0, pf[0][qb], O[2 * CP][qb], 0, 0, 0);
        O[2 * CP + 1][qb] = __builtin_amdgcn_mfma_f32_16x16x32_bf16(vo0, pf[0][qb], O[2 * CP + 1][qb], 0, 0, 0);
        O[2 * CP][qb] = __builtin_amdgcn_mfma_f32_16x16x32_bf16(ve1, pf[1][qb], O[2 * CP][qb], 0, 0, 0);
        O[2 * CP + 1][qb] = __builtin_amdgcn_mfma_f32_16x16x32_bf16(vo1, pf[1][qb], O[2 * CP + 1][qb], 0, 0, 0); }
#undef A16_PK
#undef tr_read16
}
}

__device__ __forceinline__ void attn16(const Frame& F, const bf16* Q, const bf16* Kb, const bf16* Vb, bf16* ON, const float* subln, const float* lamv, bool with_ctx, unsigned long long* stamp = nullptr) {
    using namespace att; using namespace a16;
    LAS unsigned char* lds = F.lds;
    const int tid = F.tid, wid = F.wave, lane = F.lane, l15 = lane & 15, g = lane >> 4, comp = wid >> 2, wq = wid & 3;
    const int vrl = 8 * (tid >> 7) + ((tid >> 2) & 7);
    const unsigned ksrc = (unsigned)((tid >> 3) * 128 + (((tid & 7) ^ fK(tid >> 3)) << 4));
    const unsigned vsrc = (unsigned)(vrl * 256 + (((((tid >> 5) & 3) << 2) | ((tid & 3) ^ ((vrl >> 2) & 3))) << 4));
    const unsigned ldsw = (unsigned)__builtin_amdgcn_readfirstlane(wid) * 1024u;
    const int ki = 8 * (l15 >> 2) + (l15 & 3), kf = fK(ki);
    const int kb0 = ki * 128 + (((0 + g) ^ kf) << 4), kb1 = ki * 128 + (((4 + g) ^ kf) << 4);
    const int tq = l15 >> 2, tp = lane & 3;
    const int vr0 = (int)(uintptr_t)(lds + ST_V);
    int v00 = vr0 + off_a(8 * g + tq, 0 + (tp >> 1)) + 8 * (tp & 1), v01 = vr0 + off_a(8 * g + 4 + tq, 0 + (tp >> 1)) + 8 * (tp & 1);
    int v10 = vr0 + off_a(8 * g + tq, 2 + (tp >> 1)) + 8 * (tp & 1), v11 = vr0 + off_a(8 * g + 4 + tq, 2 + (tp >> 1)) + 8 * (tp & 1);
    const LAS unsigned char* Kl = lds + comp * ST_K1;
    const float lam = __builtin_bit_cast(float, __builtin_amdgcn_readfirstlane(__builtin_bit_cast(int, lamv[0]))), oscale = __builtin_bit_cast(float, __builtin_amdgcn_readfirstlane(__builtin_bit_cast(int, lamv[1])));
    const int n_lat = NB * NH * (SEQ / 128), n_ctx = with_ctx ? NB * NH * (CTXL / 128) : 0;
#ifdef PROBE_STAMP
    unsigned long long st_t0 = 0, st_r0 = 0, st_it = 0;
    if (stamp) { st_t0 = __builtin_amdgcn_s_memtime(); st_r0 = __builtin_amdgcn_s_memrealtime(); }
#endif
    bf16x8 ones; { const short o1 = 0x3F80; ones = (bf16x8){o1, o1, o1, o1, o1, o1, o1, o1}; asm volatile("" : "+v"(ones)); }
    const int n_units = n_lat + n_ctx;
    int unit = F.vcu;
    if (unit >= n_units) return;
    int b, h, t0, NT; const char *K0u, *K1u, *V0u, *V1u; bf16x8 qf[2][2];
#define A16_DECODE(U) do { if ((U) < n_lat) { const int bh = (U) >> 5; b = bh >> 3; h = bh & 7; t0 = CTXL + ((U) & 31) * 128; NT = TK / 64; } \
        else { const int uu = (U) - n_lat, bh = uu >> 1; b = bh >> 3; h = bh & 7; t0 = (uu & 1) * 128; NT = CTXL / 64; } \
        K0u = (const char*)(Kb + (size_t)((b * NH + h) * 2) * TK * 64); K1u = K0u + (size_t)TK * 128; V0u = (const char*)(Vb + (size_t)(b * NH + h) * TK * 128); V1u = V0u + 32 * 256; } while (0)
#define A16_DMA1(gp, voff, ldsa) asm volatile("s_mov_b32 m0, %2\n\ts_nop 0\n\tglobal_load_lds_dwordx4 %0, %1" :: "v"(voff), "s"(gp), "s"(ldsa) : "memory", "m0")
#define A16_DMA(so, k0) do { const unsigned la_ = (unsigned)(uintptr_t)(lds + (so)) + ldsw; \
        A16_DMA1(K0u + (size_t)(k0) * 128, ksrc, la_); A16_DMA1(K1u + (size_t)(k0) * 128, ksrc, la_ + ST_K1); \
        A16_DMA1(V0u + (size_t)(k0) * 256, vsrc, la_ + ST_V); A16_DMA1(V1u + (size_t)(k0) * 256, vsrc, la_ + ST_V + 8192); } while (0)
#define A16_LOADQ() do { const bf16* Qw = Q + ((size_t)((b * NH + h) * 2 + comp) * TK + t0 + wq * 32 + l15) * 64 + 8 * g; \
        _Pragma("unroll") for (int qb = 0; qb < 2; ++qb) _Pragma("unroll") for (int sdim = 0; sdim < 2; ++sdim) qf[qb][sdim] = *(const bf16x8*)(Qw + (size_t)qb * 16 * 64 + 32 * sdim); } while (0)
    int c0 = 0, n0 = STAGE, w0 = 2 * STAGE;
    A16_DECODE(unit); A16_DMA(0, 0); A16_DMA(STAGE, 64); A16_LOADQ();
    asm volatile("s_waitcnt vmcnt(0)" ::: "memory"); __syncthreads();
    for (;;) {
#ifdef PROBE_STAMP
        st_it += NT;
#endif
        f32x4 O[8][2];
#pragma unroll
        for (int c = 0; c < 8; ++c) { O[c][0] = (f32x4){0.f, 0.f, 0.f, 0.f}; O[c][1] = (f32x4){0.f, 0.f, 0.f, 0.f}; }
        float ls[2] = {0.f, 0.f};
        f32x4 LS[2] = {(f32x4){0.f, 0.f, 0.f, 0.f}, (f32x4){0.f, 0.f, 0.f, 0.f}};
#define A16_LSUM() do { _Pragma("unroll") for (int qb_ = 0; qb_ < 2; ++qb_) { LS[qb_] = __builtin_amdgcn_mfma_f32_16x16x32_bf16(ones, pf[0][qb_], LS[qb_], 0, 0, 0); LS[qb_] = __builtin_amdgcn_mfma_f32_16x16x32_bf16(ones, pf[1][qb_], LS[qb_], 0, 0, 0); } } while (0)
        f32x4 SA[2][2][2], SB[2][2][2]; bf16x8 pf[2][2], pf2[2];
#define A16_ITER(SC, SNX) do { \
        if (j + 2 < NT) A16_DMA(sW, (j + 2) * 64); \
        SBAR(); qkt16(SNX, Kl + sN, kb0, kb1, qf); half16<false>(SC[1], ls, pf[1]); SBAR(); \
        asm volatile("" : "+v"(SNX[0][0][0]), "+v"(SNX[0][0][1]), "+v"(SNX[0][1][0]), "+v"(SNX[0][1][1]));     \
        pv16<0>(O, v00, v01, v10, v11, pf); pv16<1>(O, v00, v01, v10, v11, pf); A16_LSUM(); \
        pv16<2>(O, v00, v01, v10, v11, pf); pv16<3>(O, v00, v01, v10, v11, pf); \
        half16<false>(SNX[0], ls, pf2); pf[0][0] = pf2[0]; pf[0][1] = pf2[1]; \
        asm volatile("s_waitcnt vmcnt(0)" ::: "memory"); \
        __syncthreads(); { const int d_ = sN - sC; v00 += d_; v01 += d_; v10 += d_; v11 += d_; const int t_ = sC; sC = sN; sN = sW; sW = t_; } ++j; } while (0)
        int sC = c0, sN = n0, sW = w0, j = 0;
        qkt16(SA, Kl + sC, kb0, kb1, qf); half16<false>(SA[0], ls, pf[0]);
        while (j + 2 < NT) { A16_ITER(SA, SB); A16_ITER(SB, SA); }
        const int eb = b, eh = h, et0 = t0;
        const int nunit = unit + F.G; const bool has_next = nunit < n_units;
        if (has_next) A16_DECODE(nunit);
        NT = 0;
        if (has_next) A16_DMA(sW, 0);
        A16_ITER(SA, SB);
        if (has_next) { A16_DMA(sW, 64); A16_LOADQ(); }
        if (has_next) { int nt_; if (nunit < n_lat) nt_ = TK / 64; else nt_ = CTXL / 64; NT = nt_; }
        half16<false>(SB[1], ls, pf[1]); SBAR();
        pv16<0>(O, v00, v01, v10, v11, pf); pv16<1>(O, v00, v01, v10, v11, pf); A16_LSUM();
        pv16<2>(O, v00, v01, v10, v11, pf); pv16<3>(O, v00, v01, v10, v11, pf);
        { const int d_ = sN - sC; v00 += d_; v01 += d_; v10 += d_; v11 += d_; }
        c0 = sN; n0 = sW; w0 = sC;
#undef A16_ITER
#undef A16_LSUM
#pragma unroll
        for (int qb = 0; qb < 2; ++qb) ls[qb] = LS[qb][0];
        __syncthreads();
        LAS float* XE0 = (LAS float*)(lds + w0); LAS float* XE1 = (LAS float*)(lds + 98304); LAS float* SQ = (LAS float*)(lds + MOETAB_OFF);
        const float scl = comp == 0 ? __builtin_amdgcn_rcpf(ls[0]) : lam * __builtin_amdgcn_rcpf(ls[0]), sch = comp == 0 ? __builtin_amdgcn_rcpf(ls[1]) : lam * __builtin_amdgcn_rcpf(ls[1]);
#pragma unroll
        for (int c = 0; c < 8; ++c) { O[c][0] *= scl; O[c][1] *= sch; }
#pragma unroll
        for (int qb = 0; qb < 2; ++qb) { LAS float* xw = (comp == 0 ? XE0 : XE1) + (wq * 32 + qb * 16 + l15) * 64;
#pragma unroll
            for (int cc = 0; cc < 4; ++cc) *(LAS f32x4*)(xw + (((4 * cc + g) ^ l15) << 2)) = O[comp == 0 ? 4 + cc : cc][qb]; }
        __syncthreads();
        float sqp[2];
#pragma unroll
        for (int qb = 0; qb < 2; ++qb) { const LAS float* xr = (comp == 0 ? XE1 : XE0) + (wq * 32 + qb * 16 + l15) * 64; float sq = 0.f;
#pragma unroll
            for (int cc = 0; cc < 4; ++cc) { const f32x4 x = *(const LAS f32x4*)(xr + (((4 * cc + g) ^ l15) << 2)); const int c = comp == 0 ? cc : 4 + cc;
                const f32x4 v = comp == 0 ? O[c][qb] - x : x - O[c][qb]; O[c][qb] = v; sq += (v[0] * v[0] + v[1] * v[1]) + (v[2] * v[2] + v[3] * v[3]); }
            sq += __shfl_xor(sq, 16); sq += __shfl_xor(sq, 32); sqp[qb] = sq;
            if (g == 0) SQ[comp * 128 + wq * 32 + qb * 16 + l15] = sq; }
        asm volatile("s_waitcnt vmcnt(0)" ::: "memory");
        __syncthreads();
#pragma unroll
        for (int qb = 0; qb < 2; ++qb) { const int rl = wq * 32 + qb * 16 + l15; const float sq = SQ[rl] + SQ[128 + rl];
            const float rinv = rsq_((sq * (1.f / 128.f) + EPS)) * oscale;
            const int t = et0 + rl, row = t >= CTXL ? eb * SEQ + (t - CTXL) : RL + eb * CTXL + t;
            bf16* op = ON + (size_t)row * 1024 + eh * 128 + 64 * comp + 8 * g;
#pragma unroll
            for (int pp = 0; pp < 2; ++pp) { const int c = (comp == 0 ? 0 : 4) + 2 * pp; const float* gp = subln + 64 * comp + 32 * pp + 8 * g;
                const f32x4 y0 = O[c][qb] * rinv * *(const f32x4*)gp, y1 = O[c + 1][qb] * rinv * *(const f32x4*)(gp + 4);
                *(v4u*)(op + 32 * pp) = pack8(y0, y1); } }
        if (!has_next) break;
        unit = nunit;
    }
    __syncthreads();
#undef A16_DECODE
#undef A16_LOADQ
#undef A16_DMA
#undef A16_DMA1
#ifdef PROBE_STAMP
    if (stamp) { const unsigned long long t1 = __builtin_amdgcn_s_memtime(), r1 = __builtin_amdgcn_s_memrealtime(); if (tid == 0) { stamp[0] = t1 - st_t0; stamp[1] = r1 - st_r0; stamp[2] = st_it; } }
#endif
}

__device__ __forceinline__ void cvt_item(const float* s0, const float* s1, int srcN, int mode, int K, int N, bf16* dst, int item, LAS float* scr, int lane) {
    const int nblk = N / 64, kb = item / nblk, nb = item % nblk, k0 = 64 * kb, n0 = 64 * nb;
    const int v = n0 + lane; const float* sp = s0; int c = v;
    const int m1_tile = nb >> 2, m1_wc = nb & 3;
    if (mode == 1) { const int kind = (lane >> 2) & 1; sp = kind ? s1 : s0; c = m1_tile * 128 + m1_wc * 32 + ((lane >> 3) & 3) * 8 + (lane >> 5) * 4 + (lane & 3); }
    const bool glu = mode == 2 && n0 >= 3072 && n0 < 5120;
    if (glu) { const int kind = (lane >> 2) & 1; c = 3072 + kind * 1024 + (m1_tile - 12) * 128 + m1_wc * 32 + ((lane >> 3) & 3) * 8 + (lane >> 5) * 4 + (lane & 3); }
    else if (mode == 2) { if (v < 2048) c = qk_src_col(v);
        else if (v < 3072) { const int q = v & 127, cb_ = q >> 4, i = q & 15; c = (v & ~127) + 32 * (cb_ >> 1) + 8 * (i >> 2) + 4 * (cb_ & 1) + (i & 3); } }
    sp += (size_t)k0 * srcN + c;
#pragma unroll 16
    for (int kk = 0; kk < 64; ++kk) scr[kk * 64 + (lane ^ (((kk >> 3) & 7) << 2))] = sp[(size_t)kk * srcN];
    LDS_WAIT(); asm volatile("" ::: "memory");
    const int c8 = lane & 7, sw = c8 << 2;
#pragma unroll
    for (int j = 0; j < 8; ++j) { const int n = (lane >> 3) + 8 * j; const LAS float* q = scr + (8 * c8) * 64 + (n ^ sw);
        v4u o; o.x = cvt_pk_bf16(q[0 * 64], q[1 * 64]); o.y = cvt_pk_bf16(q[2 * 64], q[3 * 64]); o.z = cvt_pk_bf16(q[4 * 64], q[5 * 64]); o.w = cvt_pk_bf16(q[6 * 64], q[7 * 64]);
        const int vrow = (mode == 1 || glu) ? m1_tile * 256 + (n >> 5) * 128 + m1_wc * 32 + (n & 31) : n0 + n;
        *(v4u*)(dst + (size_t)vrow * K + k0 + 8 * c8) = o; }
    LDS_WAIT(); asm volatile("" ::: "memory");
}

__device__ __forceinline__ void phase_prologue(const Frame& F, const Args& a) {
    unsigned char* ws = a.ws;
    {
        LAS float* sv = (LAS float*)F.lds; LAS float* part = sv + 5 * 1024;
        for (int idx = F.tid; idx < 5 * 1024; idx += 512) { const int v = idx >> 10, k = idx & 1023; const float x = v < 4 ? a.in[I_C][v * 1024 + k] : a.in[I_CCTX][k]; sv[idx] = x * sigm(x); }
        __syncthreads();
        float* MOD = (float*)(ws + WS_MOD);
        for (int unit = F.vcu; unit < 192; unit += F.G) {
            const int l = unit / 96, n0 = (unit % 96) * 64; const float* W = a.in[I_WMOD] + (size_t)l * 1024 * 6144 + n0 + F.lane;
            float acc[5] = {0, 0, 0, 0, 0};
#pragma unroll 16
            for (int k = F.wave * 128; k < F.wave * 128 + 128; ++k) { const float wv = W[(size_t)k * 6144];
#pragma unroll
                for (int v = 0; v < 5; ++v) acc[v] += sv[v * 1024 + k] * wv; }
#pragma unroll
            for (int v = 0; v < 5; ++v) part[(F.wave * 5 + v) * 64 + F.lane] = acc[v];
            __syncthreads();
            if (F.tid < 320) { const int v = F.tid >> 6, ln = F.tid & 63; float s = a.in[I_BMOD][l * 6144 + n0 + ln];
#pragma unroll
                for (int w = 0; w < 8; ++w) s += part[(w * 5 + v) * 64 + ln];
                MOD[(size_t)(l * 5 + v) * 6144 + n0 + ln] = s; }
            __syncthreads();
        }
    }
    if (F.vcu == F.G - 1) {
        float* ROPE = (float*)(ws + WS_ROPE); float* LAMV = (float*)(ws + WS_LAM);
        for (int idx = F.tid; idx < 1024; idx += 512) { const int pos = idx >> 4, i = idx & 15; const float inv = __builtin_amdgcn_exp2f(-(float)(2 * i) * (13.287712379549449f / 32.f)), ang = (float)pos * inv; const float kq = rintf(ang * 0.15915494309189535f); float rr = fmaf(-kq, 6.2831854820251465f, ang); rr = fmaf(-kq, -1.7484555e-7f, rr); ROPE[idx] = __cosf(rr); ROPE[1024 + idx] = __sinf(rr); }
        if (F.tid < 2) { const int l = F.tid; float s1 = 0.f, s2 = 0.f;
            for (int d = 0; d < 64; ++d) { s1 += a.in[I_LQ1][l * 64 + d] * a.in[I_LK1][l * 64 + d]; s2 += a.in[I_LQ2][l * 64 + d] * a.in[I_LK2][l * 64 + d]; }
            const float lam_init = l == 0 ? 0.2f : 0.35550906759f; LAMV[l * 2 + 0] = __expf(s1) - __expf(s2) + lam_init; LAMV[l * 2 + 1] = 1.f - lam_init; }
    }
    {
        LAS float* scr = (LAS float*)(F.lds + F.wave * 16384);
        const int gw = F.vcu * 8 + F.wave, NGW = F.G * 8;
        constexpr int I_IN = 16 * 112, I_SQ = 16 * 16, I_GU0 = 16 * 88, I_D0 = 44 * 16, I_EGU = 16 * 112, I_ED = 56 * 16;
        constexpr int NITEMS = 2 * I_IN + 6 * I_SQ + I_GU0 + I_D0 + 8 * I_EGU + 8 * I_ED;
        for (int it = gw; it < NITEMS; it += NGW) {
            int r = it;
            if (r < 2 * I_IN) { const int l = r / I_IN; cvt_item(a.in[I_WIN] + (size_t)l * 1024 * INW, nullptr, INW, 2, 1024, INW, (bf16*)(ws + WS_WIN) + (size_t)l * INW * 1024, r % I_IN, scr, F.lane); continue; } r -= 2 * I_IN;
            if (r < 6 * I_SQ) { const int m = r / I_SQ, l = m / 3, w = m % 3; const float* src = a.in[w == 0 ? I_WATTNO : (w == 1 ? I_WCONVO : I_WOUT)] + (size_t)l * 1024 * 1024;
                bf16* dst = (bf16*)(ws + (w == 0 ? WS_WA : (w == 1 ? WS_WC : WS_WO)) + (size_t)l * 6 * MiB); cvt_item(src, nullptr, 1024, 0, 1024, 1024, dst, r % I_SQ, scr, F.lane); continue; } r -= 6 * I_SQ;
            if (r < I_GU0) { cvt_item(a.in[I_WFFG], a.in[I_WFFU], DFF, 1, 1024, 2 * DFF, (bf16*)(ws + WS_WGU0), r, scr, F.lane); continue; } r -= I_GU0;
            if (r < I_D0) { cvt_item(a.in[I_WFFD], nullptr, 1024, 0, DFF, 1024, (bf16*)(ws + WS_WD0), r, scr, F.lane); continue; } r -= I_D0;
            if (r < 8 * I_EGU) { const int e = r / I_EGU; cvt_item(a.in[I_WEG] + (size_t)e * 1024 * DFE, a.in[I_WEU] + (size_t)e * 1024 * DFE, DFE, 1, 1024, 2 * DFE, (bf16*)(ws + WS_WEGU) + (size_t)e * 2 * DFE * 1024, r % I_EGU, scr, F.lane); continue; } r -= 8 * I_EGU;
            { const int e = r / I_ED; cvt_item(a.in[I_WED] + (size_t)e * DFE * 1024, nullptr, 1024, 0, DFE, 1024, (bf16*)(ws + WS_WED) + (size_t)e * 1024 * DFE, r % I_ED, scr, F.lane); }
        }
    }
}

template <bool SB> __device__ __forceinline__ void phase_rmsmod(const Frame& F, const void* src_lat_, const void* src_ctx_, int nrows, const float* g, const float* modl, int shift_idx, bf16* H) {
    const int gw = F.vcu * 8 + F.wave, NGW = F.G * 8;
    for (int row = gw; row < nrows; row += 2 * NGW) {
        const int row2 = row + NGW; const bool has2 = row2 < nrows;
        f32x4 va[4], vb[4]; float sa = 0.f, sb = 0.f;
        if constexpr (SB) { const bf16* src_lat = (const bf16*)src_lat_; const bf16* src_ctx = (const bf16*)src_ctx_;
            const bf16* srcA = row < RL ? src_lat + (size_t)row * 1024 : src_ctx + (size_t)(row - RL) * 1024;
            const bf16* srcB = has2 ? (row2 < RL ? src_lat + (size_t)row2 * 1024 : src_ctx + (size_t)(row2 - RL) * 1024) : srcA;
#pragma unroll
            for (int j = 0; j < 4; ++j) { const v2u xa = *(const v2u*)(srcA + 4 * (F.lane + 64 * j)), xb = *(const v2u*)(srcB + 4 * (F.lane + 64 * j));
                va[j] = (f32x4){bflo(xa.x), bfhi(xa.x), bflo(xa.y), bfhi(xa.y)}; vb[j] = (f32x4){bflo(xb.x), bfhi(xb.x), bflo(xb.y), bfhi(xb.y)}; } }
        else { const float* src_lat = (const float*)src_lat_; const float* src_ctx = (const float*)src_ctx_;
            const float* srcA = row < RL ? src_lat + (size_t)row * 1024 : src_ctx + (size_t)(row - RL) * 1024;
            const float* srcB = has2 ? (row2 < RL ? src_lat + (size_t)row2 * 1024 : src_ctx + (size_t)(row2 - RL) * 1024) : srcA;
#pragma unroll
            for (int j = 0; j < 4; ++j) { va[j] = *(const f32x4*)(srcA + 4 * (F.lane + 64 * j)); vb[j] = *(const f32x4*)(srcB + 4 * (F.lane + 64 * j)); } }
#pragma unroll
        for (int j = 0; j < 4; ++j) { sa += (va[j][0] * va[j][0] + va[j][1] * va[j][1]) + (va[j][2] * va[j][2] + va[j][3] * va[j][3]); sb += (vb[j][0] * vb[j][0] + vb[j][1] * vb[j][1]) + (vb[j][2] * vb[j][2] + vb[j][3] * vb[j][3]); }
        const float ra = rsq_((wave_sum(sa) * (1.f / 1024.f) + EPS)), rb = rsq_((wave_sum(sb) * (1.f / 1024.f) + EPS));
        const float* shA = modl + row_mi(row) * 6144 + shift_idx * 1024; const float* shB = modl + row_mi(has2 ? row2 : row) * 6144 + shift_idx * 1024;
#pragma unroll
        for (int j = 0; j < 4; ++j) { const int col = 4 * (F.lane + 64 * j); const f32x4 gg = *(const f32x4*)(g + col);
            { const f32x4 s4 = *(const f32x4*)(shA + 1024 + col), h4 = *(const f32x4*)(shA + col); const f32x4 y = va[j] * ra * gg * (1.f + s4) + h4;
              v2u w; w.x = cvt_pk_bf16(y[0], y[1]); w.y = cvt_pk_bf16(y[2], y[3]); *(v2u*)(H + (size_t)row * 1024 + col) = w; }
            if (has2) { const f32x4 s4 = *(const f32x4*)(shB + 1024 + col), h4 = *(const f32x4*)(shB + col); const f32x4 y = vb[j] * rb * gg * (1.f + s4) + h4;
              v2u w; w.x = cvt_pk_bf16(y[0], y[1]); w.y = cvt_pk_bf16(y[2], y[3]); *(v2u*)(H + (size_t)row2 * 1024 + col) = w; } }
    }
}

__device__ __forceinline__ void phase_qknorm(const Frame& F, bf16* Q, bf16* Kb, const float* qg, const float* kg, const float* rope, int mode) {
    constexpr int HALFV = NB * NH * 2 * TK;
    const int total = mode ? NB * NH * 2 * CTXL : 2 * HALFV;
    const int j8 = F.tid & 7;
    for (int vec = (F.vcu * 512 + F.tid) >> 3; vec < total; vec += F.G * 64) {
        const bool isK = mode ? true : (vec >= HALFV); const int vv = mode ? (vec >> 8) * TK + (vec & 255) : (isK ? vec - HALFV : vec), t = vv % TK;
        bf16* p = (isK ? Kb : Q) + (size_t)vv * 64 + j8 * 8;
        f32x4 x0, x1; unpack8(*(const v4u*)p, x0, x1);
        float ss = (x0[0] * x0[0] + x0[1] * x0[1]) + (x0[2] * x0[2] + x0[3] * x0[3]) + (x1[0] * x1[0] + x1[1] * x1[1]) + (x1[2] * x1[2] + x1[3] * x1[3]);
        ss += __shfl_xor(ss, 1); ss += __shfl_xor(ss, 2); ss += __shfl_xor(ss, 4);
        const float rinv = rsq_((ss * (1.f / 64.f) + EPS));
        const float* gp = (isK ? kg : qg) + 32 * (j8 >> 2) + 4 * (j8 & 3); const f32x4 g0 = *(const f32x4*)gp, g1 = *(const f32x4*)(gp + 16);
        f32x4 y0 = x0 * rinv * g0, y1 = x1 * rinv * g1;
        f32x4 p0, p1;
#pragma unroll
        for (int e = 0; e < 4; ++e) { p0[e] = __shfl_xor(y0[e], 2); p1[e] = __shfl_xor(y1[e], 2); }
        if (t >= CTXL) {
            const int s = t - CTXL, pos = (j8 >> 2) ? (s & 63) : (s >> 6), i0 = (j8 & 1) * 8; const float sgn = ((j8 >> 1) & 1) ? 1.f : -1.f;
            const float* cp = rope + pos * 16 + i0; const float* sp = cp + 1024;
            const f32x4 c0 = *(const f32x4*)cp, c1 = *(const f32x4*)(cp + 4), s0 = *(const f32x4*)sp, s1 = *(const f32x4*)(sp + 4);
            y0 = y0 * c0 + p0 * s0 * sgn; y1 = y1 * c1 + p1 * s1 * sgn;
        }
        if (!isK) { y0 = y0 * QSCALE; y1 = y1 * QSCALE; }
        *(v4u*)p = pack8(y0, y1);
    }
}

__device__ __forceinline__ void phase_conv(const Frame& F, const bf16* U0, bf16* U1, const float* dww, const float* dwb, const float* lng, const float* lnb, int nrows, bool rev = false) {
    constexpr int RPU = 8, NIN = RPU + CK - 1;
    LAS float* red = (LAS float*)F.lds;
    const int half = F.tid >> 8, t8 = F.tid & 255, ch = 4 * t8, wv = F.wave & 3;
    const f32x4 bias = *(const f32x4*)(dwb + ch), g4 = *(const f32x4*)(lng + ch), b4 = *(const f32x4*)(lnb + ch);
    const int nunits = nrows / RPU;
    for (int u0 = (rev ? F.G - 1 - F.vcu : F.vcu) * 2; u0 < nunits; u0 += F.G * 2) {
        asm volatile("" ::: "memory");
        const int r0 = (u0 + half) * RPU;
        int seg_lo, seg_hi; if (r0 < RL) { seg_lo = r0 & ~4095; seg_hi = seg_lo + 4096; } else { seg_lo = RL + ((r0 - RL) & ~255); seg_hi = seg_lo + 256; }
        v2u xp[NIN];
#pragma unroll
        for (int i = 0; i < NIN; ++i) { const int rr = r0 - 15 + i; xp[i] = (rr >= seg_lo && rr < seg_hi) ? *(const v2u*)(U0 + (size_t)rr * 1024 + ch) : (v2u){0u, 0u}; }
        f32x4 acc[RPU];
#pragma unroll
        for (int r = 0; r < RPU; ++r) acc[r] = bias;
#pragma unroll
        for (int j = 0; j < CK; ++j) { const f32x4 wj = *(const f32x4*)(dww + j * 1024 + ch);
#pragma unroll
            for (int r = 0; r < RPU; ++r) { const v2u x = xp[r + j]; acc[r] += wj * (f32x4){bflo(x.x), bfhi(x.x), bflo(x.y), bfhi(x.y)}; } }
        float sv[RPU], sq[RPU];
#pragma unroll
        for (int r = 0; r < RPU; ++r) { sv[r] = (acc[r][0] + acc[r][1]) + (acc[r][2] + acc[r][3]); sq[r] = (acc[r][0] * acc[r][0] + acc[r][1] * acc[r][1]) + (acc[r][2] * acc[r][2] + acc[r][3] * acc[r][3]); }
        { const float t = reduce8(sv, F.lane), t2 = reduce8(sq, F.lane);
          __syncthreads();
          if ((F.lane & 7) == 0) { red[(half * 4 + wv) * RPU + (F.lane >> 3)] = t; red[128 + (half * 4 + wv) * RPU + (F.lane >> 3)] = t2; } }
        __syncthreads();
#pragma unroll
        for (int r = 0; r < RPU; ++r) { const float mean = ((red[(half * 4 + 0) * RPU + r] + red[(half * 4 + 1) * RPU + r]) + (red[(half * 4 + 2) * RPU + r] + red[(half * 4 + 3) * RPU + r])) * (1.f / 1024.f);
            const float q2 = ((red[128 + (half * 4 + 0) * RPU + r] + red[128 + (half * 4 + 1) * RPU + r]) + (red[128 + (half * 4 + 2) * RPU + r] + red[128 + (half * 4 + 3) * RPU + r])) * (1.f / 1024.f);
            acc[r] = acc[r] - mean; const float q = fmaxf(q2 - mean * mean, 0.f) * 1024.f;
            const float rstd = rsq_((q * (1.f / 1024.f) + EPS));
            const f32x4 y = acc[r] * rstd * g4 + b4; v2u w; w.x = cvt_pk_bf16(y[0] * sigf(y[0]), y[1] * sigf(y[1])); w.y = cvt_pk_bf16(y[2] * sigf(y[2]), y[3] * sigf(y[3]));
            *(v2u*)(U1 + (size_t)(r0 + r) * 1024 + ch) = w; }
    }
    __syncthreads();
}

__device__ __forceinline__ void phase_router(const Frame& F, const float* x1, const float* g, const float* modl, const float* wr, bf16* H2, unsigned* BC, unsigned* TOK) {
    const int TPB = (RL + F.G - 1) / F.G, tbase = F.vcu * TPB;
    LAS int* le = (LAS int*)F.lds;
    f32x4 wa[4][4], wb[4][4];
    { LAS f32x4* wl = (LAS f32x4*)(F.lds + 8192);
#pragma unroll
      for (int i = 0; i < 4; ++i) { const int gch = F.tid + 512 * i, r = gch >> 1, half = gch & 1; wl[(((r >> 8) * 4 + (r & 3)) * 2 + half) * 64 + ((r >> 2) & 63)] = *(const f32x4*)(wr + (size_t)gch * 4); }
      __syncthreads();
#pragma unroll
      for (int j = 0; j < 4; ++j)
#pragma unroll
          for (int e4 = 0; e4 < 4; ++e4) { wa[j][e4] = wl[((j * 4 + e4) * 2 + 0) * 64 + F.lane]; wb[j][e4] = wl[((j * 4 + e4) * 2 + 1) * 64 + F.lane]; } }
    for (int tl0 = F.wave; tl0 < TPB; tl0 += 16) {
        f32x4 v[2][4]; int rows[2]; bool ok[2];
#pragma unroll
        for (int u = 0; u < 2; ++u) { const int tl = tl0 + 8 * u; rows[u] = tbase + tl; ok[u] = tl < TPB && rows[u] < RL;
            if (ok[u]) {
#pragma unroll
                for (int j = 0; j < 4; ++j) v[u][j] = *(const f32x4*)(x1 + (size_t)rows[u] * 1024 + 4 * (F.lane + 64 * j)); }
            else {
#pragma unroll
                for (int j = 0; j < 4; ++j) v[u][j] = (f32x4){0.f, 0.f, 0.f, 0.f}; } }
#pragma unroll
        for (int u = 0; u < 2; ++u) {
            const int tl = tl0 + 8 * u, row = rows[u];
            if (tl >= TPB) continue;
            if (!ok[u]) { if (F.lane == 0) { le[tl * 2] = -1; le[tl * 2 + 1] = -1; } continue; }
            float ss = 0.f;
#pragma unroll
            for (int j = 0; j < 4; ++j) ss += (v[u][j][0] * v[u][j][0] + v[u][j][1] * v[u][j][1]) + (v[u][j][2] * v[u][j][2] + v[u][j][3] * v[u][j][3]);
            const float rinv = rsq_((wave_sum(ss) * (1.f / 1024.f) + EPS));
            const float* sh = modl + (row >> 12) * 6144 + 3 * 1024; const float* sc = sh + 1024;
            float lg[8] = {0, 0, 0, 0, 0, 0, 0, 0};
#pragma unroll
            for (int j = 0; j < 4; ++j) { const int col = 4 * (F.lane + 64 * j); const f32x4 gg = *(const f32x4*)(g + col), s4 = *(const f32x4*)(sc + col), h4 = *(const f32x4*)(sh + col);
                const f32x4 y = v[u][j] * rinv * gg * (1.f + s4) + h4; v2u w; w.x = cvt_pk_bf16(y[0], y[1]); w.y = cvt_pk_bf16(y[2], y[3]); *(v2u*)(H2 + (size_t)row * 1024 + col) = w;
#pragma unroll
                for (int e4 = 0; e4 < 4; ++e4)
#pragma unroll
                    for (int e = 0; e < 4; ++e) { lg[e] += y[e4] * wa[j][e4][e]; lg[4 + e] += y[e4] * wb[j][e4][e]; } }
            { const float t = reduce8(lg, F.lane);
#pragma unroll
              for (int e = 0; e < 8; ++e) lg[e] = __builtin_bit_cast(float, __builtin_amdgcn_readlane(__builtin_bit_cast(int, t), 8 * e)); }
            if (F.lane == 0) {
                int e0 = 0; float v0 = lg[0];
#pragma unroll
                for (int e = 1; e < 8; ++e) if (lg[e] > v0) { v0 = lg[e]; e0 = e; }
                int e1 = e0 == 0 ? 1 : 0; float v1 = lg[e1];
#pragma unroll
                for (int e = 0; e < 8; ++e) if (e != e0 && lg[e] > v1) { v1 = lg[e]; e1 = e; }
                const float w0 = 1.f / (1.f + __expf(v1 - v0)), w1 = 1.f - w0;
                unsigned* tk = TOK + (size_t)row * 8; tk[0] = (unsigned)e0; tk[1] = (unsigned)e1; tk[4] = __float_as_uint(w0); tk[5] = __float_as_uint(w1);
                le[tl * 2] = e0; le[tl * 2 + 1] = e1;
            }
        }
    }
    __syncthreads();
    { const int e = F.wave; unsigned c = 0;
      for (int t0 = 0; t0 < TPB; t0 += 64) { const int tl = t0 + F.lane; const bool m = tl < TPB && (le[tl * 2] == e || le[tl * 2 + 1] == e); c += (unsigned)__popcll(__ballot(m)); }
      if (F.lane == 0) BC[F.vcu * 8 + e] = c; }
    __syncthreads();
}
__device__ __forceinline__ void phase_moe_lists(const Frame& F, const unsigned* BC, unsigned* cnt, unsigned* TOK, int* slist) {
    const int TPB = (RL + F.G - 1) / F.G, tbase = F.vcu * TPB;
    LAS int* le = (LAS int*)F.lds; LAS unsigned* tot = (LAS unsigned*)(F.lds + 4096); LAS unsigned* pre = tot + 8;
    for (int i = F.tid; i < TPB * 2; i += 512) { const int row = tbase + (i >> 1); le[i] = row < RL ? (int)TOK[(size_t)row * 8 + (i & 1)] : -1; }
    LAS unsigned* bcl = pre + 8;
    for (int i = F.tid; i < F.G * 8; i += 512) bcl[i] = BC[i];
    __syncthreads();
    const int e = F.wave;
    { unsigned t = 0, p = 0; for (int b = F.lane; b < F.G; b += 64) { const unsigned c = bcl[b * 8 + e]; t += c; p += (b < F.vcu) ? c : 0u; }
#pragma unroll
      for (int o = 32; o > 0; o >>= 1) { t += (unsigned)__shfl_xor((int)t, o); p += (unsigned)__shfl_xor((int)p, o); }
      if (F.lane == 0) { tot[e] = t; pre[e] = p; } }
    __syncthreads();
    unsigned run = pre[e]; for (int x = 0; x < e; ++x) run += tot[x];
    if (F.vcu == 0 && F.lane == 0) cnt[64 * e] = tot[e];
    for (int t0 = 0; t0 < TPB; t0 += 64) { const int tl = t0 + F.lane; bool m0 = false, m1 = false; if (tl < TPB) { m0 = le[tl * 2] == e; m1 = le[tl * 2 + 1] == e; }
        const unsigned long long bal = __ballot(m0 || m1); const unsigned pos = run + (unsigned)__popcll(bal & ((1ull << F.lane) - 1ull)); const int row = tbase + tl;
        if (m0) { TOK[(size_t)row * 8 + 6] = pos; slist[pos] = row; } else if (m1) { TOK[(size_t)row * 8 + 7] = pos; slist[pos] = row; }
        run += (unsigned)__popcll(bal); }
    __syncthreads();
}
__device__ __forceinline__ int moe_build_table(const Frame& F, const unsigned* cnt, LAS int* tab) {
    LAS int* scan = tab + 4 * 160; LAS int* offl = scan + 132;
    if (F.tid < 64) {
        const int c = F.lane < 8 ? (int)__hip_atomic_load(cnt + 64 * F.lane, __ATOMIC_RELAXED, __HIP_MEMORY_SCOPE_AGENT) : 0; int inc = c;
#pragma unroll
        for (int o = 1; o < 8; o <<= 1) { const int n = __shfl_up(inc, o); if (F.lane >= o) inc += n; }
        if (F.lane < 8) offl[F.lane + 1] = inc; if (F.lane == 0) offl[0] = 0; }
    __syncthreads();
    int nmine = 0;
    if (F.tid < 128) { const int base = F.tid * 256;
#pragma unroll
        for (int e = 0; e < 8; ++e) { const int lo = max(base, offl[e]), hi = min(base + 256, offl[e + 1]); if (lo < hi) ++nmine; }
        int inc = nmine;
#pragma unroll
        for (int o = 1; o < 64; o <<= 1) { const int n = __shfl_up(inc, o); if (F.lane >= o) inc += n; }
        scan[F.tid] = inc - nmine; if (F.tid == 63) scan[129] = inc; if (F.tid == 127) scan[130] = inc; }
    __syncthreads();
    const int w0tot = scan[129], total = w0tot + scan[130];
    if (F.tid < 128) { const int base = F.tid * 256; int o = scan[F.tid] + (F.tid >= 64 ? w0tot : 0);
#pragma unroll
        for (int e = 0; e < 8; ++e) { const int lo = max(base, offl[e]), hi = min(base + 256, offl[e + 1]); if (lo < hi) { tab[o * 4 + 0] = F.tid; tab[o * 4 + 1] = e; tab[o * 4 + 2] = lo; tab[o * 4 + 3] = hi; ++o; } } }
    __syncthreads();
    return total;
}
__device__ __forceinline__ void phase_moe_final(const Frame& F, float* out, const bf16* Ys, const unsigned* TOK, const float* gate5) {
    const int gw = F.vcu * 8 + F.wave, NGW = F.G * 8;
    for (int row = gw; row < RL; row += 2 * NGW) {
        const int row2 = (row + NGW < RL) ? row + NGW : row;
        const unsigned* tka = TOK + (size_t)row * 8; const unsigned* tkb = TOK + (size_t)row2 * 8;
        const float wa0 = __uint_as_float(tka[4]), wa1 = __uint_as_float(tka[5]), wb0 = __uint_as_float(tkb[4]), wb1 = __uint_as_float(tkb[5]);
        const size_t pa0 = tka[6], pa1 = tka[7], pb0 = tkb[6], pb1 = tkb[7];
        const float* ga = gate5 + (row >> 12) * 6144; const float* gb = gate5 + (row2 >> 12) * 6144;
        v2u ya0[4], ya1[4], yb0[4], yb1[4]; f32x4 xa[4], xb[4];
#pragma unroll
        for (int j = 0; j < 4; ++j) { const int col = 4 * (F.lane + 64 * j);
            ya0[j] = *(const v2u*)(Ys + pa0 * 1024 + col); ya1[j] = *(const v2u*)(Ys + pa1 * 1024 + col); yb0[j] = *(const v2u*)(Ys + pb0 * 1024 + col); yb1[j] = *(const v2u*)(Ys + pb1 * 1024 + col);
            xa[j] = *(const f32x4*)(out + (size_t)row * 1024 + col); xb[j] = *(const f32x4*)(out + (size_t)row2 * 1024 + col); }
#pragma unroll
        for (int j = 0; j < 4; ++j) { const int col = 4 * (F.lane + 64 * j); const f32x4 gga = *(const f32x4*)(ga + col), ggb = *(const f32x4*)(gb + col);
            f32x4 x = xa[j];
            x[0] += gga[0] * (wa0 * bflo(ya0[j].x) + wa1 * bflo(ya1[j].x)); x[1] += gga[1] * (wa0 * bfhi(ya0[j].x) + wa1 * bfhi(ya1[j].x)); x[2] += gga[2] * (wa0 * bflo(ya0[j].y) + wa1 * bflo(ya1[j].y)); x[3] += gga[3] * (wa0 * bfhi(ya0[j].y) + wa1 * bfhi(ya1[j].y));
            *(f32x4*)(out + (size_t)row * 1024 + col) = x;
            if (row2 != row) { f32x4 y = xb[j];
                y[0] += ggb[0] * (wb0 * bflo(yb0[j].x) + wb1 * bflo(yb1[j].x)); y[1] += ggb[1] * (wb0 * bfhi(yb0[j].x) + wb1 * bfhi(yb1[j].x)); y[2] += ggb[2] * (wb0 * bflo(yb0[j].y) + wb1 * bflo(yb1[j].y)); y[3] += ggb[3] * (wb0 * bfhi(yb0[j].y) + wb1 * bfhi(yb1[j].y));
                *(f32x4*)(out + (size_t)row2 * 1024 + col) = y; } }
    }
}

#ifndef REP_MASK
#define REP_MASK 0u
#endif
#define REP(j) (1 + ((REP_MASK >> (j)) & 1u))
#ifndef PH_MASK
#define PH_MASK 0xffffffffu
#endif
#define IN(k) (lo <= (k) && (k) < hi)
#define ON(j) ((PH_MASK >> (j)) & 1u)
#define SEAM(k) do { if (IN(k) && IN((k) + 1)) xcd_barrier(bar); } while (0)
template <int l>
__device__ __forceinline__ void layer_body(const Frame& F, const Args& a, const XcdBarrier& bar, unsigned char* ws, unsigned* ctl, const int lo, const int hi) {
    const int G = F.G, cb = (int)blockIdx.x;
    const float* MOD = (const float*)(ws + WS_MOD);
    bf16* A0 = (bf16*)(ws + WS_A0); bf16* A1 = (bf16*)(ws + WS_A1); bf16* A2 = (bf16*)(ws + WS_A2); bf16* A3 = (bf16*)(ws + WS_A3); bf16* A4 = (bf16*)(ws + WS_A4); bf16* A5 = (bf16*)(ws + WS_A5);
    bf16* XB = (bf16*)(ws + WS_XB);
    {
        const int pb = 1 + l * 9;
        const float* modl = MOD + (size_t)l * 5 * 6144;
        const void* xs_lat = l == 0 ? (const void*)a.in[I_X] : (const void*)XB; const void* xs_ctx = l == 0 ? (const void*)a.in[I_CTX] : (const void*)(XB + (size_t)RL * 1024);
        if (ON(1) && IN(pb + 0)) for (int rep_ = 0; rep_ < (int)REP(1); ++rep_) phase_rmsmod<(l != 0)>(F, xs_lat, xs_ctx, R, a.in[I_GMIX] + l * 1024, modl, 0, A0);
        SEAM(pb + 0);
        if (ON(2) && IN(pb + 1)) {
            SchedPlain S{(const char*)A0, (const char*)(ws + WS_WIN + (size_t)l * 14 * MiB), (l == 0 ? R : RL) / 256, INW / 256, 1024, G, cb};
            EpiInProj E{A1, A2, A3, A4, A5, a.in[I_QG] + l * 64, a.in[I_KG] + l * 64, (const float*)(ws + WS_ROPE)};
            for (int rep_ = 0; rep_ < (int)REP(2); ++rep_) run_gemm<false>(F.lds, 1024, S, E);
            if (l == 1) {
                for (int t = F.vcu; t < 512; t += G) { const int tm = t >> 5, tn = t & 31; Unit u{};
                    gemm_small_tile(F.lds, A0 + (size_t)(RL + 64 * tm) * 1024, (const bf16*)(ws + WS_WIN + (size_t)14 * MiB) + (size_t)(1024 + 64 * tn) * 1024, 1024, RL + 64 * tm, 1024 + 64 * tn, u, E); }
            }
        }
        SEAM(pb + 1);
        if (ON(3) && IN(pb + 2)) {
#if FAST_GEMM
            if (l == 1) phase_qknorm(F, A1, A2, a.in[I_QG] + l * 64, a.in[I_KG] + l * 64, (const float*)(ws + WS_ROPE), 1);
#else
            phase_qknorm(F, A1, A2, a.in[I_QG] + l * 64, a.in[I_KG] + l * 64, (const float*)(ws + WS_ROPE), 0);
#endif
#ifndef SKIP_CONV
            for (int rep_ = 0; rep_ < (int)REP(3); ++rep_) phase_conv(F, A4, A0, a.in[I_DWW] + (size_t)l * CK * 1024, a.in[I_DWB] + l * 1024, a.in[I_CLNG] + l * 1024, a.in[I_CLNB] + l * 1024, l == 0 ? R : RL, l == 0);
#endif
        }
        if (l != 0) SEAM(pb + 2);
        bf16* ONb = l == 0 ? XB : A4;
        if (ON(4) && IN(pb + 3)) {
#ifndef SKIP_ATTN
#if FAST_ATTN
#ifdef ATT_XVAR
            attn_fast<ATT_XVAR>(F, A1, A2, A3, A4, a.in[I_SUBLN] + l * 128, (const float*)(ws + WS_LAM) + l * 2, l == 0);
#endif
            attn16(F, A1, A2, A3, ONb, a.in[I_SUBLN] + l * 128, (const float*)(ws + WS_LAM) + l * 2, l == 0
#ifdef PROBE_STAMP
                   , (l == 0 && blockIdx.x == 0) ? (unsigned long long*)(ws + WS_CTL + 768 * 1024) : nullptr
#endif
                   );
#else
            attn_naive(F, A1, A2, A3, A4, a.in[I_SUBLN] + l * 128, (const float*)(ws + WS_LAM) + l * 2, l == 0);
#endif
#endif
        }
        SEAM(pb + 3);
        if (ON(5) && IN(pb + 4)) {
            SchedMerge S{(const char*)ONb, (const char*)(ws + WS_WA + (size_t)l * 6 * MiB), (const char*)A0, (const char*)(ws + WS_WC + (size_t)l * 6 * MiB), RL / 256, 4, 1024, G, cb};
            EpiMerge E{A5, A2, A1};
            for (int rep_ = 0; rep_ < (int)REP(5); ++rep_) run_gemm<false>(F.lds, 1024, S, E);
            if (l == 0) {
                for (int t = F.vcu; t < 256; t += G) { const int tm = t >> 4, tn = t & 15; Unit u{};
                    u.aux = 0; gemm_small_tile(F.lds, ONb + (size_t)(RL + 64 * tm) * 1024, (const bf16*)(ws + WS_WA) + (size_t)(64 * tn) * 1024, 1024, RL + 64 * tm, 64 * tn, u, E);
                    u.aux = 1; gemm_small_tile(F.lds, A0 + (size_t)(RL + 64 * tm) * 1024, (const bf16*)(ws + WS_WC) + (size_t)(64 * tn) * 1024, 1024, RL + 64 * tm, 64 * tn, u, E); }
            }
        }
        SEAM(pb + 4);
        if (ON(6) && IN(pb + 5)) {
            SchedPlain S{(const char*)A1, (const char*)(ws + WS_WO + (size_t)l * 6 * MiB), RL / 256, 4, 1024, G, cb};
            EpiResidT<(l != 0), (l == 0)> E{xs_lat, xs_ctx, l == 0 ? (void*)XB : (void*)a.out, modl + 2 * 1024};
            for (int rep_ = 0; rep_ < (int)REP(6); ++rep_) run_gemm<false>(F.lds, 1024, S, E);
            if (l == 0) { for (int t = F.vcu; t < 256; t += G) { const int tm = t >> 4, tn = t & 15; Unit u{};
                    gemm_small_tile(F.lds, A1 + (size_t)(RL + 64 * tm) * 1024, (const bf16*)(ws + WS_WO) + (size_t)(64 * tn) * 1024, 1024, RL + 64 * tm, 64 * tn, u, E); } }
        }
        SEAM(pb + 5);
        if (l == 0) {
            if (ON(7) && IN(pb + 6)) for (int rep_ = 0; rep_ < (int)REP(7); ++rep_) phase_rmsmod<true>(F, XB, XB + (size_t)RL * 1024, R, a.in[I_GFFN], modl, 3, A0);
            SEAM(pb + 6);
            if (ON(8) && IN(pb + 7)) {
                SchedPlain S{(const char*)A0, (const char*)(ws + WS_WGU0), R / 256, 2 * DFF / 256, 1024, G, cb};
                EpiSwiglu E{A1, DFF};
                for (int rep_ = 0; rep_ < (int)REP(8); ++rep_) run_gemm<false>(F.lds, 1024, S, E);
            }
            SEAM(pb + 7);
            if (ON(9) && IN(pb + 8)) {
                SchedPlain S{(const char*)A1, (const char*)(ws + WS_WD0), RL / 256, 4, DFF, G, cb};
                EpiResidT<true, true> E{XB, XB + (size_t)RL * 1024, XB, modl + 5 * 1024};
                run_gemm<false>(F.lds, DFF, S, E);
                for (int t = F.vcu; t < 256; t += G) { const int tm = t >> 4, tn = t & 15; Unit u{};
                    gemm_small_tile(F.lds, A1 + (size_t)(RL + 64 * tm) * DFF, (const bf16*)(ws + WS_WD0) + (size_t)(64 * tn) * DFF, DFF, RL + 64 * tm, 64 * tn, u, E); }
            }
            SEAM(pb + 8);
        } else {
            unsigned* cnt = ctl + CW_CNT; unsigned* TOK = (unsigned*)(ws + WS_TOK); int* slist = (int*)(ws + WS_SLIST);
            LAS int* tab = (LAS int*)(F.lds + MOETAB_OFF);
#ifndef SKIP_ROUTER
            if (ON(16) && IN(16)) phase_router(F, a.out, a.in[I_GFFN] + 1024, modl, a.in[I_WR], A0, (unsigned*)(ws + WS_BC), TOK);
#endif
            SEAM(16);
            if (ON(17) && IN(17)) phase_moe_lists(F, (const unsigned*)(ws + WS_BC), cnt, TOK, slist);
            SEAM(17);
            if (ON(18) && IN(18)) {
                const int NU = moe_build_table(F, cnt, tab);
                SchedMoe S{(const char*)A0, (const char*)(ws + WS_WEGU), slist, tab, NU, 2 * DFE / 256, 1024, G, cb, (size_t)2 * DFE * 1024 * 2, 1, NU * (2 * DFE / 256)};
                EpiSwiglu E{A1, DFE};
                for (int rep_ = 0; rep_ < (int)REP(18); ++rep_) run_gemm<true>(F.lds, 1024, S, E);
                { const int total = NU * 4, whole = (total / G) * G, left = total - whole;
                  if (left > 0 && 2 * left <= G) for (int sidx = F.vcu; sidx < left; sidx += G) { int pm, pn; tile_of(whole + sidx, NU, 4, pm, pn); const int lo = tab[pm * 4 + 2], hi = tab[pm * 4 + 3];
                      for (int i = F.tid; i < (hi - lo) * 32; i += 512) *(v4u*)((bf16*)XB + (size_t)(lo + (i >> 5)) * 1024 + pn * 256 + (i & 31) * 8) = (v4u){0u, 0u, 0u, 0u}; } }
            }
            SEAM(18);
            if (ON(19) && IN(19)) {
                const int NU = moe_build_table(F, cnt, tab);
                const int total = NU * 4; int whole = (total / G) * G, left = total - whole;
                if (!(left > 0 && 2 * left <= G)) { whole = total; left = 0; }
                SchedMoeDown S{(const char*)A1, (const char*)(ws + WS_WED), tab, NU, whole, left, G, cb, (size_t)1024 * DFE * 2};
                EpiMoeDown E{(bf16*)XB, 1024};
                run_gemm<false, DFE, true>(F.lds, DFE, S, E);
            }
            SEAM(19);
            if (ON(20) && IN(20)) phase_moe_final(F, a.out, (const bf16*)XB, TOK, modl + 5 * 1024);
        }
        }
}

constexpr int N_PHASES = 21;
__global__ void __launch_bounds__(512, 2) fwd_kernel(Args a) {
    extern __shared__ __attribute__((aligned(16))) unsigned char lds_raw[];
    Frame F; F.lds = (LAS unsigned char*)lds_raw; F.tid = threadIdx.x; F.lane = F.tid & 63; F.wave = __builtin_amdgcn_readfirstlane(F.tid >> 6);
    F.G = gridDim.x; { const int bx = blockIdx.x; F.vcu = (F.G % 8 == 0) ? (bx % 8) * (F.G / 8) + bx / 8 : bx; }
    unsigned char* ws = a.ws;
    unsigned* ctl = (unsigned*)(ws + WS_CTL);
    for (int u = F.tid; u < (LDS_BYTES - LDSCTL_OFF) / 4; u += 512) ((LAS unsigned*)(F.lds + LDSCTL_OFF))[u] = 0u;
    __syncthreads();
    volatile LAS unsigned* MISC = (volatile LAS unsigned*)(F.lds + MISC_OFF);
    XcdBarrier bar = xcd_barrier_post(ctl + CW_BAR, MISC + 8);
    const int lo = a.ph_lo, hi = a.ph_hi;

    const int G = F.G, cb = (int)blockIdx.x;
    const float* MOD = (const float*)(ws + WS_MOD);
    bf16* A0 = (bf16*)(ws + WS_A0); bf16* A1 = (bf16*)(ws + WS_A1); bf16* A2 = (bf16*)(ws + WS_A2); bf16* A3 = (bf16*)(ws + WS_A3); bf16* A4 = (bf16*)(ws + WS_A4); bf16* A5 = (bf16*)(ws + WS_A5);
    bf16* XB = (bf16*)(ws + WS_XB);

    #ifndef SKIP_PRO
    if (ON(0) && IN(0)) { for (int rep_ = 0; rep_ < (int)REP(0); ++rep_) phase_prologue(F, a); }
#endif
    SEAM(0);

    layer_body<0>(F, a, bar, ws, ctl, lo, hi);
    layer_body<1>(F, a, bar, ws, ctl, lo, hi);
#ifdef PROBE_STAMP
    xcd_barrier(bar);
    if (blockIdx.x == 0 && F.tid == 0) { const unsigned long long* st = (const unsigned long long*)(ws + WS_CTL + 768 * 1024);
        const float ghz = (float)st[0] / (float)st[1] * 0.1f, cpi = (float)st[0] / (float)st[2];
        a.out[0] += (PROBE_STAMP == 1) ? ghz * 10.f : (cpi - 2000.f) * 0.05f; }
#endif
#undef IN
#undef SEAM
}

extern "C" void kernel_launch(void* const* d_in, const int* in_sizes, int n_in, void* d_out, int out_size, void* d_ws, size_t ws_size, hipStream_t stream) {
    static int grid = 0;
    if (grid == 0) {
        if (n_in != N_IN || out_size != RL * D || ws_size < WS_END) { fprintf(stderr, "kernel_launch: unexpected shapes (n_in %d out %d ws %zu)\n", n_in, out_size, ws_size); grid = -1; return; }
        int dev = 0, cus = 0, per_cu = 0;
        if (hipGetDevice(&dev) != hipSuccess || hipDeviceGetAttribute(&cus, hipDeviceAttributeMultiprocessorCount, dev) != hipSuccess) { grid = -1; return; }
        if (hipFuncSetAttribute((const void*)fwd_kernel, hipFuncAttributeMaxDynamicSharedMemorySize, LDS_BYTES) != hipSuccess) { fprintf(stderr, "kernel_launch: hipFuncSetAttribute failed\n"); grid = -1; return; }
        if (hipOccupancyMaxActiveBlocksPerMultiprocessor(&per_cu, (const void*)fwd_kernel, 512, LDS_BYTES) != hipSuccess || per_cu < 1) fprintf(stderr, "kernel_launch: occupancy query reports %d\n", per_cu);
        (void)hipGetLastError();
        grid = cus;
    }
    if (grid < 0) return;
    (void)hipMemsetAsync((char*)d_ws + WS_CTL, 0, CTL_ZERO_BYTES, stream);
    Args a{};
    for (int i = 0; i < N_IN; ++i) a.in[i] = (const float*)d_in[i];
    a.out = (float*)d_out; a.ws = (unsigned char*)d_ws; a.ph_lo = 0; a.ph_hi = N_PHASES;
    hipLaunchKernelGGL(fwd_kernel, dim3(grid), dim3(512), LDS_BYTES, stream, a);
}
```
